# Optimizing an MI355X kernel written in HIP

```python
import jax, jax.numpy as jnp
from jax import lax
import numpy as np

D_MODEL = 4096
BATCH = 8
SEQ = 2048
DEPTH = 2
DEC_BATCH = 1
DEC_SEQ = 16384
PAST_LEN = 128

HEAD_DIM = 128
GLA_WIDTH = 3 * D_MODEL // 8
GLA_DV = 2 * HEAD_DIM
GLA_HEADS = GLA_WIDTH // GLA_DV
GLA_DK = HEAD_DIM
GLA_QK_WIDTH = GLA_HEADS * GLA_DK
GLA_CHUNK = 64
GLA_GATE_RANK = 16
GLA_GATE_TAU = 16.0
SGU_WIDTH = D_MODEL // 4
SGU_CHUNK = 128
SGU_GROUP_DIM = 128
SGU_GROUPS = SGU_WIDTH // SGU_GROUP_DIM
ATT_WIDTH = 3 * D_MODEL // 8
ATT_Q_HEADS = ATT_WIDTH // HEAD_DIM
ATT_KV_HEADS = 4
ATT_GROUP = ATT_Q_HEADS // ATT_KV_HEADS
ATT_KV_WIDTH = ATT_KV_HEADS * HEAD_DIM
WINDOW = 128
ROPE_THETA = 500000.0
ROPE_DIMS = HEAD_DIM // 4
N_BRANCH = 3
MIX_WIDTH = GLA_WIDTH + SGU_WIDTH + ATT_WIDTH
SPLIT_SIZES = (GLA_QK_WIDTH, GLA_QK_WIDTH, GLA_WIDTH, 2 * GLA_GATE_RANK, GLA_WIDTH,
               SGU_WIDTH, SGU_WIDTH, SGU_WIDTH,
               ATT_WIDTH, ATT_KV_WIDTH, ATT_KV_WIDTH, ATT_WIDTH,
               N_BRANCH * D_MODEL)
N_IN = sum(SPLIT_SIZES)
NORM_EPS = 1e-6
LN_EPS = 1e-5

kernel_name = "hybrid_gla_sgu_swa_gated_encoder"


def _rms_norm(x, gain):
    xf = x.astype(jnp.float32)
    y = xf * lax.rsqrt(jnp.mean(xf * xf, axis=-1, keepdims=True) + NORM_EPS)
    return (y * gain.astype(jnp.float32)).astype(x.dtype)


def _layer_norm(x, gain, bias):
    xf = x.astype(jnp.float32)
    mu = jnp.mean(xf, axis=-1, keepdims=True)
    xc = xf - mu
    y = xc * lax.rsqrt(jnp.mean(xc * xc, axis=-1, keepdims=True) + LN_EPS)
    return (y * gain.astype(jnp.float32) + bias.astype(jnp.float32)).astype(x.dtype)


def _partial_rope(x):
    S = x.shape[1]
    inv_freq = ROPE_THETA ** (-jnp.arange(0, ROPE_DIMS, 2, dtype=jnp.float32) / ROPE_DIMS)
    ang = jnp.arange(S, dtype=jnp.float32)[:, None] * inv_freq[None, :]
    cos = jnp.cos(ang)[None, :, None, :]
    sin = jnp.sin(ang)[None, :, None, :]
    xf = x.astype(jnp.float32)
    half = ROPE_DIMS // 2
    x1 = xf[..., :half]
    x2 = xf[..., half:ROPE_DIMS]
    out = jnp.concatenate([x1 * cos - x2 * sin, x2 * cos + x1 * sin, xf[..., ROPE_DIMS:]], axis=-1)
    return out.astype(x.dtype)


def _gla_chunked(q, k, v, log_a):
    B, S, H, DK = q.shape
    DV = v.shape[-1]
    C = GLA_CHUNK
    NC = S // C

    def to_chunks(t):
        return t.astype(jnp.float32).reshape(B, NC, C, H, t.shape[-1]).transpose(1, 0, 3, 2, 4)

    qc = to_chunks(q) * (DK ** -0.5)
    kc = to_chunks(k)
    vc = to_chunks(v)
    gc = to_chunks(log_a)
    lower = jnp.tril(jnp.ones((C, C), dtype=bool))

    def step(state, inp):
        qi, ki, vi, gi = inp
        b = jnp.cumsum(gi, axis=2)
        b_last = b[:, :, -1:, :]
        o_inter = jnp.einsum('bhtd,bhde->bhte', qi * jnp.exp(b), state)
        diff = b[:, :, :, None, :] - b[:, :, None, :, :]
        decay = jnp.exp(jnp.where(lower[:, :, None], diff, -jnp.inf))
        scores = jnp.einsum('bhtsd,bhsd->bhts', qi[:, :, :, None, :] * decay, ki)
        o_intra = jnp.einsum('bhts,bhse->bhte', scores, vi)
        new_state = (jnp.exp(b_last[:, :, 0, :, None]) * state
                     + jnp.einsum('bhsd,bhse->bhde', ki * jnp.exp(b_last - b), vi))
        return new_state, o_inter + o_intra

    state0 = jnp.zeros((B, H, DK, DV), jnp.float32)
    _, o = lax.scan(step, state0, (qc, kc, vc, gc))
    return o.transpose(1, 0, 3, 2, 4).reshape(B, S, H, DV)


def _window_attention(q, k, v, sink):
    B, S = q.shape[:2]
    nb = S // WINDOW
    qb = q.reshape(B, nb, WINDOW, ATT_KV_HEADS, ATT_GROUP, HEAD_DIM)
    pad = ((0, 0), (WINDOW, WINDOW), (0, 0), (0, 0))
    kp = jnp.pad(k, pad).reshape(B, nb + 2, WINDOW, ATT_KV_HEADS, HEAD_DIM)
    vp = jnp.pad(v, pad).reshape(B, nb + 2, WINDOW, ATT_KV_HEADS, HEAD_DIM)
    kb = jnp.concatenate([kp[:, :-2], kp[:, 1:-1], kp[:, 2:]], axis=2)
    vb = jnp.concatenate([vp[:, :-2], vp[:, 1:-1], vp[:, 2:]], axis=2)
    s = jnp.einsum('bnqhgd,bnkhd->bnhgqk', qb, kb,
                   preferred_element_type=jnp.float32) * (HEAD_DIM ** -0.5)
    blk = jnp.arange(nb)[:, None, None]
    qpos = blk * WINDOW + jnp.arange(WINDOW)[None, :, None]
    kpos = blk * WINDOW - WINDOW + jnp.arange(3 * WINDOW)[None, None, :]
    valid = (jnp.abs(kpos - qpos) <= WINDOW) & (kpos >= 0) & (kpos < S)
    s = jnp.where(valid[None, :, None, None], s, -jnp.inf)
    sink_logit = jnp.broadcast_to(
        sink.astype(jnp.float32).reshape(1, 1, ATT_KV_HEADS, ATT_GROUP, 1, 1), s.shape[:-1] + (1,))
    p = jax.nn.softmax(jnp.concatenate([s, sink_logit], axis=-1), axis=-1)[..., :-1]
    o = jnp.einsum('bnhgqk,bnkhd->bnqhgd', p.astype(v.dtype), vb)
    return o.reshape(B, S, ATT_Q_HEADS * HEAD_DIM)


def _layer(x, norm_gain, w_in, gla_gate_up, gla_gate_bias, gla_norm_gain,
           sgu_ln_gain, sgu_ln_bias, sgu_w, sgu_b, q_norm_gain, k_norm_gain, sink,
           gate_bias, w_br, w_out):
    B, S, _ = x.shape
    h = _rms_norm(x, norm_gain) @ w_in
    split_idx = [int(i) for i in np.cumsum(SPLIT_SIZES)[:-1]]
    (a_q, a_k, a_v, a_lr, a_gate, b_u, b_v, b_gate,
     c_q, c_k, c_v, c_gate, g_merge) = jnp.split(h, split_idx, axis=-1)

    qa = a_q.reshape(B, S, GLA_HEADS, GLA_DK)
    ka = a_k.reshape(B, S, GLA_HEADS, GLA_DK)
    va = a_v.reshape(B, S, GLA_HEADS, GLA_DV)
    lr = a_lr.reshape(B, S, 2, GLA_GATE_RANK)
    z = jnp.einsum('bsjr,jrk->bsjk', lr, gla_gate_up) + gla_gate_bias
    log_a = (jax.nn.log_sigmoid(z.astype(jnp.float32)) / GLA_GATE_TAU).reshape(B, S, 2, GLA_HEADS, GLA_DK)
    fwd = _gla_chunked(qa, ka, va, log_a[:, :, 0])
    rev = lambda t: jnp.flip(t, axis=1)
    bwd = rev(_gla_chunked(rev(qa), rev(ka), rev(va), rev(log_a[:, :, 1])))
    o_a = _rms_norm(fwd + bwd, gla_norm_gain).astype(x.dtype).reshape(B, S, GLA_WIDTH) * jax.nn.silu(a_gate)

    u = jax.nn.gelu(b_u)
    vv = _layer_norm(jax.nn.gelu(b_v), sgu_ln_gain, sgu_ln_bias)
    vr = vv.reshape(B, S // SGU_CHUNK, SGU_CHUNK, SGU_GROUPS, SGU_GROUP_DIM)
    mixed = jnp.einsum('gpq,bnqgc->bnpgc', sgu_w, vr) + sgu_b.T[None, None, :, :, None]
    o_b = u * mixed.reshape(B, S, SGU_WIDTH) * jax.nn.silu(b_gate)

    qc = _partial_rope(_rms_norm(c_q.reshape(B, S, ATT_Q_HEADS, HEAD_DIM), q_norm_gain))
    kc = _partial_rope(_rms_norm(c_k.reshape(B, S, ATT_KV_HEADS, HEAD_DIM), k_norm_gain))
    vc = c_v.reshape(B, S, ATT_KV_HEADS, HEAD_DIM)
    o_c = _window_attention(qc, kc, vc, sink) * jax.nn.silu(c_gate)

    gates = jax.nn.sigmoid(g_merge.reshape(B, S, N_BRANCH, D_MODEL) + gate_bias)
    y_a = o_a @ w_br[:GLA_WIDTH]
    y_b = o_b @ w_br[GLA_WIDTH:GLA_WIDTH + SGU_WIDTH]
    y_c = o_c @ w_br[GLA_WIDTH + SGU_WIDTH:]
    merged = gates[:, :, 0] * y_a + gates[:, :, 1] * y_b + gates[:, :, 2] * y_c
    return x + merged @ w_out


def setup_inputs(seed: int = 0) -> dict:
    key = jax.random.key(seed)
    ks = jax.random.split(key, 17)
    nrm = jax.random.normal
    f32 = jnp.float32
    return {
        "x_prompt": nrm(ks[0], (BATCH, SEQ, D_MODEL), f32),
        "x_sample": nrm(ks[1], (DEC_BATCH, DEC_SEQ, D_MODEL), f32),
        "norm_gain": 1.0 + 0.02 * nrm(ks[2], (DEPTH, D_MODEL), f32),
        "w_in": nrm(ks[3], (DEPTH, D_MODEL, N_IN), f32) * (D_MODEL ** -0.5),
        "gla_gate_up": nrm(ks[4], (DEPTH, 2, GLA_GATE_RANK, GLA_QK_WIDTH), f32) * (GLA_GATE_RANK ** -0.5),
        "gla_gate_bias": 0.1 * nrm(ks[5], (DEPTH, 2, GLA_QK_WIDTH), f32),
        "gla_norm_gain": 1.0 + 0.02 * nrm(ks[6], (DEPTH, GLA_DV), f32),
        "sgu_ln_gain": 1.0 + 0.02 * nrm(ks[7], (DEPTH, SGU_WIDTH), f32),
        "sgu_ln_bias": 0.02 * nrm(ks[8], (DEPTH, SGU_WIDTH), f32),
        "sgu_w": nrm(ks[9], (DEPTH, SGU_GROUPS, SGU_CHUNK, SGU_CHUNK), f32) * (SGU_CHUNK ** -0.5),
        "sgu_b": 1.0 + 0.02 * nrm(ks[10], (DEPTH, SGU_GROUPS, SGU_CHUNK), f32),
        "q_norm_gain": 1.0 + 0.02 * nrm(ks[11], (DEPTH, HEAD_DIM), f32),
        "k_norm_gain": 1.0 + 0.02 * nrm(ks[12], (DEPTH, HEAD_DIM), f32),
        "sink": 0.5 * nrm(ks[13], (DEPTH, ATT_Q_HEADS), f32),
        "gate_bias": 0.1 * nrm(ks[14], (DEPTH, N_BRANCH, D_MODEL), f32),
        "w_br": nrm(ks[15], (DEPTH, MIX_WIDTH, D_MODEL), f32) * (MIX_WIDTH ** -0.5),
        "w_out": nrm(ks[16], (DEPTH, D_MODEL, D_MODEL), f32) * (D_MODEL ** -0.5),
    }


def reference(x_prompt, x_sample, norm_gain, w_in, gla_gate_up, gla_gate_bias, gla_norm_gain,
              sgu_ln_gain, sgu_ln_bias, sgu_w, sgu_b, q_norm_gain, k_norm_gain, sink,
              gate_bias, w_br, w_out):
    y_prompt = x_prompt
    y_sample = x_sample
    for l in range(DEPTH):
        params = (norm_gain[l], w_in[l], gla_gate_up[l], gla_gate_bias[l], gla_norm_gain[l],
                  sgu_ln_gain[l], sgu_ln_bias[l], sgu_w[l], sgu_b[l], q_norm_gain[l],
                  k_norm_gain[l], sink[l], gate_bias[l], w_br[l], w_out[l])
        y_prompt = _layer(y_prompt, *params)
        y_sample = _layer(y_sample, *params)
    return (y_prompt, y_sample)
```

```cpp
#include <hip/hip_runtime.h>
#include <cstdio>
#include <cstdint>

#ifndef MFMA_SGU
#define MFMA_SGU 1
#endif
#ifndef MFMA_ATT
#define MFMA_ATT 1
#endif
#ifndef ATT_FUSED_NORM
#define ATT_FUSED_NORM 0
#endif
#ifndef MFMA_GLA
#define MFMA_GLA 1
#endif
#ifndef KROT
#define KROT 0
#endif
#ifndef DUP_MASK
#define DUP_MASK 0
#endif
#ifndef MK_N_LAUNCHES
#define MK_N_LAUNCHES 1
#endif

namespace pg8 {
#define PG8_LAS __attribute__((address_space(3)))
typedef unsigned short bf16_t;
typedef short bf16x8 __attribute__((ext_vector_type(8)));
typedef float f32x4 __attribute__((ext_vector_type(4)));
typedef unsigned u32x4 __attribute__((ext_vector_type(4)));
constexpr int BM = 256, BK = 64, HALF = 128, HTB = HALF * BK * 2, STAGE_BYTES = 8 * HTB, NXCD = 8, WGM = 8;

__host__ __device__ __forceinline__ int lds_byte(int r, int c) { const int st = (r >> 4) * 2 + (c >> 5), rr = r & 15, cc = c & 31, ob = rr * 64 + cc * 2; return st * 1024 + (ob ^ (((ob >> 9) & 1) << 5)); }
__host__ __device__ __forceinline__ void stage_rc(int b, int& R, int& C) { const int st = b / 1024, sb = b % 1024, swz = sb ^ (((sb >> 9) & 1) << 5); R = (st >> 1) * 16 + swz / 64; C = (st & 1) * 32 + (swz % 64) / 2; }
__host__ __device__ __forceinline__ int perm32(int rho) { const int n = rho >> 4, i = rho & 15; return 8 * (i >> 2) + 4 * n + (i & 3); }

struct Unit { int pm, pn, k0, nt, tag, rot; };
struct Gemm { const bf16_t* A; const bf16_t* Bt; static constexpr int lda = 4096, ldb = 4096; };

__host__ __device__ __forceinline__ void static_tile(int L, int nM, int nN, int& pm, int& pn) {
    const int nwg = nM * nN; int wgid = L;
    { const int q = nwg / NXCD, r = nwg % NXCD, xcd = wgid % NXCD, off = wgid / NXCD; wgid = (xcd < r ? xcd * (q + 1) : r * (q + 1) + (xcd - r) * q) + off; }
    const int nig = WGM * nN, gid = wgid / nig, fm = gid * WGM, gsz = (nM - fm) < WGM ? (nM - fm) : WGM;
    pm = fm + ((wgid % nig) % gsz); pn = (wgid % nig) / gsz;
}

typedef __bf16 bf16x2v __attribute__((ext_vector_type(2)));
typedef float f32x2v __attribute__((ext_vector_type(2)));
__device__ __forceinline__ unsigned cvt_pk_bf16(float lo, float hi) { const f32x2v v = {lo, hi}; return __builtin_bit_cast(unsigned, __builtin_convertvector(v, bf16x2v)); }

template <class Epi, class Sched, bool ALIGN_EPI, bool SP2>
__device__ __forceinline__ void gemm_phase(PG8_LAS unsigned char* lds, const Gemm g, const Sched& S, const Epi& E) {
    int tid_ = threadIdx.x; asm volatile("" : "+v"(tid_));
    const int tid = tid_, wid = __builtin_amdgcn_readfirstlane(tid >> 6), lane = tid & 63, wr = wid >> 2, wc = wid & 3, fr = lane & 15, fq = lane >> 4;
    unsigned voffA[2], voffB[2];
#pragma unroll
    for (int i = 0; i < 2; ++i) { int R, C; stage_rc(tid * 16 + i * 8192, R, C); const int Rb = Epi::PERM ? ((R & ~31) + perm32(R & 31)) : R;
        voffA[i] = (unsigned)(R * g.lda + C) * 2u; voffB[i] = (unsigned)(Rb * g.ldb + C) * 2u; }
    const size_t kstep = (size_t)(BK * 2);
    const size_t hstepA = (size_t)HALF * g.lda * 2, hstepB = (size_t)HALF * g.ldb * 2;
    const unsigned ldsw = (unsigned)wid * 1024u;
    const int aoff = lds_byte(wr * 64 + fr, fq * 8), boff = lds_byte(wc * 32 + fr, fq * 8);
#define PG8_SA(b, h) (((b) * 2 + (h)) * HTB)
#define PG8_SB(b, h) ((4 + (b) * 2 + (h)) * HTB)
#define PG8_STAGE(bufoff, gbase, voff) do { _Pragma("unroll") for (int _i = 0; _i < 2; ++_i) \
        __builtin_amdgcn_global_load_lds((const unsigned*)((const char*)(gbase) + (voff)[_i]), (PG8_LAS unsigned*)(lds + (bufoff) + ldsw + _i * 8192), 16, 0, 0); } while (0)
#define PG8_LDA(dst, b, h) do { _Pragma("unroll") for (int m = 0; m < 4; ++m) _Pragma("unroll") for (int k = 0; k < 2; ++k) dst[m][k] = *(const PG8_LAS bf16x8*)(lds + PG8_SA(b, h) + aoff + m * 2048 + k * 1024); } while (0)
#define PG8_LDB(dst, b, h) do { _Pragma("unroll") for (int n = 0; n < 2; ++n) _Pragma("unroll") for (int k = 0; k < 2; ++k) dst[n][k] = *(const PG8_LAS bf16x8*)(lds + PG8_SB(b, h) + boff + n * 2048 + k * 1024); } while (0)
#define PG8_MMA(ai, bj, At, Bt) do { __builtin_amdgcn_s_setprio(1); _Pragma("unroll") for (int m = 0; m < 4; ++m) _Pragma("unroll") for (int n = 0; n < 2; ++n) _Pragma("unroll") for (int k = 0; k < 2; ++k) \
        acc[ai][bj][m][n] = __builtin_amdgcn_mfma_f32_16x16x32_bf16(Bt[n][k], At[m][k], acc[ai][bj][m][n], 0, 0, 0); __builtin_amdgcn_s_setprio(0); } while (0)
#define PG8_WAIT_V(n) asm volatile("s_waitcnt vmcnt(" #n ")" ::: "memory")
#define PG8_WAIT_L(n) asm volatile("s_waitcnt lgkmcnt(" #n ")" ::: "memory")
#define PG8_BAR __builtin_amdgcn_s_barrier()
#define PG8_SCHED __builtin_amdgcn_sched_barrier(0)
    Unit cur, nxt; int ui = 0;
    if (!S.next(0, cur)) return;
    f32x4 acc[2][2][4][2];
#pragma unroll
    for (int a = 0; a < 2; ++a)
#pragma unroll
        for (int b = 0; b < 2; ++b)
#pragma unroll
            for (int m = 0; m < 4; ++m)
#pragma unroll
                for (int n = 0; n < 2; ++n) acc[a][b][m][n] = (f32x4){0.f, 0.f, 0.f, 0.f};
    bf16x8 At[4][2], B0[2][2], B1[2][2];
    const char* cA = (const char*)g.A + ((size_t)cur.pm * BM * g.lda + cur.k0) * 2; const char* cB = (const char*)g.Bt + ((size_t)cur.pn * BM * g.ldb + cur.k0) * 2;
    { const size_t o0 = (size_t)(cur.rot & (cur.nt - 1)) * kstep, o1 = (size_t)((cur.rot + 1) & (cur.nt - 1)) * kstep;
    if constexpr (SP2) {
        PG8_STAGE(PG8_SB(0, 0), cB + o0, voffB); PG8_STAGE(PG8_SB(0, 1), cB + hstepB + o0, voffB); PG8_STAGE(PG8_SA(0, 0), cA + o0, voffA); PG8_STAGE(PG8_SA(0, 1), cA + hstepA + o0, voffA);
        if (wr == 1) PG8_BAR;
        PG8_WAIT_V(2); PG8_BAR;
        PG8_STAGE(PG8_SB(1, 0), cB + o1, voffB); PG8_STAGE(PG8_SA(1, 0), cA + o1, voffA); PG8_STAGE(PG8_SB(1, 1), cB + hstepB + o1, voffB);
        PG8_WAIT_V(6); PG8_BAR;
    } else {
        PG8_STAGE(PG8_SB(0, 0), cB + o0, voffB); PG8_STAGE(PG8_SA(0, 0), cA + o0, voffA); PG8_STAGE(PG8_SB(0, 1), cB + hstepB + o0, voffB); PG8_STAGE(PG8_SA(0, 1), cA + hstepA + o0, voffA);
        if (wr == 1) PG8_BAR;
        PG8_WAIT_V(4); PG8_BAR;
        PG8_STAGE(PG8_SB(1, 0), cB + o1, voffB); PG8_STAGE(PG8_SA(1, 0), cA + o1, voffA); PG8_STAGE(PG8_SB(1, 1), cB + hstepB + o1, voffB);
        PG8_WAIT_V(6); PG8_BAR;
    } }
    for (;;) {
        const bool has_next = S.next(ui + 1, nxt);
        const char* nA = has_next ? (const char*)g.A + ((size_t)nxt.pm * BM * g.lda + nxt.k0) * 2 : cA; const char* nB = has_next ? (const char*)g.Bt + ((size_t)nxt.pn * BM * g.ldb + nxt.k0) * 2 : cB;
        const int nt = cur.nt, rot = cur.rot, msk = nt - 1;
        const size_t n0 = has_next ? (size_t)(nxt.rot & (nxt.nt - 1)) * kstep : (size_t)(rot & msk) * kstep, n1 = has_next ? (size_t)((nxt.rot + 1) & (nxt.nt - 1)) * kstep : (size_t)((rot + 1) & msk) * kstep;
        for (int t = 0; t < nt; t += 2) {
            if constexpr (Epi::HAS_MID) { if (t == Epi::MID0 || t == Epi::MID1) E.mid(acc, cur, t, wr, wc, fr, fq); }
            const bool last = (t == nt - 2);
            const size_t k1 = rot ? (size_t)((t + 1 + rot) & msk) * kstep : (size_t)(t + 1) * kstep, k2 = rot ? (size_t)((t + 2 + rot) & msk) * kstep : (size_t)(t + 2) * kstep, k3 = rot ? (size_t)((t + 3 + rot) & msk) * kstep : (size_t)(t + 3) * kstep;
            const char* a1 = cA + k1;
            const char* a2 = last ? nA + n0 : cA + k2; const char* b2 = last ? nB + n0 : cB + k2;
            const char* a3 = last ? nA + n1 : cA + k3; const char* b3 = last ? nB + n1 : cB + k3;
            if constexpr (SP2) {
            PG8_LDB(B0, 0, 0); PG8_LDB(B1, 0, 1); PG8_SCHED; PG8_LDA(At, 0, 0); PG8_STAGE(PG8_SA(1, 1), a1 + hstepA, voffA);
            PG8_WAIT_V(8); PG8_WAIT_L(0); PG8_BAR; PG8_MMA(0, 0, At, B0); PG8_MMA(0, 1, At, B1); PG8_BAR; PG8_SCHED;
            PG8_LDA(At, 0, 1); PG8_STAGE(PG8_SB(0, 0), b2, voffB); PG8_STAGE(PG8_SB(0, 1), b2 + hstepB, voffB); PG8_STAGE(PG8_SA(0, 0), a2, voffA);
            PG8_WAIT_V(8); PG8_WAIT_L(0); PG8_BAR; PG8_MMA(1, 0, At, B0); PG8_MMA(1, 1, At, B1); PG8_BAR; PG8_SCHED;
            PG8_LDB(B0, 1, 0); PG8_LDB(B1, 1, 1); PG8_SCHED; PG8_LDA(At, 1, 0); PG8_STAGE(PG8_SA(0, 1), a2 + hstepA, voffA);
            PG8_WAIT_V(8); PG8_WAIT_L(0); PG8_BAR; PG8_MMA(0, 0, At, B0); PG8_MMA(0, 1, At, B1); PG8_BAR; PG8_SCHED;
            PG8_LDA(At, 1, 1); PG8_STAGE(PG8_SB(1, 0), b3, voffB); PG8_STAGE(PG8_SB(1, 1), b3 + hstepB, voffB); PG8_STAGE(PG8_SA(1, 0), a3, voffA);
            PG8_WAIT_V(8); PG8_WAIT_L(0); PG8_BAR; PG8_MMA(1, 0, At, B0); PG8_MMA(1, 1, At, B1); PG8_BAR; PG8_SCHED;
            } else {
            PG8_LDB(B0, 0, 0); PG8_SCHED; PG8_LDA(At, 0, 0); PG8_STAGE(PG8_SA(1, 1), a1 + hstepA, voffA);
            PG8_WAIT_L(8); PG8_BAR; PG8_WAIT_L(0); PG8_MMA(0, 0, At, B0); PG8_BAR; PG8_SCHED;
            PG8_LDB(B1, 0, 1); PG8_STAGE(PG8_SB(0, 0), b2, voffB);
            PG8_BAR; PG8_WAIT_L(0); PG8_MMA(0, 1, At, B1); PG8_BAR;
            PG8_LDA(At, 0, 1); PG8_STAGE(PG8_SA(0, 0), a2, voffA);
            PG8_BAR; PG8_WAIT_L(0); PG8_MMA(1, 0, At, B0); PG8_BAR; PG8_SCHED;
            PG8_STAGE(PG8_SB(0, 1), b2 + hstepB, voffB);
            PG8_WAIT_V(6); PG8_BAR; PG8_MMA(1, 1, At, B1); PG8_BAR;
            PG8_LDB(B0, 1, 0); PG8_SCHED; PG8_LDA(At, 1, 0); PG8_STAGE(PG8_SA(0, 1), a2 + hstepA, voffA);
            PG8_WAIT_L(8); PG8_BAR; PG8_WAIT_L(0); PG8_MMA(0, 0, At, B0); PG8_BAR; PG8_SCHED;
            PG8_LDB(B1, 1, 1); PG8_STAGE(PG8_SB(1, 0), b3, voffB);
            PG8_BAR; PG8_WAIT_L(0); PG8_MMA(0, 1, At, B1); PG8_BAR;
            PG8_LDA(At, 1, 1); PG8_STAGE(PG8_SA(1, 0), a3, voffA);
            PG8_BAR; PG8_WAIT_L(0); PG8_MMA(1, 0, At, B0); PG8_BAR; PG8_SCHED;
            PG8_STAGE(PG8_SB(1, 1), b3 + hstepB, voffB);
            PG8_WAIT_V(6); PG8_BAR; PG8_MMA(1, 1, At, B1); PG8_BAR;
            }
        }
        if constexpr (ALIGN_EPI) { if (wr == 0) PG8_BAR; }
        E(acc, cur, wr, wc, fr, fq);
        if (!has_next) break;
#pragma unroll
        for (int a = 0; a < 2; ++a)
#pragma unroll
            for (int b = 0; b < 2; ++b)
#pragma unroll
                for (int m = 0; m < 4; ++m)
#pragma unroll
                    for (int n = 0; n < 2; ++n) acc[a][b][m][n] = (f32x4){0.f, 0.f, 0.f, 0.f};
        cur = nxt; cA = nA; cB = nB; ++ui;
        if constexpr (ALIGN_EPI) { if (wr == 1) PG8_BAR; }
    }
    PG8_WAIT_V(0);
    if constexpr (!ALIGN_EPI) { if (wr == 0) PG8_BAR; }
    PG8_BAR;
#undef PG8_SA
#undef PG8_SB
#undef PG8_STAGE
#undef PG8_LDA
#undef PG8_LDB
#undef PG8_MMA
#undef PG8_WAIT_V
#undef PG8_WAIT_L
#undef PG8_BAR
#undef PG8_SCHED
}
}

constexpr int NWAVES = 8;
constexpr int T = 32768, TP = 16384;
constexpr int D = 4096, NIN = 24096, DEPTH = 2;
constexpr int HP = 24064;
constexpr int NBROWS = 24320;
constexpr int C_AQ = 0, C_AK = 768, C_AV = 1536, C_AG = 3072, C_BU = 4608, C_BV = 5632, C_BG = 6656, C_CQ = 7680, C_CK = 9216, C_CV = 9728, C_CG = 10240, C_GM = 11776, C_LR = 24064;
constexpr int O_A = 0, O_B = 1536, O_C = 2560;
constexpr int N_PHASES = 17;
constexpr int N_LAUNCHES = MK_N_LAUNCHES;

constexpr size_t MiB = 1u << 20;
constexpr size_t WS_CTL = 0, CTL_ZERO_BYTES = 1 * MiB;
constexpr size_t WS_ROPE = 1 * MiB;
constexpr size_t WS_WIN = 3 * MiB, WIN_BYTES = (size_t)NBROWS * D * 2;
constexpr size_t WS_WBR = WS_WIN + 2 * 190 * MiB, WSQ_BYTES = (size_t)D * D * 2;
constexpr size_t WS_WOUT = WS_WBR + 64 * MiB;
constexpr size_t WS_XN = WS_WOUT + 64 * MiB;
constexpr size_t WS_H = WS_XN + 256 * MiB;
constexpr size_t WS_ST = WS_H + 1504 * MiB;
constexpr size_t WS_MG = WS_ST + 384 * MiB;
constexpr size_t WS_LR = WS_MG + 256 * MiB;
constexpr size_t WS_DECC = WS_LR + 8 * MiB;
constexpr size_t WS_END = WS_DECC + 4 * MiB;
static_assert(WIN_BYTES <= 190 * MiB && (size_t)T * HP * 2 <= 1504 * MiB, "ws map");
constexpr int CW_TMO = 0, CW_CODE = 1;
constexpr int CW_BAR = 4096;

constexpr int RING_OFF = 0, RING_BYTES = 131072;
constexpr int LDSCTL_OFF = RING_BYTES, MISC_OFF = LDSCTL_OFF + 320;
constexpr int LDS_BYTES = 147456;

#define GAS __attribute__((address_space(1)))
#define LAS __attribute__((address_space(3)))
typedef unsigned short bf16;
typedef unsigned v4u __attribute__((ext_vector_type(4)));
typedef unsigned v2u __attribute__((ext_vector_type(2)));
typedef float f32x4 __attribute__((ext_vector_type(4)));
typedef GAS unsigned gu32;
#define RLX_AGENT __ATOMIC_RELAXED, __HIP_MEMORY_SCOPE_AGENT
#define LDS_WAIT() asm volatile("s_waitcnt lgkmcnt(0)" ::: "memory")
#define VM_WAIT() asm volatile("s_waitcnt vmcnt(0)" ::: "memory")
__device__ __forceinline__ unsigned f2bf(float f) { unsigned u = __builtin_bit_cast(unsigned, f); return (u + 0x7fffu + ((u >> 16) & 1u)) >> 16; }
__device__ __forceinline__ unsigned pk2(float lo, float hi) { return pg8::cvt_pk_bf16(lo, hi); }
__device__ __forceinline__ float bflo(unsigned w) { return __uint_as_float(w << 16); }
__device__ __forceinline__ float bfhi(unsigned w) { return __uint_as_float(w & 0xffff0000u); }
__device__ __forceinline__ float bf1(bf16 v) { return __uint_as_float((unsigned)v << 16); }
__device__ __forceinline__ void unpack8(const v4u w, float* x) { x[0] = bflo(w.x); x[1] = bfhi(w.x); x[2] = bflo(w.y); x[3] = bfhi(w.y); x[4] = bflo(w.z); x[5] = bfhi(w.z); x[6] = bflo(w.w); x[7] = bfhi(w.w); }
__device__ __forceinline__ float sigm(float x) { return __builtin_amdgcn_rcpf(1.0f + __builtin_amdgcn_exp2f(-1.44269504089f * x)); }

#define XB_TMO      128
#define XB_XCNT(j)  (256  + 64 * (j))
#define XB_XSUB(j)  (1280 + 64 * (j))
#define XB_XGEN(j)  (2304 + 64 * (j))
#define XB_TOP      3328
#define XB_TOPGEN   3392
#define XCD_BAR_WORDS 3456
#define XB_SPIN_CAP (1u << 24)
__device__ __forceinline__ unsigned xb_ld(unsigned* p)              { return __hip_atomic_load(p, __ATOMIC_RELAXED, __HIP_MEMORY_SCOPE_AGENT); }
__device__ __forceinline__ unsigned xb_add(unsigned* p, unsigned v) { return __hip_atomic_fetch_add(p, v, __ATOMIC_RELAXED, __HIP_MEMORY_SCOPE_AGENT); }
__device__ __forceinline__ unsigned xb_xcc_id() { return (unsigned)__builtin_amdgcn_s_getreg((3 << 11) | 20) & 0xFu; }
#define XB_SPIN(cond, bar) do { unsigned _sp = 0; while (cond) { __builtin_amdgcn_s_sleep(1); \
    if ((++_sp & 255u) == 0u) { if (xb_ld(&(bar)[XB_TMO])) break; if (_sp > XB_SPIN_CAP) { atomicAdd(&(bar)[XB_TMO], 1u); break; } } } } while (0)
struct XcdBarrier { unsigned* bar; unsigned x; volatile LAS unsigned* st; };
__device__ __forceinline__ XcdBarrier xcd_barrier_post(unsigned* bar, volatile LAS unsigned* st) {
    XcdBarrier b; b.bar = bar; b.x = xb_xcc_id(); b.st = st;
    if (threadIdx.x == 0) (void)xb_add(&bar[XB_XCNT(b.x)], 1u);
    return b;
}
__device__ __forceinline__ void xcd_barrier_complete(unsigned* bar, unsigned x, unsigned& nloc, unsigned& nx) {
    const unsigned G = gridDim.x * gridDim.y * gridDim.z;
    unsigned sum, cnt, mine, sp = 0u;
    for (;;) {
        sum = 0u; cnt = 0u; mine = 0u;
#pragma unroll
        for (unsigned j = 0; j < 16; ++j) { const unsigned c = xb_ld(&bar[XB_XCNT(j)]); sum += c; cnt += (c > 0u) ? 1u : 0u; mine = (j == x) ? c : mine; }
        if (sum == G) break;
        __builtin_amdgcn_s_sleep(1);
        if ((++sp & 255u) == 0u) { if (xb_ld(&bar[XB_TMO])) break; if (sp > XB_SPIN_CAP) { atomicAdd(&bar[XB_TMO], 1u); break; } }
    }
    nloc = mine > 0u ? mine : 1u; nx = cnt > 0u ? cnt : 1u;
}
__device__ __forceinline__ void xcd_barrier(const XcdBarrier& b) {
    asm volatile("s_waitcnt vmcnt(0)" ::: "memory");
    __syncthreads();
    if (threadIdx.x == 0) {
        unsigned* bar = b.bar;
        __builtin_amdgcn_s_waitcnt(0);
        unsigned nloc = b.st[0], nx = b.st[1];
        if (nloc == 0u) { xcd_barrier_complete(bar, b.x, nloc, nx); b.st[0] = nloc; b.st[1] = nx; }
        const unsigned old = xb_add(&bar[XB_XSUB(b.x)], 1u);
        const unsigned gen = old / nloc;
        if (old + 1u == (gen + 1u) * nloc) {
            __builtin_amdgcn_fence(__ATOMIC_RELEASE, "agent");
            asm volatile("s_waitcnt vmcnt(0)" ::: "memory");
            const unsigned og = xb_add(&bar[XB_TOP], 1u);
            const unsigned tg = og / nx;
            if (og + 1u == (tg + 1u) * nx) xb_add(&bar[XB_TOPGEN], 1u);
            else XB_SPIN(xb_ld(&bar[XB_TOPGEN]) == tg, bar);
            __builtin_amdgcn_fence(__ATOMIC_ACQUIRE, "agent");
            xb_add(&bar[XB_XGEN(b.x)], 1u);
            asm volatile("s_waitcnt vmcnt(0)" ::: "memory");
        } else {
            XB_SPIN(xb_ld(&bar[XB_XGEN(b.x)]) == gen, bar);
            __builtin_amdgcn_fence(__ATOMIC_ACQUIRE, "agent");
            asm volatile("s_waitcnt vmcnt(0)" ::: "memory");
        }
    }
    __syncthreads();
}

struct Args { const float* in[17]; float* out; unsigned char* ws; int ph_lo, ph_hi; };
struct Frame {
    LAS unsigned char* lds;
    int vcu, G;
};
#define PHASE_IDS() int tid_ = threadIdx.x; asm volatile("" : "+v"(tid_)); const int tid = tid_, lane = tid & 63, wave = __builtin_amdgcn_readfirstlane(tid >> 6); (void)tid; (void)lane; (void)wave
__device__ __forceinline__ float wave_sum(float v) {
#pragma unroll
    for (int o = 1; o < 64; o <<= 1) v += __shfl_xor(v, o);
    return v;
}
__device__ __forceinline__ float wave_max(float v) {
#pragma unroll
    for (int o = 1; o < 64; o <<= 1) v = fmaxf(v, __shfl_xor(v, o));
    return v;
}

struct CvtItem { const float* W; const float* kgain; bf16* WT; int Nsrc, nsrc0, ndst0, k0; };
__device__ __forceinline__ CvtItem cvt_decode(const Args& a, int it) {
    constexpr int I_IN = 64 * (NBROWS / 32), I_SQ = 64 * (D / 32), I_L = I_IN + 2 * I_SQ;
    CvtItem c; const int l = it / I_L; int r = it - l * I_L;
    if (r < I_IN) { const int nb = r % (NBROWS / 32), kb = r / (NBROWS / 32), nm = nb * 32;
        c.W = a.in[3] + (size_t)l * D * NIN; c.Nsrc = NIN; c.nsrc0 = nm < 3072 ? nm : (nm < C_LR ? nm + 32 : (nm < C_LR + 32 ? 3072 + (nm - C_LR) : -1));
        c.kgain = a.in[2] + l * D; c.WT = (bf16*)(a.ws + WS_WIN + l * (190 * MiB)); c.ndst0 = nm; c.k0 = kb * 64; return c; }
    r -= I_IN; const bool br = r < I_SQ; if (!br) r -= I_SQ;
    const int nb = r % (D / 32), kb = r / (D / 32);
    c.W = a.in[br ? 15 : 16] + (size_t)l * D * D; c.Nsrc = D; c.nsrc0 = nb * 32; c.kgain = nullptr; c.WT = (bf16*)(a.ws + (br ? WS_WBR : WS_WOUT) + l * (32 * MiB)); c.ndst0 = nb * 32; c.k0 = kb * 64; return c;
}
__device__ __forceinline__ void cvt_load(const CvtItem& c, int lane, f32x4 (&v)[8]) {
    const int kr = lane >> 3, nq = (lane & 7) * 4;
#pragma unroll
    for (int i = 0; i < 8; ++i) { v[i] = (f32x4){0.f, 0.f, 0.f, 0.f};
        if (c.nsrc0 >= 0) { v[i] = *(const f32x4*)(c.W + (size_t)(c.k0 + kr + 8 * i) * c.Nsrc + c.nsrc0 + nq); if (c.kgain) v[i] = v[i] * c.kgain[c.k0 + kr + 8 * i]; } }
}
__device__ __forceinline__ void cvt_store(const CvtItem& c, int lane, const f32x4 (&v)[8], LAS float* scr) {
    const int kr = lane >> 3, nq = (lane & 7) * 4;
#pragma unroll
    for (int i = 0; i < 8; ++i) { LAS float* d = scr + (kr + 8 * i) * 33 + nq; d[0] = v[i].x; d[1] = v[i].y; d[2] = v[i].z; d[3] = v[i].w; }
    LDS_WAIT(); asm volatile("" ::: "memory");
    const int cc = lane & 7;
#pragma unroll
    for (int j = 0; j < 4; ++j) { const int n = (lane >> 3) + 8 * j; const LAS float* s = scr + (8 * cc) * 33 + n;
        v4u o; o.x = pk2(s[0 * 33], s[1 * 33]); o.y = pk2(s[2 * 33], s[3 * 33]); o.z = pk2(s[4 * 33], s[5 * 33]); o.w = pk2(s[6 * 33], s[7 * 33]);
        *(GAS v4u*)(c.WT + (size_t)(c.ndst0 + n) * D + c.k0 + 8 * cc) = o; }
    LDS_WAIT(); asm volatile("" ::: "memory");
}
__device__ __forceinline__ void phase_convert(Frame& F, const Args& a) {
    PHASE_IDS();
    LAS float* scr = (LAS float*)(F.lds + RING_OFF + wave * 16384);
    const int gw = F.vcu * NWAVES + wave, NGW = F.G * NWAVES;
    constexpr int I_IN = 64 * (NBROWS / 32), I_SQ = 64 * (D / 32), I_L = I_IN + 2 * I_SQ, NIT = DEPTH * I_L;
    if (gw < NIT) {
        CvtItem cur = cvt_decode(a, gw); f32x4 v[8]; cvt_load(cur, lane, v);
        for (int it = gw; it < NIT; it += NGW) {
            const int itn = it + NGW; CvtItem nxt = cur; f32x4 vn[8];
            if (itn < NIT) { nxt = cvt_decode(a, itn); cvt_load(nxt, lane, vn); }
            cvt_store(cur, lane, v, scr);
            cur = nxt;
#pragma unroll
            for (int i = 0; i < 8; ++i) v[i] = vn[i];
        }
    }
    float2* rt = (float2*)(a.ws + WS_ROPE);
    for (int e = (F.vcu * NWAVES + wave) * 64 + lane; e < 16384 * 16; e += F.G * NWAVES * 64) {
        const int pos = e >> 4, i = e & 15;
        const float inv = (float)pow(500000.0, -(double)(2 * i) / 32.0);
        const float ang = (float)pos * inv;
        double sn, cs; sincos((double)ang, &sn, &cs);
        rt[e] = make_float2((float)cs, (float)sn);
    }
}

__device__ __forceinline__ void phase_rmsnorm(Frame& F, const Args& a, int layer) {
    PHASE_IDS();
    const int gw = F.vcu * NWAVES + wave, NGW = F.G * NWAVES;
    bf16* XN = (bf16*)(a.ws + WS_XN);
    for (int m = gw; m < T; m += NGW) {
        const float* xrow = layer == 0 ? (m < TP ? a.in[0] + (size_t)m * D : a.in[1] + (size_t)(m - TP) * D) : a.out + (size_t)m * D;
        const GAS f32x4* xr = (const GAS f32x4*)xrow + lane;
        f32x4 v[16]; float s = 0.f;
#pragma unroll
        for (int j = 0; j < 16; ++j) { v[j] = xr[64 * j]; s += (v[j].x * v[j].x + v[j].y * v[j].y) + (v[j].z * v[j].z + v[j].w * v[j].w); }
        const float rstd = 1.0f / sqrtf(wave_sum(s) * (1.f / D) + 1e-6f);
        GAS v2u* o8 = (GAS v2u*)(XN + (size_t)m * D) + lane;
#pragma unroll
        for (int j = 0; j < 16; ++j) { v2u w; w.x = pk2(v[j].x * rstd, v[j].y * rstd); w.y = pk2(v[j].z * rstd, v[j].w * rstd); o8[64 * j] = w; }
    }
}

struct Sched1 {
    int c, G;
    __device__ __forceinline__ bool next(int i, pg8::Unit& u) const {
        const bool hf = (c & 1) && G == 256;
        u.rot = 0;
        if (hf) { if (i == 0) { u.pm = c >> 1; u.pn = 94; u.k0 = 2048; u.nt = 32; u.tag = 1; return true; } i -= 1; }
        long L = (long)i * G + c;
        if (L < 128 * 94) { pg8::static_tile((int)L, 128, 94, u.pm, u.pn); u.k0 = 0; u.nt = 64; u.tag = 0; u.rot = KROT * (c & 7); return true; }
        if (hf) return false;
        L -= 128 * 94;
        if (G == 256) { if (L < 256 && !(L & 1)) { u.pm = (int)(L >> 1); u.pn = 94; u.k0 = 0; u.nt = 32; u.tag = 0; return true; } return false; }
        if (L < 256) { u.pm = (int)(L >> 1); u.pn = 94; u.k0 = (int)(L & 1) * 2048; u.nt = 32; u.tag = (int)(L & 1); return true; }
        return false;
    }
};
struct Sched2 {
    int c, G;
    __device__ __forceinline__ bool next(int i, pg8::Unit& u) const {
        const long L = (long)i * G + c; if (L >= 128 * 16) return false;
        pg8::static_tile((int)L, 128, 16, u.pm, u.pn); u.k0 = 0; u.nt = 64; u.tag = 0; u.rot = 0; return true;
    }
};
struct Sched3 {
    int c, G;
    __device__ __forceinline__ bool next(int i, pg8::Unit& u) const {
        const long L = (long)i * G + c; if (L >= 128 * 16) return false;
        pg8::static_tile((int)L, 128, 16, u.pm, u.pn); u.k0 = 0; u.nt = 64; u.tag = 0; u.rot = KROT * (c & 7); return true;
    }
};
struct Epi1 {
    static constexpr bool PERM = true, HAS_MID = false; static constexpr int MID0 = -1, MID1 = -1;
    bf16* H; float* LR; const float* gbias;
    __device__ __forceinline__ void operator()(const f32x4 (&acc)[2][2][4][2], const pg8::Unit& u, int wr, int wc, int fr, int fq) const {
        using namespace pg8;
        const int row0 = u.pm * BM + wr * 64 + fr;
        if (u.pn == 94) {
            if (wc == 0) { float* base = LR + (size_t)u.tag * T * 32 + 8 * fq;
#pragma unroll
                for (int ai = 0; ai < 2; ++ai)
#pragma unroll
                    for (int m = 0; m < 4; ++m) { float* rp = base + (size_t)(row0 + ai * HALF + m * 16) * 32;
                        *(f32x4*)rp = acc[ai][0][m][0]; *(f32x4*)(rp + 4) = acc[ai][0][m][1]; } }
            return;
        }
        const int pn = u.pn;
        const int act = pn < 12 ? 0 : (pn < 18 ? 1 : (pn < 26 ? 2 : (pn < 30 ? 1 : (pn < 40 ? 0 : (pn < 46 ? 1 : 3)))));
        const int col0 = pn * BM + wc * 32 + 8 * fq;
        if (act == 0) {
#pragma unroll
            for (int ai = 0; ai < 2; ++ai)
#pragma unroll
                for (int m = 0; m < 4; ++m) { bf16* rowp = H + (size_t)(row0 + ai * HALF + m * 16) * HP + col0;
#pragma unroll
                    for (int bj = 0; bj < 2; ++bj) { const f32x4 v0 = acc[ai][bj][m][0], v1 = acc[ai][bj][m][1];
                        u32x4 w; w.x = cvt_pk_bf16(v0[0], v0[1]); w.y = cvt_pk_bf16(v0[2], v0[3]); w.z = cvt_pk_bf16(v1[0], v1[1]); w.w = cvt_pk_bf16(v1[2], v1[3]);
                        __builtin_nontemporal_store(w, (u32x4*)(rowp + bj * HALF)); } }
            return;
        }
        if (act == 3) {
            f32x4 bv[2][2];
#pragma unroll
            for (int bj = 0; bj < 2; ++bj)
#pragma unroll
                for (int n = 0; n < 2; ++n) bv[bj][n] = *(const f32x4*)(gbias + (pn - 46) * BM + wc * 32 + 8 * fq + bj * HALF + 4 * n);
#pragma unroll
            for (int ai = 0; ai < 2; ++ai)
#pragma unroll
                for (int m = 0; m < 4; ++m) { bf16* rowp = H + (size_t)(row0 + ai * HALF + m * 16) * HP + col0;
#pragma unroll
                    for (int bj = 0; bj < 2; ++bj) { float x[8];
#pragma unroll
                        for (int j = 0; j < 4; ++j) { x[j] = sigm(acc[ai][bj][m][0][j] + bv[bj][0][j]); x[4 + j] = sigm(acc[ai][bj][m][1][j] + bv[bj][1][j]); }
                        u32x4 w; w.x = cvt_pk_bf16(x[0], x[1]); w.y = cvt_pk_bf16(x[2], x[3]); w.z = cvt_pk_bf16(x[4], x[5]); w.w = cvt_pk_bf16(x[6], x[7]);
                        __builtin_nontemporal_store(w, (u32x4*)(rowp + bj * HALF)); } }
        } else if (act == 1) {
#pragma unroll
            for (int ai = 0; ai < 2; ++ai)
#pragma unroll
                for (int m = 0; m < 4; ++m) { bf16* rowp = H + (size_t)(row0 + ai * HALF + m * 16) * HP + col0;
#pragma unroll
                    for (int bj = 0; bj < 2; ++bj) { float x[8];
#pragma unroll
                        for (int j = 0; j < 4; ++j) { const float a0 = acc[ai][bj][m][0][j], a1 = acc[ai][bj][m][1][j]; x[j] = a0 * sigm(a0); x[4 + j] = a1 * sigm(a1); }
                        u32x4 w; w.x = cvt_pk_bf16(x[0], x[1]); w.y = cvt_pk_bf16(x[2], x[3]); w.z = cvt_pk_bf16(x[4], x[5]); w.w = cvt_pk_bf16(x[6], x[7]);
                        __builtin_nontemporal_store(w, (u32x4*)(rowp + bj * HALF)); } }
        } else {
#pragma unroll
            for (int ai = 0; ai < 2; ++ai)
#pragma unroll
                for (int m = 0; m < 4; ++m) { bf16* rowp = H + (size_t)(row0 + ai * HALF + m * 16) * HP + col0;
#pragma unroll
                    for (int bj = 0; bj < 2; ++bj) { float x[8];
#pragma unroll
                        for (int j = 0; j < 4; ++j) { const float a0 = acc[ai][bj][m][0][j], a1 = acc[ai][bj][m][1][j];
                            x[j] = a0 * sigm(1.5957691216f * (a0 + 0.044715f * a0 * a0 * a0)); x[4 + j] = a1 * sigm(1.5957691216f * (a1 + 0.044715f * a1 * a1 * a1)); }
                        u32x4 w; w.x = cvt_pk_bf16(x[0], x[1]); w.y = cvt_pk_bf16(x[2], x[3]); w.z = cvt_pk_bf16(x[4], x[5]); w.w = cvt_pk_bf16(x[6], x[7]);
                        __builtin_nontemporal_store(w, (u32x4*)(rowp + bj * HALF)); } }
        }
    }
};
struct Epi2 {
    static constexpr bool PERM = true, HAS_MID = true; static constexpr int MID0 = 24, MID1 = 40;
    const bf16* H; bf16* MG;
    __device__ __forceinline__ void mid(f32x4 (&acc)[2][2][4][2], const pg8::Unit& u, int t, int wr, int wc, int fr, int fq) const {
        using namespace pg8;
        asm volatile("" : "+v"(fr), "+v"(fq));
        const int row0 = u.pm * BM + wr * 64 + fr, col0 = u.pn * BM + wc * 32 + 8 * fq, b = t == MID0 ? 0 : 1;
#pragma unroll
        for (int ai = 0; ai < 2; ++ai)
#pragma unroll
            for (int m = 0; m < 4; ++m) { const bf16* gp = H + (size_t)(row0 + ai * HALF + m * 16) * HP + C_GM + b * D + col0;
#pragma unroll
                for (int bj = 0; bj < 2; ++bj) { const u32x4 ga = *(const u32x4*)(gp + bj * HALF), gb = *(const u32x4*)(gp + D + bj * HALF);
                    float xa[8], xb[8]; unpack8(ga, xa); unpack8(gb, xb);
#pragma unroll
                    for (int j = 0; j < 4; ++j) { acc[ai][bj][m][0][j] *= xa[j] * __builtin_amdgcn_rcpf(xb[j]); acc[ai][bj][m][1][j] *= xa[4 + j] * __builtin_amdgcn_rcpf(xb[4 + j]); } } }
    }
    __device__ __forceinline__ void operator()(const f32x4 (&acc)[2][2][4][2], const pg8::Unit& u, int wr, int wc, int fr, int fq) const {
        using namespace pg8;
        const int row0 = u.pm * BM + wr * 64 + fr, col0 = u.pn * BM + wc * 32 + 8 * fq;
#pragma unroll
        for (int ai = 0; ai < 2; ++ai)
#pragma unroll
            for (int m = 0; m < 4; ++m) { const size_t row = (size_t)(row0 + ai * HALF + m * 16);
                const bf16* gp = H + row * HP + C_GM + 2 * D + col0; bf16* mp = MG + row * D + col0;
#pragma unroll
                for (int bj = 0; bj < 2; ++bj) { const u32x4 gw = *(const u32x4*)(gp + bj * HALF);
                    float g[8]; unpack8(gw, g);
                    u32x4 w; w.x = cvt_pk_bf16(acc[ai][bj][m][0][0] * g[0], acc[ai][bj][m][0][1] * g[1]); w.y = cvt_pk_bf16(acc[ai][bj][m][0][2] * g[2], acc[ai][bj][m][0][3] * g[3]);
                    w.z = cvt_pk_bf16(acc[ai][bj][m][1][0] * g[4], acc[ai][bj][m][1][1] * g[5]); w.w = cvt_pk_bf16(acc[ai][bj][m][1][2] * g[6], acc[ai][bj][m][1][3] * g[7]);
                    *(u32x4*)(mp + bj * HALF) = w; } }
    }
};
struct Epi3 {
    static constexpr bool PERM = false, HAS_MID = false; static constexpr int MID0 = -1, MID1 = -1;
    const float* xp; const float* xs; float* out; int layer;
    __device__ __forceinline__ void operator()(const f32x4 (&acc)[2][2][4][2], const pg8::Unit& u, int wr, int wc, int fr, int fq) const {
        using namespace pg8;
        const int row0 = u.pm * BM + wr * 64 + fr, col0 = u.pn * BM + wc * 32 + 4 * fq;
#pragma unroll
        for (int ai = 0; ai < 2; ++ai)
#pragma unroll
            for (int m = 0; m < 4; ++m) { const int row = row0 + ai * HALF + m * 16;
                const float* xr = (layer == 0 ? (row < TP ? xp + (size_t)row * D : xs + (size_t)(row - TP) * D) : out + (size_t)row * D) + col0;
                float* op = out + (size_t)row * D + col0;
#pragma unroll
                for (int bj = 0; bj < 2; ++bj)
#pragma unroll
                    for (int n = 0; n < 2; ++n) { const f32x4 xv = *(const f32x4*)(xr + bj * HALF + n * 16); __builtin_nontemporal_store(xv + acc[ai][bj][m][n], (f32x4*)(op + bj * HALF + n * 16)); } }
    }
};

__device__ __forceinline__ void phase_prep(Frame& F, const Args& a, int layer) {
    PHASE_IDS();
    const int gw = F.vcu * NWAVES + wave, NGW = F.G * NWAVES;
    bf16* H = (bf16*)(a.ws + WS_H);
    const float2* rt = (const float2*)(a.ws + WS_ROPE);
    const float* qg = a.in[11] + layer * 128; const float* kg = a.in[12] + layer * 128;
#if !(MFMA_ATT && ATT_FUSED_NORM)
    {
        const int li = lane & 15;
        float qgv[8], kgv[8];
#pragma unroll
        for (int i = 0; i < 8; ++i) { qgv[i] = qg[8 * li + i]; kgv[i] = kg[8 * li + i]; }
        v4u w[4], wn[4];
        if (gw < T) { const v4u* p = (const v4u*)(H + (size_t)gw * HP + C_CQ) + lane;
#pragma unroll
            for (int j = 0; j < 4; ++j) w[j] = p[64 * j]; }
        for (int row = gw; row < T; row += NGW) {
            const int rn = row + NGW;
            if (rn < T) { const v4u* p = (const v4u*)(H + (size_t)rn * HP + C_CQ) + lane;
#pragma unroll
                for (int j = 0; j < 4; ++j) wn[j] = p[64 * j]; }
            const int pos = row < TP ? (row & 2047) : row - TP;
            float cs[8], sn[8];
            if (li < 4) { const f32x4* r4 = (const f32x4*)(rt + pos * 16 + 8 * (li & 1));
#pragma unroll
                for (int i = 0; i < 4; ++i) { const f32x4 t4 = r4[i]; cs[2 * i] = t4.x; sn[2 * i] = t4.y; cs[2 * i + 1] = t4.z; sn[2 * i + 1] = t4.w; } }
            v4u* po = (v4u*)(H + (size_t)row * HP + C_CQ) + lane;
#pragma unroll
            for (int j = 0; j < 4; ++j) { float x[8]; unpack8(w[j], x);
                float ss = 0.f;
#pragma unroll
                for (int i = 0; i < 8; ++i) ss += x[i] * x[i];
                ss += __shfl_xor(ss, 1); ss += __shfl_xor(ss, 2); ss += __shfl_xor(ss, 4); ss += __shfl_xor(ss, 8);
                const float rstd = 1.0f / sqrtf(ss * (1.f / 128.f) + 1e-6f);
                const bool isq = j < 3;
#pragma unroll
                for (int i = 0; i < 8; ++i) x[i] = x[i] * rstd * (isq ? qgv[i] : kgv[i]);
                float pv[8];
#pragma unroll
                for (int i = 0; i < 8; ++i) pv[i] = __shfl_xor(x[i], 2);
                if (li < 4) {
#pragma unroll
                    for (int i = 0; i < 8; ++i) x[i] = li < 2 ? x[i] * cs[i] - pv[i] * sn[i] : x[i] * cs[i] + pv[i] * sn[i]; }
                if (isq) {
#pragma unroll
                    for (int i = 0; i < 8; ++i) x[i] *= 0.08838834764831845f; }
                v4u o; o.x = pk2(x[0], x[1]); o.y = pk2(x[2], x[3]); o.z = pk2(x[4], x[5]); o.w = pk2(x[6], x[7]);
                po[64 * j] = o; }
#pragma unroll
            for (int j = 0; j < 4; ++j) w[j] = wn[j];
        }
    }
#endif
#if !MFMA_SGU
    const float* lg = a.in[7] + layer * 1024; const float* lb = a.in[8] + layer * 1024;
    for (int row = gw; row < T; row += NGW) {
        v4u* p = (v4u*)(H + (size_t)row * HP + C_BV) + lane;
        v4u w0 = p[0], w1 = p[64]; float x[16];
        x[0] = bflo(w0.x); x[1] = bfhi(w0.x); x[2] = bflo(w0.y); x[3] = bfhi(w0.y); x[4] = bflo(w0.z); x[5] = bfhi(w0.z); x[6] = bflo(w0.w); x[7] = bfhi(w0.w);
        x[8] = bflo(w1.x); x[9] = bfhi(w1.x); x[10] = bflo(w1.y); x[11] = bfhi(w1.y); x[12] = bflo(w1.z); x[13] = bfhi(w1.z); x[14] = bflo(w1.w); x[15] = bfhi(w1.w);
        float s = 0.f;
#pragma unroll
        for (int j = 0; j < 16; ++j) s += x[j];
        const float mean = wave_sum(s) * (1.f / 1024.f); float q = 0.f;
#pragma unroll
        for (int j = 0; j < 16; ++j) { x[j] -= mean; q += x[j] * x[j]; }
        const float rstd = 1.0f / sqrtf(wave_sum(q) * (1.f / 1024.f) + 1e-5f);
#pragma unroll
        for (int j = 0; j < 16; ++j) { const int c = (j < 8 ? 8 * lane + j : 512 + 8 * lane + (j - 8)); x[j] = x[j] * rstd * lg[c] + lb[c]; }
        w0.x = pk2(x[0], x[1]); w0.y = pk2(x[2], x[3]); w0.z = pk2(x[4], x[5]); w0.w = pk2(x[6], x[7]);
        w1.x = pk2(x[8], x[9]); w1.y = pk2(x[10], x[11]); w1.z = pk2(x[12], x[13]); w1.w = pk2(x[14], x[15]);
        p[0] = w0; p[64] = w1;
    }
#endif
#if MFMA_GLA
    {
        const float* up = a.in[4] + (size_t)layer * 2 * 16 * 768; const float* gb = a.in[5] + layer * 2 * 768;
        const float* LR0 = (const float*)(a.ws + WS_LR); const float* LR1 = LR0 + (size_t)T * 32;
        float* Bc = (float*)(a.ws + WS_MG);
        LAS float* lrs = (LAS float*)(F.lds + RING_OFF);
        for (int rep8 = 0; rep8 < ((DUP_MASK & 8) ? (F.G > 100 ? 2 : 1) : 1); ++rep8)
        for (int chunk = blockIdx.x; chunk < 512; chunk += F.G) {
            __syncthreads();
            { const size_t o = (size_t)chunk * 2048 + tid * 4; const f32x4 x0 = *(const f32x4*)(LR0 + o), x1 = *(const f32x4*)(LR1 + o); *(LAS f32x4*)(lrs + tid * 4) = x0 + x1; }
            __syncthreads();
#pragma unroll 1
            for (int rr = 0; rr < 3; ++rr) { const int r = tid + 512 * rr, dir = r >= 768 ? 1 : 0, k = r - dir * 768;
                float upv[16];
#pragma unroll
                for (int j = 0; j < 16; ++j) upv[j] = up[(dir * 16 + j) * 768 + k];
                const float bias = gb[dir * 768 + k]; float b = 0.f;
#pragma unroll 4
                for (int i = 0; i < 64; ++i) { const int ri = dir == 0 ? i : 63 - i; const LAS f32x4* l4 = (const LAS f32x4*)(lrs + ri * 32 + dir * 16);
                    float z = bias;
#pragma unroll
                    for (int j = 0; j < 4; ++j) { const f32x4 x = l4[j]; z += x.x * upv[4 * j] + x.y * upv[4 * j + 1] + x.z * upv[4 * j + 2] + x.w * upv[4 * j + 3]; }
                    const float ls = fminf(z, 0.f) - __logf(1.0f + __expf(-fabsf(z)));
                    b += ls * (1.f / 16.f); Bc[((size_t)chunk * 64 + ri) * 1536 + r] = b; }
            }
        }
    }
#endif
#if !MFMA_GLA
    const float* up = a.in[4] + (size_t)layer * 2 * 16 * 768; const float* gb = a.in[5] + layer * 2 * 768;
    const float* LR0 = (const float*)(a.ws + WS_LR); const float* LR1 = LR0 + (size_t)T * 32;
    float* DEC = (float*)(a.ws + WS_MG);
    for (size_t e = (size_t)(F.vcu * NWAVES + wave) * 64 + lane; e < (size_t)T * 1536; e += (size_t)F.G * NWAVES * 64) {
        const int row = (int)(e / 1536), r = (int)(e - (size_t)row * 1536), dir = r / 768, k = r - dir * 768;
        float z = gb[dir * 768 + k];
#pragma unroll
        for (int j = 0; j < 16; ++j) z += (LR0[(size_t)row * 32 + dir * 16 + j] + LR1[(size_t)row * 32 + dir * 16 + j]) * up[(dir * 16 + j) * 768 + k];
        const float ls = fminf(z, 0.f) - log1pf(expf(-fabsf(z)));
        DEC[e] = expf(ls * (1.f / 16.f));
    }
#endif
}

__device__ __forceinline__ void phase_mix_naive(Frame& F, const Args& a, int layer) {
    PHASE_IDS();
    bf16* H = (bf16*)(a.ws + WS_H); bf16* O = (bf16*)(a.ws + WS_XN);
#if !MFMA_SGU
    {
        const float* W = a.in[9] + (size_t)layer * 8 * 128 * 128; const float* sb = a.in[10] + layer * 8 * 128;
        const int c = tid & 127, pq = tid >> 7;
        for (int it = blockIdx.x; it < 256 * 8; it += F.G) {
            const int chunk = it >> 3, g = it & 7; const size_t r0 = (size_t)chunk * 128;
            for (int pp = 0; pp < 32; ++pp) { const int p = pp * 4 + pq; const float* wr = W + ((size_t)g * 128 + p) * 128;
                float acc = 0.f;
                for (int q = 0; q < 128; ++q) acc += wr[q] * bf1(H[(r0 + q) * HP + C_BV + g * 128 + c]);
                const size_t row = r0 + p;
                const float u = bf1(H[row * HP + C_BU + g * 128 + c]), sg = bf1(H[row * HP + C_BG + g * 128 + c]);
                O[row * D + O_B + g * 128 + c] = (bf16)f2bf((acc + sb[g * 128 + p]) * u * sg); }
        }
    }
#endif
#if !MFMA_ATT
    {
        LAS float* wq = (LAS float*)(F.lds + RING_OFF + wave * 2048);
        LAS float* sc = wq + 128;
        const float* sink = a.in[13] + layer * 12;
        const int gw = F.vcu * NWAVES + wave, NGW = F.G * NWAVES;
        for (int it = gw; it < T * 12; it += NGW) {
            const int row = it / 12, hq = it - row * 12, kvh = hq / 3;
            const int s0 = row < TP ? (row & ~2047) : TP, L = row < TP ? 2048 : 16384, qpos = row - s0;
            { const unsigned w = *((const unsigned*)(H + (size_t)row * HP + C_CQ + hq * 128) + lane); wq[2 * lane] = bflo(w); wq[2 * lane + 1] = bfhi(w); }
            LDS_WAIT(); asm volatile("" ::: "memory");
            float mx = -INFINITY;
            for (int pass = 0; pass < 5; ++pass) { const int jj = pass * 64 + lane, kpos = qpos - 128 + jj; float s = -INFINITY;
                if (jj <= 256 && kpos >= 0 && kpos < L) { const v4u* kr = (const v4u*)(H + (size_t)(s0 + kpos) * HP + C_CK + kvh * 128); float d = 0.f;
#pragma unroll 4
                    for (int i = 0; i < 16; ++i) { const v4u w = kr[i]; const LAS float* q8 = wq + 8 * i;
                        d += q8[0] * bflo(w.x) + q8[1] * bfhi(w.x) + q8[2] * bflo(w.y) + q8[3] * bfhi(w.y) + q8[4] * bflo(w.z) + q8[5] * bfhi(w.z) + q8[6] * bflo(w.w) + q8[7] * bfhi(w.w); }
                    s = d; }
                sc[jj] = s; mx = fmaxf(mx, s); }
            const float sk = sink[hq];
            const float m = fmaxf(wave_max(mx), sk);
            LDS_WAIT(); asm volatile("" ::: "memory");
            float ps = 0.f;
            for (int pass = 0; pass < 5; ++pass) { const int jj = pass * 64 + lane; const float s = sc[jj]; const float p = (s == -INFINITY) ? 0.f : __expf(s - m); sc[jj] = p; ps += p; }
            const float denom = wave_sum(ps) + __expf(sk - m);
            LDS_WAIT(); asm volatile("" ::: "memory");
            float o0 = 0.f, o1 = 0.f;
            const int jlo = qpos >= 128 ? 0 : 128 - qpos, jhi = (qpos + 128 < L) ? 256 : (L - 1 - qpos + 128);
            for (int jj = jlo; jj <= jhi; ++jj) { const float p = sc[jj]; const unsigned w = *((const unsigned*)(H + (size_t)(s0 + qpos - 128 + jj) * HP + C_CV + kvh * 128) + lane);
                o0 += p * bflo(w); o1 += p * bfhi(w); }
            const float inv = 1.0f / denom;
            const unsigned gwd = *((const unsigned*)(H + (size_t)row * HP + C_CG + hq * 128) + lane);
            *((unsigned*)(O + (size_t)row * D + O_C + hq * 128) + lane) = pk2(o0 * inv * bflo(gwd), o1 * inv * bfhi(gwd));
            LDS_WAIT(); asm volatile("" ::: "memory");
        }
    }
#endif
    __syncthreads();
    if (blockIdx.x < 108) {
        const int b = blockIdx.x, seq = b / 12, hd = (b % 12) >> 1, dir = b & 1;
        const int s0 = seq < 8 ? seq * 2048 : TP, L = seq < 8 ? 2048 : 16384;
        LAS float* la = (LAS float*)(F.lds + RING_OFF + 32768); LAS float* lq = la + 128; LAS float* lk = lq + 128; LAS float* lo = lk + 128;
        const float* DEC = (const float*)(a.ws + WS_MG);
        float* OUT = (float*)(a.ws + WS_ST) + (size_t)dir * T * 1536;
        const int dv = tid & 255, half = tid >> 8;
        float S[64];
#pragma unroll
        for (int j = 0; j < 64; ++j) S[j] = 0.f;
        float na = 0.f, nq = 0.f, nk = 0.f, nv;
        { const size_t p = (size_t)(dir == 0 ? s0 : s0 + L - 1);
          if (tid < 128) { na = DEC[p * 1536 + dir * 768 + hd * 128 + tid]; nq = bf1(H[p * HP + C_AQ + hd * 128 + tid]) * 0.08838834764831845f; nk = bf1(H[p * HP + C_AK + hd * 128 + tid]); }
          nv = bf1(H[p * HP + C_AV + hd * 256 + dv]); }
        for (int t = 0; t < L; ++t) {
            const size_t p = (size_t)(dir == 0 ? s0 + t : s0 + L - 1 - t);
            if (tid < 128) { la[tid] = na; lq[tid] = nq; lk[tid] = nk; }
            const float v = nv;
            __syncthreads();
            if (t + 1 < L) { const size_t pn = (size_t)(dir == 0 ? p + 1 : p - 1);
                if (tid < 128) { na = DEC[pn * 1536 + dir * 768 + hd * 128 + tid]; nq = bf1(H[pn * HP + C_AQ + hd * 128 + tid]) * 0.08838834764831845f; nk = bf1(H[pn * HP + C_AK + hd * 128 + tid]); }
                nv = bf1(H[pn * HP + C_AV + hd * 256 + dv]); }
            float acc = 0.f;
#pragma unroll
            for (int j = 0; j < 64; ++j) { const int dk = half * 64 + j; S[j] = la[dk] * S[j] + lk[dk] * v; acc += lq[dk] * S[j]; }
            if (half == 1) lo[dv] = acc;
            __syncthreads();
            if (half == 0) OUT[p * 1536 + hd * 256 + dv] = acc + lo[dv];
        }
    }
}

__device__ __forceinline__ void phase_gla_fin(Frame& F, const Args& a, int layer) {
    PHASE_IDS();
    const int gw = F.vcu * NWAVES + wave, NGW = F.G * NWAVES;
    const bf16* H = (const bf16*)(a.ws + WS_H); bf16* O = (bf16*)(a.ws + WS_XN);
    const float* OF = (const float*)(a.ws + WS_ST); const float* OB = OF + (size_t)T * 1536;
    const float* gn = a.in[6] + layer * 256;
    for (int it = gw; it < T * 6; it += NGW) {
        const int row = it / 6, hd = it - row * 6;
        const f32x4 f = *((const f32x4*)(OF + (size_t)row * 1536 + hd * 256) + lane), b = *((const f32x4*)(OB + (size_t)row * 1536 + hd * 256) + lane);
        const f32x4 s = f + b;
        const float rstd = 1.0f / sqrtf(wave_sum((s.x * s.x + s.y * s.y) + (s.z * s.z + s.w * s.w)) * (1.f / 256.f) + 1e-6f);
        const f32x4 g = *((const f32x4*)gn + lane);
        const v2u gt = *((const v2u*)(H + (size_t)row * HP + C_AG + hd * 256) + lane);
        v2u w; w.x = pk2(s.x * rstd * g.x * bflo(gt.x), s.y * rstd * g.y * bfhi(gt.x)); w.y = pk2(s.z * rstd * g.z * bflo(gt.y), s.w * rstd * g.w * bfhi(gt.y));
        *((v2u*)(O + (size_t)row * D + O_A + hd * 256) + lane) = w;
    }
}


typedef short bf16x8 __attribute__((ext_vector_type(8)));
#define MFMA16(a_, b_, c_) __builtin_amdgcn_mfma_f32_16x16x32_bf16(a_, b_, c_, 0, 0, 0)
__device__ __forceinline__ bf16x8 ldsfrag(const LAS unsigned char* base, int pitch, int row0, int k0, int fr, int fq) {
    return *(const LAS bf16x8*)(base + (row0 + fr) * pitch + (k0 + 8 * fq) * 2);
}

__device__ __forceinline__ void phase_sgu(Frame& F, const Args& a, int layer) {
    PHASE_IDS();
    const int fr = lane & 15, fq = lane >> 4;
    constexpr int PIT = 272;
    LAS unsigned char* VT = F.lds + RING_OFF;
    LAS unsigned char* WA = VT + 128 * PIT;
    LAS float* STt = (LAS float*)(WA + 128 * PIT);
    const bf16* H = (const bf16*)(a.ws + WS_H); bf16* O = (bf16*)(a.ws + WS_XN);
    const float* lg = a.in[7] + layer * 1024; const float* lb = a.in[8] + layer * 1024;
    const float* W = a.in[9] + (size_t)layer * 8 * 128 * 128; const float* sb = a.in[10] + layer * 8 * 128;
    for (int chunk = blockIdx.x; chunk < 256; chunk += F.G) {
        const size_t r0 = (size_t)chunk * 128;
        __syncthreads();
        for (int i = 0; i < 16; ++i) { const size_t row = r0 + 16 * wave + i;
            const v4u* p = (const v4u*)(H + row * HP + C_BV) + lane; float x[16]; unpack8(p[0], x); unpack8(p[64], x + 8);
            float s = 0.f;
#pragma unroll
            for (int j = 0; j < 16; ++j) s += x[j];
            const float mean = wave_sum(s) * (1.f / 1024.f); float q = 0.f;
#pragma unroll
            for (int j = 0; j < 16; ++j) { const float d = x[j] - mean; q += d * d; }
            const float rstd = 1.0f / sqrtf(wave_sum(q) * (1.f / 1024.f) + 1e-5f);
            if (lane == 0) { STt[2 * (16 * wave + i)] = mean; STt[2 * (16 * wave + i) + 1] = rstd; } }
        __syncthreads();
        for (int g = 0; g < 8; ++g) {
            { const int q = tid & 127, cb = (tid >> 7) * 32; const v4u* src = (const v4u*)(H + (r0 + q) * HP + C_BV + g * 128 + cb); const float st_x = STt[2 * q], st_y = STt[2 * q + 1];
#pragma unroll
              for (int i = 0; i < 4; ++i) { float x[8]; unpack8(src[i], x);
#pragma unroll
                  for (int j = 0; j < 8; ++j) { const int c = cb + 8 * i + j; const float y = (x[j] - st_x) * st_y * lg[g * 128 + c] + lb[g * 128 + c];
                      *(LAS bf16*)(VT + c * PIT + q * 2) = (bf16)f2bf(y); } } }
            { const int p = tid >> 2, qb = (tid & 3) * 32; const f32x4* src = (const f32x4*)(W + ((size_t)g * 128 + p) * 128 + qb);
#pragma unroll
              for (int i = 0; i < 4; ++i) { const f32x4 u0 = src[2 * i], u1 = src[2 * i + 1]; v4u w; w.x = pk2(u0.x, u0.y); w.y = pk2(u0.z, u0.w); w.z = pk2(u1.x, u1.y); w.w = pk2(u1.z, u1.w);
                  *(LAS v4u*)(WA + p * PIT + (qb + 8 * i) * 2) = w; } }
            __syncthreads();
            f32x4 acc[8];
#pragma unroll
            for (int n = 0; n < 8; ++n) acc[n] = (f32x4){0.f, 0.f, 0.f, 0.f};
#pragma unroll
            for (int ks = 0; ks < 4; ++ks) { const bf16x8 af = ldsfrag(WA, PIT, 16 * wave, 32 * ks, fr, fq);
#pragma unroll
                for (int n = 0; n < 8; ++n) acc[n] = MFMA16(ldsfrag(VT, PIT, 16 * n, 32 * ks, fr, fq), af, acc[n]); }
            const int p = 16 * wave + fr; const size_t row = r0 + p; const float sbv = sb[g * 128 + p];
#pragma unroll
            for (int n = 0; n < 8; ++n) { const int c = g * 128 + 16 * n + 4 * fq;
                const v2u gu = *(const v2u*)(H + row * HP + C_BU + c), sg = *(const v2u*)(H + row * HP + C_BG + c);
                v2u w; w.x = pk2((acc[n][0] + sbv) * bflo(gu.x) * bflo(sg.x), (acc[n][1] + sbv) * bfhi(gu.x) * bfhi(sg.x));
                w.y = pk2((acc[n][2] + sbv) * bflo(gu.y) * bflo(sg.y), (acc[n][3] + sbv) * bfhi(gu.y) * bfhi(sg.y));
                *(v2u*)(O + row * D + O_B + c) = w; }
            __syncthreads();
        }
    }
}

__device__ __forceinline__ void phase_attn(Frame& F, const Args& a, int layer) {
    PHASE_IDS();
    const int fr = lane & 15, fq = lane >> 4;
    constexpr int PIT = 272;
    LAS unsigned char* Kt = F.lds + RING_OFF;
    LAS unsigned char* Vt = Kt + 128 * PIT;
    LAS unsigned char* Pm = Vt + 128 * PIT;
    const bf16* H = (const bf16*)(a.ws + WS_H); bf16* O = (bf16*)(a.ws + WS_XN);
    const float* sink = a.in[13] + layer * 12;
    const float* qg = a.in[11] + layer * 128; const float* kg = a.in[12] + layer * 128;
    const float* rt = (const float*)(a.ws + WS_ROPE);
    constexpr int NU = 256 * 12;
    int u = blockIdx.x; if (u >= NU) return;
#define ATT_DECODE(u_, qb_, hq_, r0_, s0_, nblk_, qi_) const int qb_ = (u_) / 12, hq_ = (u_) - qb_ * 12, r0_ = qb_ * 128, s0_ = r0_ < TP ? (r0_ & ~2047) : TP, nblk_ = r0_ < TP ? 16 : 128, qi_ = (r0_ - s0_) >> 7
#define ATT_LOAD_KV(s0_, kbi_, kvh_) do { const size_t kr0_ = (size_t)((s0_) + (kbi_) * 128); \
        const v4u* ks_ = (const v4u*)(H + (kr0_ + (tid >> 2)) * HP + C_CK + (kvh_) * 128 + (tid & 3) * 32); const v4u* vs_ = (const v4u*)(H + (kr0_ + (tid & 127)) * HP + C_CV + (kvh_) * 128 + (tid >> 7) * 32); \
        _Pragma("unroll") for (int i_ = 0; i_ < 4; ++i_) { kraw[i_] = ks_[i_]; vraw[i_] = vs_[i_]; } } while (0)
#define ATT_LOAD_Q(r0_, hq_) do { const bf16* qp_ = H + (size_t)((r0_) + 16 * wave + fr) * HP + C_CQ + (hq_) * 128 + 8 * fq; \
        _Pragma("unroll") for (int i_ = 0; i_ < 4; ++i_) qraw[i_] = *(const v4u*)(qp_ + 32 * i_); } while (0)
    v4u kraw[4], vraw[4], qraw[4];
    int t;
    { ATT_DECODE(u, qb, hq, r0, s0, nblk, qi); (void)nblk; t = qi == 0 ? 0 : -1; ATT_LOAD_KV(s0, qi + t, hq / 3); ATT_LOAD_Q(r0, hq); }
    for (;;) {
        ATT_DECODE(u, qb, hq, r0, s0, nblk, qi); const int kvh = hq / 3;
        const size_t qrow = (size_t)(r0 + 16 * wave + fr);
        bf16x8 qf[4];
#if ATT_FUSED_NORM
        { float x[4][8]; float ss = 0.f;
#pragma unroll
          for (int ks = 0; ks < 4; ++ks) { unpack8(qraw[ks], x[ks]);
#pragma unroll
              for (int j = 0; j < 8; ++j) ss += x[ks][j] * x[ks][j]; }
          ss += __shfl_xor(ss, 16); ss += __shfl_xor(ss, 32);
          const float rstd = 1.0f / sqrtf(ss * (1.f / 128.f) + 1e-6f);
#pragma unroll
          for (int ks = 0; ks < 4; ++ks) { const f32x4 g0 = *(const f32x4*)(qg + 32 * ks + 8 * fq), g1 = *(const f32x4*)(qg + 32 * ks + 8 * fq + 4);
              x[ks][0] *= rstd * g0.x; x[ks][1] *= rstd * g0.y; x[ks][2] *= rstd * g0.z; x[ks][3] *= rstd * g0.w; x[ks][4] *= rstd * g1.x; x[ks][5] *= rstd * g1.y; x[ks][6] *= rstd * g1.z; x[ks][7] *= rstd * g1.w; }
          { const int pos = (int)qrow - s0; const f32x4* c4 = (const f32x4*)(rt + (pos * 16 + 8 * (fq & 1)) * 2);
#pragma unroll
            for (int j2 = 0; j2 < 4; ++j2) { const f32x4 cs = c4[j2]; const float pa = __shfl_xor(x[0][2 * j2], 32), pb = __shfl_xor(x[0][2 * j2 + 1], 32);
                x[0][2 * j2] = fq < 2 ? x[0][2 * j2] * cs.x - pa * cs.y : x[0][2 * j2] * cs.x + pa * cs.y;
                x[0][2 * j2 + 1] = fq < 2 ? x[0][2 * j2 + 1] * cs.z - pb * cs.w : x[0][2 * j2 + 1] * cs.z + pb * cs.w; } }
#pragma unroll
          for (int ks = 0; ks < 4; ++ks) { v4u w; const float sc = 0.08838834764831845f;
              w.x = pk2(x[ks][0] * sc, x[ks][1] * sc); w.y = pk2(x[ks][2] * sc, x[ks][3] * sc); w.z = pk2(x[ks][4] * sc, x[ks][5] * sc); w.w = pk2(x[ks][6] * sc, x[ks][7] * sc);
              qf[ks] = __builtin_bit_cast(bf16x8, w); } }
#else
#pragma unroll
        for (int ks = 0; ks < 4; ++ks) qf[ks] = __builtin_bit_cast(bf16x8, qraw[ks]);
#endif
        float m = sink[hq], l = fq == 0 ? 1.f : 0.f;
        f32x4 Oa[8];
#pragma unroll
        for (int n = 0; n < 8; ++n) Oa[n] = (f32x4){0.f, 0.f, 0.f, 0.f};
        int un = u, tn = t; bool more = true;
        for (;;) {
            const size_t kr0 = (size_t)(s0 + (qi + t) * 128);
            __syncthreads();
#if ATT_FUSED_NORM
            { const int key = tid >> 2, dq = tid & 3, db = dq * 32; float ss = 0.f;
#pragma unroll
              for (int i = 0; i < 4; ++i) { float x[8]; unpack8(kraw[i], x);
#pragma unroll
                  for (int j = 0; j < 8; ++j) ss += x[j] * x[j]; }
              ss += __shfl_xor(ss, 1); ss += __shfl_xor(ss, 2);
              const float rstd = 1.0f / sqrtf(ss * (1.f / 128.f) + 1e-6f);
              if (dq == 0) {
                  const int pos = (int)(kr0 - s0) + key; const f32x4* c4 = (const f32x4*)(rt + pos * 32);
#pragma unroll
                  for (int h = 0; h < 2; ++h) { float xa[8], xb[8]; unpack8(kraw[h], xa); unpack8(kraw[h + 2], xb);
#pragma unroll
                      for (int j = 0; j < 8; ++j) { xa[j] *= rstd * kg[8 * h + j]; xb[j] *= rstd * kg[16 + 8 * h + j]; }
#pragma unroll
                      for (int j2 = 0; j2 < 4; ++j2) { const f32x4 cs = c4[4 * h + j2];
                          const float a0 = xa[2 * j2], b0 = xb[2 * j2], a1 = xa[2 * j2 + 1], b1 = xb[2 * j2 + 1];
                          xa[2 * j2] = a0 * cs.x - b0 * cs.y; xb[2 * j2] = b0 * cs.x + a0 * cs.y; xa[2 * j2 + 1] = a1 * cs.z - b1 * cs.w; xb[2 * j2 + 1] = b1 * cs.z + a1 * cs.w; }
                      v4u w; w.x = pk2(xa[0], xa[1]); w.y = pk2(xa[2], xa[3]); w.z = pk2(xa[4], xa[5]); w.w = pk2(xa[6], xa[7]); *(LAS v4u*)(Kt + key * PIT + (8 * h) * 2) = w;
                      w.x = pk2(xb[0], xb[1]); w.y = pk2(xb[2], xb[3]); w.z = pk2(xb[4], xb[5]); w.w = pk2(xb[6], xb[7]); *(LAS v4u*)(Kt + key * PIT + (16 + 8 * h) * 2) = w; }
              } else {
#pragma unroll
                  for (int i = 0; i < 4; ++i) { float x[8]; unpack8(kraw[i], x);
#pragma unroll
                      for (int j = 0; j < 8; ++j) x[j] *= rstd * kg[db + 8 * i + j];
                      v4u w; w.x = pk2(x[0], x[1]); w.y = pk2(x[2], x[3]); w.z = pk2(x[4], x[5]); w.w = pk2(x[6], x[7]); *(LAS v4u*)(Kt + key * PIT + (db + 8 * i) * 2) = w; } } }
#else
            { const int key = tid >> 2, db = (tid & 3) * 32;
#pragma unroll
              for (int i = 0; i < 4; ++i) *(LAS v4u*)(Kt + key * PIT + (db + 8 * i) * 2) = kraw[i]; }
#endif
            { const int key = tid & 127, db = (tid >> 7) * 32;
#pragma unroll
              for (int i = 0; i < 4; ++i) { const v4u w = vraw[i]; const unsigned ww[4] = {w.x, w.y, w.z, w.w};
#pragma unroll
                  for (int j = 0; j < 4; ++j) { *(LAS bf16*)(Vt + (db + 8 * i + 2 * j) * PIT + key * 2) = (bf16)(ww[j] & 0xffffu); *(LAS bf16*)(Vt + (db + 8 * i + 2 * j + 1) * PIT + key * 2) = (bf16)(ww[j] >> 16); } } }
            if (t + 1 <= 1 && qi + t + 1 < nblk) { tn = t + 1; ATT_LOAD_KV(s0, qi + tn, kvh); }
            else { un = u + F.G; if (un < NU) { ATT_DECODE(un, qb2, hq2, r02, s02, nblk2, qi2); (void)nblk2; tn = qi2 == 0 ? 0 : -1; ATT_LOAD_KV(s02, qi2 + tn, hq2 / 3); ATT_LOAD_Q(r02, hq2); } else more = false; }
            __syncthreads();
            f32x4 S[8];
#pragma unroll
            for (int n = 0; n < 8; ++n) S[n] = (f32x4){0.f, 0.f, 0.f, 0.f};
#pragma unroll
            for (int ks = 0; ks < 4; ++ks)
#pragma unroll
                for (int n = 0; n < 8; ++n) S[n] = MFMA16(ldsfrag(Kt, PIT, 16 * n, 32 * ks, fr, fq), qf[ks], S[n]);
            const int qi_ = 16 * wave + fr; float mx = -INFINITY;
#pragma unroll
            for (int n = 0; n < 8; ++n)
#pragma unroll
                for (int j = 0; j < 4; ++j) { const int kj = 16 * n + 4 * fq + j; const bool ok = t == 0 || (t < 0 ? kj >= qi_ : kj <= qi_);
                    const float sv = ok ? S[n][j] : -INFINITY; S[n][j] = sv; mx = fmaxf(mx, sv); }
            mx = fmaxf(mx, __shfl_xor(mx, 16)); mx = fmaxf(mx, __shfl_xor(mx, 32));
            const float mn = fmaxf(m, mx), alpha = __expf(m - mn); m = mn;
            float ps = 0.f;
#pragma unroll
            for (int n = 0; n < 8; ++n) { float p0 = __expf(S[n][0] - mn), p1 = __expf(S[n][1] - mn), p2 = __expf(S[n][2] - mn), p3 = __expf(S[n][3] - mn);
                ps += (p0 + p1) + (p2 + p3); v2u w; w.x = pk2(p0, p1); w.y = pk2(p2, p3);
                *(LAS v2u*)(Pm + (16 * wave + fr) * PIT + (16 * n + 4 * fq) * 2) = w; Oa[n] = Oa[n] * alpha; }
            l = l * alpha + ps;
            LDS_WAIT(); asm volatile("" ::: "memory");
#pragma unroll
            for (int ks = 0; ks < 4; ++ks) { const bf16x8 pf = ldsfrag(Pm, PIT, 16 * wave, 32 * ks, fr, fq);
#pragma unroll
                for (int n = 0; n < 8; ++n) Oa[n] = MFMA16(ldsfrag(Vt, PIT, 16 * n, 32 * ks, fr, fq), pf, Oa[n]); }
            if (un != u || !more) break;
            t = tn;
        }
        l += __shfl_xor(l, 16); l += __shfl_xor(l, 32);
        const float inv = 1.0f / l;
#pragma unroll
        for (int n = 0; n < 8; ++n) { const int d = hq * 128 + 16 * n + 4 * fq; const v2u gt = *(const v2u*)(H + qrow * HP + C_CG + d);
            v2u w; w.x = pk2(Oa[n][0] * inv * bflo(gt.x), Oa[n][1] * inv * bfhi(gt.x)); w.y = pk2(Oa[n][2] * inv * bflo(gt.y), Oa[n][3] * inv * bfhi(gt.y));
            *(v2u*)(O + qrow * D + O_C + d) = w; }
        if (!more) break;
        u = un; t = tn;
    }
#undef ATT_DECODE
#undef ATT_LOAD_KV
#undef ATT_LOAD_Q
}

__device__ __forceinline__ void phase_gla_c1(Frame& F, const Args& a, int layer) {
    PHASE_IDS();
    const int fr = lane & 15, fq = lane >> 4;
    constexpr int PV = 144;
    LAS unsigned char* VT = F.lds + RING_OFF;
    LAS unsigned char* K1T = VT + 256 * PV;
    const bf16* H = (const bf16*)(a.ws + WS_H); const float* Bc = (const float*)(a.ws + WS_MG);
    bf16* STb = (bf16*)(a.ws + WS_ST); float* DECC = (float*)(a.ws + WS_DECC);
    v4u vraw[4], kraw[2]; f32x4 braw[2][4];
#define C1_LOAD(u_) do { const int c_ = (u_) / 6, hd_ = (u_) - c_ * 6; const size_t r0_ = (size_t)c_ * 64; const int s_ = tid & 63; \
        const v4u* vs_ = (const v4u*)(H + (r0_ + s_) * HP + C_AV + hd_ * 256 + (tid >> 6) * 32); _Pragma("unroll") for (int i_ = 0; i_ < 4; ++i_) vraw[i_] = vs_[i_]; \
        const v4u* ks_ = (const v4u*)(H + (r0_ + s_) * HP + C_AK + hd_ * 128 + (tid >> 6) * 16); kraw[0] = ks_[0]; kraw[1] = ks_[1]; \
        _Pragma("unroll") for (int d_ = 0; d_ < 2; ++d_) { const f32x4* bs_ = (const f32x4*)(Bc + (r0_ + s_) * 1536 + d_ * 768 + hd_ * 128 + (tid >> 6) * 16); _Pragma("unroll") for (int i_ = 0; i_ < 4; ++i_) braw[d_][i_] = bs_[i_]; } } while (0)
    if ((int)blockIdx.x < 512 * 6) C1_LOAD((int)blockIdx.x);
    for (int u = blockIdx.x; u < 512 * 6; u += F.G) {
        const int c = u / 6, hd = u - c * 6; const size_t r0 = (size_t)c * 64;
        __syncthreads();
        { const int s = tid & 63, dvb = (tid >> 6) * 32;
#pragma unroll
          for (int i = 0; i < 4; ++i) { const v4u w = vraw[i]; const unsigned ww[4] = {w.x, w.y, w.z, w.w};
#pragma unroll
              for (int j = 0; j < 4; ++j) { *(LAS bf16*)(VT + (dvb + 8 * i + 2 * j) * PV + s * 2) = (bf16)(ww[j] & 0xffffu); *(LAS bf16*)(VT + (dvb + 8 * i + 2 * j + 1) * PV + s * 2) = (bf16)(ww[j] >> 16); } } }
        { const int s = tid & 63, dkb = (tid >> 6) * 16; float kx[16]; unpack8(kraw[0], kx); unpack8(kraw[1], kx + 8);
#pragma unroll
          for (int dir = 0; dir < 2; ++dir)
#pragma unroll
            for (int i = 0; i < 4; ++i) { const f32x4 bb = braw[dir][i];
#pragma unroll
                for (int j = 0; j < 4; ++j) *(LAS bf16*)(K1T + (dir * 128 + dkb + 4 * i + j) * PV + s * 2) = (bf16)f2bf(kx[4 * i + j] * __expf(-bb[j])); } }
        if (u + F.G < 512 * 6) C1_LOAD(u + F.G);
        __syncthreads();
#pragma unroll
        for (int dir = 0; dir < 2; ++dir) {
            f32x4 acc[2][8];
#pragma unroll
            for (int m = 0; m < 2; ++m)
#pragma unroll
                for (int n = 0; n < 8; ++n) acc[m][n] = (f32x4){0.f, 0.f, 0.f, 0.f};
#pragma unroll
            for (int ks = 0; ks < 2; ++ks) { const bf16x8 a0 = ldsfrag(VT, PV, 32 * wave, 32 * ks, fr, fq), a1 = ldsfrag(VT, PV, 32 * wave + 16, 32 * ks, fr, fq);
#pragma unroll
                for (int n = 0; n < 8; ++n) { const bf16x8 bfr = ldsfrag(K1T + dir * 128 * PV, PV, 16 * n, 32 * ks, fr, fq); acc[0][n] = MFMA16(bfr, a0, acc[0][n]); acc[1][n] = MFMA16(bfr, a1, acc[1][n]); } }
            const size_t lastrow = r0 + (dir == 0 ? 63 : 0); const int slot = (c * 6 + hd) * 2 + dir; bf16* dst = STb + (size_t)slot * 32768;
#pragma unroll
            for (int n = 0; n < 8; ++n) { const int dk = 16 * n + 4 * fq; const f32x4 bl = *(const f32x4*)(Bc + lastrow * 1536 + dir * 768 + hd * 128 + dk);
                const float e0 = __expf(bl.x), e1 = __expf(bl.y), e2 = __expf(bl.z), e3 = __expf(bl.w);
#pragma unroll
                for (int m = 0; m < 2; ++m) { const int dv = 32 * wave + 16 * m + fr; v2u w; w.x = pk2(acc[m][n][0] * e0, acc[m][n][1] * e1); w.y = pk2(acc[m][n][2] * e2, acc[m][n][3] * e3);
                    *(v2u*)(dst + dv * 128 + dk) = w; } }
            if (tid < 128) DECC[slot * 128 + tid] = __expf(Bc[lastrow * 1536 + dir * 768 + hd * 128 + tid]);
        }
    }
#undef C1_LOAD
}
__device__ __forceinline__ void gla_scan_item(int it, bf16* STb, const float* DECC, int lane) {
    int seq, hdir, slab;
    if (it < 768) { seq = 8; hdir = it >> 6; slab = it & 63; } else { const int j = it - 768; const int sh = j >> 6; seq = sh / 12; hdir = sh - seq * 12; slab = j & 63; }
    const int c0 = seq < 8 ? seq * 32 : 256, nc = seq < 8 ? 32 : 256, hd = hdir >> 1, dir = hdir & 1;
    const int e0 = slab * 512 + lane * 8, dk0 = e0 & 127;
    float S[8];
#pragma unroll
    for (int j = 0; j < 8; ++j) S[j] = 0.f;
    v4u kvn[8];
#pragma unroll
    for (int i = 0; i < 8; ++i) { const int c = dir == 0 ? c0 + i : c0 + nc - 1 - i; kvn[i] = *(const v4u*)(STb + (size_t)((c * 6 + hd) * 2 + dir) * 32768 + e0); }
    for (int st = 0; st < nc; st += 8) {
        v4u kv[8]; f32x4 d0[8], d1[8];
#pragma unroll
        for (int i = 0; i < 8; ++i) { const int c = dir == 0 ? c0 + st + i : c0 + nc - 1 - (st + i); const int slot = (c * 6 + hd) * 2 + dir;
            kv[i] = kvn[i]; d0[i] = *(const f32x4*)(DECC + slot * 128 + dk0); d1[i] = *(const f32x4*)(DECC + slot * 128 + dk0 + 4); }
        if (st + 8 < nc) {
#pragma unroll
            for (int i = 0; i < 8; ++i) { const int c = dir == 0 ? c0 + st + 8 + i : c0 + nc - 1 - (st + 8 + i); kvn[i] = *(const v4u*)(STb + (size_t)((c * 6 + hd) * 2 + dir) * 32768 + e0); } }
#pragma unroll
        for (int i = 0; i < 8; ++i) { const int c = dir == 0 ? c0 + st + i : c0 + nc - 1 - (st + i); const int slot = (c * 6 + hd) * 2 + dir;
            v4u w; w.x = pk2(S[0], S[1]); w.y = pk2(S[2], S[3]); w.z = pk2(S[4], S[5]); w.w = pk2(S[6], S[7]);
            *(v4u*)(STb + (size_t)slot * 32768 + e0) = w;
            float x[8]; unpack8(kv[i], x);
            S[0] = d0[i].x * S[0] + x[0]; S[1] = d0[i].y * S[1] + x[1]; S[2] = d0[i].z * S[2] + x[2]; S[3] = d0[i].w * S[3] + x[3];
            S[4] = d1[i].x * S[4] + x[4]; S[5] = d1[i].y * S[5] + x[5]; S[6] = d1[i].z * S[6] + x[6]; S[7] = d1[i].w * S[7] + x[7]; }
    }
}
__device__ __forceinline__ void phase_gla_scan(Frame& F, const Args& a) {
    PHASE_IDS();
    bf16* STb = (bf16*)(a.ws + WS_ST); const float* DECC = (const float*)(a.ws + WS_DECC);
    const int gw = F.vcu * NWAVES + wave, NGW = F.G * NWAVES;
    if (F.G == 256) {
        const int cu = blockIdx.x;
        if (wave < 3) gla_scan_item(cu * 3 + wave, STb, DECC, lane);
        else for (int it = 768 + cu * 5 + (wave - 3); it < 768 + 6144; it += 1280) gla_scan_item(it, STb, DECC, lane);
    }
    else for (int it = gw; it < 768 + 6144; it += NGW) gla_scan_item(it, STb, DECC, lane);
}
__device__ __forceinline__ void phase_gla_c3(Frame& F, const Args& a, int layer) {
    PHASE_IDS();
    const int fr = lane & 15, fq = lane >> 4;
    constexpr int PQ = 272, PV = 144;
    LAS unsigned char* Q1 = F.lds + RING_OFF;
    LAS unsigned char* K1 = Q1 + 2 * 64 * PQ;
    LAS unsigned char* VT = K1 + 2 * 64 * PQ;
    LAS unsigned char* Pm = VT + 256 * PV;
    LAS float* red = (LAS float*)(Pm + 2 * 64 * PV);
    const bf16* H = (const bf16*)(a.ws + WS_H); const float* Bc = (const float*)(a.ws + WS_MG);
    const bf16* STb = (const bf16*)(a.ws + WS_ST); bf16* O = (bf16*)(a.ws + WS_XN);
    const float* gn = a.in[6] + layer * 256;
    v4u qraw[2], kraw[2], vraw[4]; f32x4 braw[2][4];
#define C3_LOAD(u_) do { const int c_ = (u_) / 6, hd_ = (u_) - c_ * 6; const size_t r0_ = (size_t)c_ * 64; const int s_ = tid >> 3, dkb_ = (tid & 7) * 16; \
        const v4u* qs_ = (const v4u*)(H + (r0_ + s_) * HP + C_AQ + hd_ * 128 + dkb_); const v4u* ks_ = (const v4u*)(H + (r0_ + s_) * HP + C_AK + hd_ * 128 + dkb_); \
        qraw[0] = qs_[0]; qraw[1] = qs_[1]; kraw[0] = ks_[0]; kraw[1] = ks_[1]; \
        _Pragma("unroll") for (int d_ = 0; d_ < 2; ++d_) { const f32x4* bs_ = (const f32x4*)(Bc + (r0_ + s_) * 1536 + d_ * 768 + hd_ * 128 + dkb_); _Pragma("unroll") for (int i_ = 0; i_ < 4; ++i_) braw[d_][i_] = bs_[i_]; } \
        const v4u* vs_ = (const v4u*)(H + (r0_ + (tid & 63)) * HP + C_AV + hd_ * 256 + (tid >> 6) * 32); _Pragma("unroll") for (int i_ = 0; i_ < 4; ++i_) vraw[i_] = vs_[i_]; } while (0)
    if ((int)blockIdx.x < 512 * 6) C3_LOAD((int)blockIdx.x);
    for (int u = blockIdx.x; u < 512 * 6; u += F.G) {
        const int c = u / 6, hd = u - c * 6; const size_t r0 = (size_t)c * 64;
        bf16x8 sfr[2][4][2];
#pragma unroll
        for (int dir = 0; dir < 2; ++dir) { const bf16* Sg = STb + (size_t)((c * 6 + hd) * 2 + dir) * 32768;
#pragma unroll
            for (int ks = 0; ks < 4; ++ks)
#pragma unroll
                for (int n = 0; n < 2; ++n) sfr[dir][ks][n] = *(const bf16x8*)(Sg + (32 * wave + 16 * n + fr) * 128 + 32 * ks + 8 * fq); }
        __syncthreads();
        { const int s = tid >> 3, dkb = (tid & 7) * 16; float q0[16], k0[16]; unpack8(qraw[0], q0); unpack8(qraw[1], q0 + 8); unpack8(kraw[0], k0); unpack8(kraw[1], k0 + 8);
#pragma unroll
          for (int dir = 0; dir < 2; ++dir) { float qx[16], kx[16];
#pragma unroll
            for (int i = 0; i < 4; ++i) { const f32x4 bb = braw[dir][i];
#pragma unroll
                for (int j = 0; j < 4; ++j) { const float e = __expf(bb[j]); qx[4 * i + j] = q0[4 * i + j] * e * 0.08838834764831845f; kx[4 * i + j] = k0[4 * i + j] * __builtin_amdgcn_rcpf(e); } }
            v4u w;
            w.x = pk2(qx[0], qx[1]); w.y = pk2(qx[2], qx[3]); w.z = pk2(qx[4], qx[5]); w.w = pk2(qx[6], qx[7]); *(LAS v4u*)(Q1 + (dir * 64 + s) * PQ + dkb * 2) = w;
            w.x = pk2(qx[8], qx[9]); w.y = pk2(qx[10], qx[11]); w.z = pk2(qx[12], qx[13]); w.w = pk2(qx[14], qx[15]); *(LAS v4u*)(Q1 + (dir * 64 + s) * PQ + dkb * 2 + 16) = w;
            w.x = pk2(kx[0], kx[1]); w.y = pk2(kx[2], kx[3]); w.z = pk2(kx[4], kx[5]); w.w = pk2(kx[6], kx[7]); *(LAS v4u*)(K1 + (dir * 64 + s) * PQ + dkb * 2) = w;
            w.x = pk2(kx[8], kx[9]); w.y = pk2(kx[10], kx[11]); w.z = pk2(kx[12], kx[13]); w.w = pk2(kx[14], kx[15]); *(LAS v4u*)(K1 + (dir * 64 + s) * PQ + dkb * 2 + 16) = w; } }
        { const int s = tid & 63, dvb = (tid >> 6) * 32;
#pragma unroll
          for (int i = 0; i < 4; ++i) { const v4u w = vraw[i]; const unsigned ww[4] = {w.x, w.y, w.z, w.w};
#pragma unroll
              for (int j = 0; j < 4; ++j) { *(LAS bf16*)(VT + (dvb + 8 * i + 2 * j) * PV + s * 2) = (bf16)(ww[j] & 0xffffu); *(LAS bf16*)(VT + (dvb + 8 * i + 2 * j + 1) * PV + s * 2) = (bf16)(ww[j] >> 16); } } }
        if (u + F.G < 512 * 6) C3_LOAD(u + F.G);
        __syncthreads();
        { const int mt = wave >> 1, nt0 = (wave & 1) * 2;
#pragma unroll
          for (int dir = 0; dir < 2; ++dir) { f32x4 sc[2] = {(f32x4){0.f, 0.f, 0.f, 0.f}, (f32x4){0.f, 0.f, 0.f, 0.f}};
#pragma unroll
              for (int ks = 0; ks < 4; ++ks) { const bf16x8 af = ldsfrag(Q1 + dir * 64 * PQ, PQ, 16 * mt, 32 * ks, fr, fq);
#pragma unroll
                  for (int nn = 0; nn < 2; ++nn) sc[nn] = MFMA16(ldsfrag(K1 + dir * 64 * PQ, PQ, 16 * (nt0 + nn), 32 * ks, fr, fq), af, sc[nn]); }
              const int t = 16 * mt + fr;
#pragma unroll
              for (int nn = 0; nn < 2; ++nn) { const int sb_ = 16 * (nt0 + nn) + 4 * fq; float p[4];
#pragma unroll
                  for (int j = 0; j < 4; ++j) { const int s_ = sb_ + j; const bool ok = dir == 0 ? s_ <= t : s_ >= t; p[j] = ok ? sc[nn][j] : 0.f; }
                  v2u w; w.x = pk2(p[0], p[1]); w.y = pk2(p[2], p[3]); *(LAS v2u*)(Pm + (dir * 64 + t) * PV + sb_ * 2) = w; } } }
        __syncthreads();
        f32x4 acc[4][2];
#pragma unroll
        for (int m = 0; m < 4; ++m) { acc[m][0] = (f32x4){0.f, 0.f, 0.f, 0.f}; acc[m][1] = (f32x4){0.f, 0.f, 0.f, 0.f}; }
#pragma unroll
        for (int dir = 0; dir < 2; ++dir) {
#pragma unroll
            for (int ks = 0; ks < 4; ++ks) {
#pragma unroll
                for (int m = 0; m < 4; ++m) { const bf16x8 af = ldsfrag(Q1 + dir * 64 * PQ, PQ, 16 * m, 32 * ks, fr, fq); acc[m][0] = MFMA16(sfr[dir][ks][0], af, acc[m][0]); acc[m][1] = MFMA16(sfr[dir][ks][1], af, acc[m][1]); } }
#pragma unroll
            for (int ks = 0; ks < 2; ++ks) { const bf16x8 b0 = ldsfrag(VT, PV, 32 * wave, 32 * ks, fr, fq), b1 = ldsfrag(VT, PV, 32 * wave + 16, 32 * ks, fr, fq);
#pragma unroll
                for (int m = 0; m < 4; ++m) { const bf16x8 af = ldsfrag(Pm + dir * 64 * PV, PV, 16 * m, 32 * ks, fr, fq); acc[m][0] = MFMA16(b0, af, acc[m][0]); acc[m][1] = MFMA16(b1, af, acc[m][1]); } } }
#pragma unroll
        for (int m = 0; m < 4; ++m) { float ss = 0.f;
#pragma unroll
            for (int n = 0; n < 2; ++n)
#pragma unroll
                for (int j = 0; j < 4; ++j) ss += acc[m][n][j] * acc[m][n][j];
            ss += __shfl_xor(ss, 16); ss += __shfl_xor(ss, 32);
            if (fq == 0) red[(16 * m + fr) * 8 + wave] = ss; }
        __syncthreads();
#pragma unroll
        for (int m = 0; m < 4; ++m) { const int t = 16 * m + fr; const f32x4 ra = *(const LAS f32x4*)(red + t * 8), rb = *(const LAS f32x4*)(red + t * 8 + 4);
            const float tot = ((ra.x + ra.y) + (ra.z + ra.w)) + ((rb.x + rb.y) + (rb.z + rb.w)); const float rstd = 1.0f / sqrtf(tot * (1.f / 256.f) + 1e-6f);
            const size_t row = r0 + t;
#pragma unroll
            for (int n = 0; n < 2; ++n) { const int dv = 32 * wave + 16 * n + 4 * fq; const f32x4 g = *(const f32x4*)(gn + dv); const v2u gt = *(const v2u*)(H + row * HP + C_AG + hd * 256 + dv);
                v2u w; w.x = pk2(acc[m][n][0] * rstd * g.x * bflo(gt.x), acc[m][n][1] * rstd * g.y * bfhi(gt.x)); w.y = pk2(acc[m][n][2] * rstd * g.z * bflo(gt.y), acc[m][n][3] * rstd * g.w * bfhi(gt.y));
                *(v2u*)(O + row * D + O_A + hd * 256 + dv) = w; } }
    }
#undef C3_LOAD
}

__global__ void __launch_bounds__(NWAVES * 64, 2) fwd_kernel(Args args) {
    extern __shared__ __attribute__((aligned(16))) unsigned char lds[];
    Frame F;
    F.lds = (LAS unsigned char*)lds;
    volatile LAS unsigned* MISC = (volatile LAS unsigned*)(F.lds + MISC_OFF);
    F.G = gridDim.x; { const int bx = blockIdx.x; F.vcu = (F.G % 8 == 0) ? (bx % 8) * (F.G / 8) + bx / 8 : bx; }
    unsigned char* ws = args.ws;
    gu32* ctl = (gu32*)(ws + WS_CTL);
    for (int u = threadIdx.x; u < (LDS_BYTES - LDSCTL_OFF) / 4; u += NWAVES * 64) ((LAS unsigned*)(F.lds + LDSCTL_OFF))[u] = 0u;
    __syncthreads();
    XcdBarrier bar; bar.bar = (unsigned*)(ctl + CW_BAR); bar.x = 0; bar.st = nullptr;
    if (N_LAUNCHES == 1) bar = xcd_barrier_post((unsigned*)(ctl + CW_BAR), MISC + 8);
    const int lo = args.ph_lo, hi = args.ph_hi;
#define IN(k) (lo <= (k) && (k) < hi)
#define REPS(bit) ((DUP_MASK & (bit)) ? (hi > 16 ? 2 : 1) : 1)
#define SEAM(k) do { if (IN(k) && IN((k) + 1)) xcd_barrier(bar); } while (0)

    if (IN(0)) { for (int rep = 0; rep < REPS(1); ++rep) phase_convert(F, args); }
    SEAM(0);
    for (int layer = 0; layer < DEPTH; ++layer) {
        const int pb = 1 + 8 * layer;
        if (IN(pb + 0)) { for (int rep = 0; rep < REPS(2); ++rep) phase_rmsnorm(F, args, layer); }
        SEAM(pb + 0);
        if (IN(pb + 1)) {
            pg8::Gemm g{(const bf16*)(ws + WS_XN), (const bf16*)(ws + WS_WIN + layer * (190 * MiB))};
            Sched1 S{(int)blockIdx.x, F.G};
            Epi1 E{(bf16*)(ws + WS_H), (float*)(ws + WS_LR), args.in[14] + layer * 3 * D};
            for (int rep = 0; rep < REPS(4); ++rep) pg8::gemm_phase<Epi1, Sched1, true, true>(F.lds + RING_OFF, g, S, E);
        }
        SEAM(pb + 1);
        if (IN(pb + 2)) { phase_prep(F, args, layer); }
        SEAM(pb + 2);
        if (IN(pb + 3)) {
#if MFMA_SGU
            for (int rep = 0; rep < REPS(16); ++rep) phase_sgu(F, args, layer);
#endif
#if MFMA_ATT
            for (int rep = 0; rep < REPS(32); ++rep) phase_attn(F, args, layer);
#endif
#if MFMA_GLA
            for (int rep = 0; rep < REPS(64); ++rep) phase_gla_c1(F, args, layer);
#else
            phase_mix_naive(F, args, layer);
#endif
        }
        SEAM(pb + 3);
        if (IN(pb + 4)) {
#if MFMA_GLA
            phase_gla_scan(F, args);
#endif
        }
        SEAM(pb + 4);
        if (IN(pb + 5)) {
#if MFMA_GLA
            for (int rep = 0; rep < REPS(128); ++rep) phase_gla_c3(F, args, layer);
#else
            phase_gla_fin(F, args, layer);
#endif
        }
        SEAM(pb + 5);
        if (IN(pb + 6)) {
            pg8::Gemm g{(const bf16*)(ws + WS_XN), (const bf16*)(ws + WS_WBR + layer * (32 * MiB))};
            Sched2 S{(int)blockIdx.x, F.G};
            Epi2 E{(const bf16*)(ws + WS_H), (bf16*)(ws + WS_MG)};
            for (int rep = 0; rep < REPS(256); ++rep) pg8::gemm_phase<Epi2, Sched2, true, true>(F.lds + RING_OFF, g, S, E);
        }
        SEAM(pb + 6);
        if (IN(pb + 7)) {
            pg8::Gemm g{(const bf16*)(ws + WS_MG), (const bf16*)(ws + WS_WOUT + layer * (32 * MiB))};
            Sched3 S{(int)blockIdx.x, F.G};
            Epi3 E{args.in[0], args.in[1], args.out, layer};
            for (int rep = 0; rep < (layer == 0 ? REPS(512) : 1); ++rep) pg8::gemm_phase<Epi3, Sched3, true, true>(F.lds + RING_OFF, g, S, E);
        }
        SEAM(pb + 7);
    }
#undef IN
#undef SEAM
}

extern "C" void kernel_launch(void* const* d_in, const int* in_sizes, int n_in, void* d_out, int out_size, void* d_ws, size_t ws_size, hipStream_t stream) {
    static int grid = 0;
    if (grid == 0) {
        if (n_in != 17 || ws_size < WS_END) { fprintf(stderr, "kernel_launch: bad inputs / workspace (%d, %zu < %zu)\n", n_in, ws_size, (size_t)WS_END); grid = -1; return; }
        int dev = 0, cus = 0;
        if (hipGetDevice(&dev) != hipSuccess || hipDeviceGetAttribute(&cus, hipDeviceAttributeMultiprocessorCount, dev) != hipSuccess) { grid = -1; return; }
        if (hipFuncSetAttribute((const void*)fwd_kernel, hipFuncAttributeMaxDynamicSharedMemorySize, LDS_BYTES) != hipSuccess) { grid = -1; return; }
        int per_cu = 0;
        (void)hipOccupancyMaxActiveBlocksPerMultiprocessor(&per_cu, (const void*)fwd_kernel, NWAVES * 64, LDS_BYTES);
        (void)hipGetLastError();
        grid = cus;
    }
    if (grid < 0) return;
    (void)hipMemsetAsync((char*)d_ws + WS_CTL, 0, CTL_ZERO_BYTES, stream);
    Args a{};
    for (int i = 0; i < 17; ++i) a.in[i] = (const float*)d_in[i];
    a.out = (float*)d_out; a.ws = (unsigned char*)d_ws;
    if (N_LAUNCHES == 1) { a.ph_lo = 0; a.ph_hi = N_PHASES; hipLaunchKernelGGL(fwd_kernel, dim3(grid), dim3(NWAVES * 64), LDS_BYTES, stream, a); }
    else for (int p = 0; p < N_PHASES; ++p) { a.ph_lo = p; a.ph_hi = p + 1; hipLaunchKernelGGL(fwd_kernel, dim3(grid), dim3(NWAVES * 64), LDS_BYTES, stream, a); }
}
```

```cpp
#include <hip/hip_runtime.h>
#include <cstdio>
#include <cstdint>

#ifndef MFMA_SGU
#define MFMA_SGU 1
#endif
#ifndef MFMA_ATT
#define MFMA_ATT 1
#endif
#ifndef ATT_FUSED_NORM
#define ATT_FUSED_NORM 0
#endif
#ifndef MFMA_GLA
#define MFMA_GLA 1
#endif
#ifndef KROT
#define KROT 0
#endif
#ifndef STAG2
#define STAG2 0
#endif
#ifndef STAG3
#define STAG3 0
#endif
#ifndef FP8_ATT
#define FP8_ATT 1
#endif
#ifndef F8_TILES
#define F8_TILES 64
#endif
#ifndef F8_OC
#define F8_OC 1
#endif
#ifndef DUP_MASK
#define DUP_MASK 0
#endif
#ifndef MK_N_LAUNCHES
#define MK_N_LAUNCHES 1
#endif

namespace pg8 {
#define PG8_LAS __attribute__((address_space(3)))
typedef unsigned short bf16_t;
typedef short bf16x8 __attribute__((ext_vector_type(8)));
typedef float f32x4 __attribute__((ext_vector_type(4)));
typedef unsigned u32x4 __attribute__((ext_vector_type(4)));
constexpr int BM = 256, BK = 64, HALF = 128, HTB = HALF * BK * 2, STAGE_BYTES = 8 * HTB, NXCD = 8, WGM = 8;

__host__ __device__ __forceinline__ int lds_byte(int r, int c) { const int st = (r >> 4) * 2 + (c >> 5), rr = r & 15, cc = c & 31, ob = rr * 64 + cc * 2; return st * 1024 + (ob ^ (((ob >> 9) & 1) << 5)); }
__host__ __device__ __forceinline__ void stage_rc(int b, int& R, int& C) { const int st = b / 1024, sb = b % 1024, swz = sb ^ (((sb >> 9) & 1) << 5); R = (st >> 1) * 16 + swz / 64; C = (st & 1) * 32 + (swz % 64) / 2; }
__host__ __device__ __forceinline__ int perm32(int rho) { const int n = rho >> 4, i = rho & 15; return 8 * (i >> 2) + 4 * n + (i & 3); }

__device__ __forceinline__ int lane_id_v() { int l; asm volatile("v_mbcnt_lo_u32_b32 %0, -1, 0\n\tv_mbcnt_hi_u32_b32 %0, -1, %0" : "=v"(l)); return l; }
struct Unit { int pm, pn, k0, nt, tag, rot; };
struct Gemm { const bf16_t* A; const bf16_t* Bt; const bf16_t* A8; static constexpr int lda = 4096, ldb = 4096; };

__host__ __device__ __forceinline__ void static_tile(int L, int nM, int nN, int& pm, int& pn) {
    const int nwg = nM * nN; int wgid = L;
    { const int q = nwg / NXCD, r = nwg % NXCD, xcd = wgid % NXCD, off = wgid / NXCD; wgid = (xcd < r ? xcd * (q + 1) : r * (q + 1) + (xcd - r) * q) + off; }
    const int nig = WGM * nN, gid = wgid / nig, fm = gid * WGM, gsz = (nM - fm) < WGM ? (nM - fm) : WGM;
    pm = fm + ((wgid % nig) % gsz); pn = (wgid % nig) / gsz;
}

typedef __bf16 bf16x2v __attribute__((ext_vector_type(2)));
typedef float f32x2v __attribute__((ext_vector_type(2)));
__device__ __forceinline__ unsigned cvt_pk_bf16(float lo, float hi) { const f32x2v v = {lo, hi}; return __builtin_bit_cast(unsigned, __builtin_convertvector(v, bf16x2v)); }

typedef int v8i_t __attribute__((ext_vector_type(8)));
typedef int v4i_t __attribute__((ext_vector_type(4)));
__device__ __forceinline__ f32x4 mfma_f8(bf16x8 b0, bf16x8 b1, bf16x8 a0, bf16x8 a1, f32x4 c) {
    const v8i_t bb = __builtin_shufflevector(__builtin_bit_cast(v4i_t, b0), __builtin_bit_cast(v4i_t, b1), 0, 1, 2, 3, 4, 5, 6, 7);
    const v8i_t aa = __builtin_shufflevector(__builtin_bit_cast(v4i_t, a0), __builtin_bit_cast(v4i_t, a1), 0, 1, 2, 3, 4, 5, 6, 7);
    return __builtin_amdgcn_mfma_scale_f32_16x16x128_f8f6f4(bb, aa, c, 0, 0, 0, 0x7F7F7F7F, 0, 0x7F7F7F7F);
}
template <class Epi, class Sched, bool ALIGN_EPI, bool SP2, bool F8 = false>
__device__ __forceinline__ void gemm_phase(PG8_LAS unsigned char* lds, const Gemm g, const Sched& S, const Epi& E, const int wv) {
    int tid_ = (wv << 6) + lane_id_v(); asm volatile("" : "+v"(tid_));
    const int tid = tid_, wid = __builtin_amdgcn_readfirstlane(tid >> 6), lane = tid & 63, wr = wid >> 2, wc = wid & 3, fr = lane & 15, fq = lane >> 4;
    unsigned voffA[2], voffB[2];
#pragma unroll
    for (int i = 0; i < 2; ++i) { int R, C; stage_rc(tid * 16 + i * 8192, R, C); const int Rb = Epi::PERM ? ((R & ~31) + perm32(R & 31)) : R;
        voffA[i] = (unsigned)(R * g.lda + C) * 2u; voffB[i] = (unsigned)(Rb * g.ldb + C) * 2u; }
    const size_t kstep = (size_t)(BK * 2);
    const size_t hstepA = (size_t)HALF * g.lda * 2, hstepB = (size_t)HALF * g.ldb * 2;
    const unsigned ldsw = (unsigned)wid * 1024u;
    const int aoff = lds_byte(wr * 64 + fr, fq * 8), boff = lds_byte(wc * 32 + fr, fq * 8);
    const int bdelta = (4 * wc - 8 * wr) * 1024; (void)bdelta;
#define PG8_SA(b, h) (((b) * 2 + (h)) * HTB)
#define PG8_SB(b, h) ((4 + (b) * 2 + (h)) * HTB)
#define PG8_STAGE(bufoff, gbase, voff) do { const char* _gb = (const char*)(gbase); asm volatile("" : "+s"(_gb)); _Pragma("unroll") for (int _i = 0; _i < 2; ++_i) { unsigned _vo = (voff)[_i]; asm volatile("" : "+v"(_vo)); \
        __builtin_amdgcn_global_load_lds((const unsigned*)(_gb + _vo), (PG8_LAS unsigned*)(lds + (bufoff) + ldsw + _i * 8192), 16, 0, 0); } } while (0)
#define PG8_LDA(dst, b, h) do { _Pragma("unroll") for (int m = 0; m < 4; ++m) _Pragma("unroll") for (int k = 0; k < 2; ++k) dst[m][k] = *(const PG8_LAS bf16x8*)(lds + PG8_SA(b, h) + aoff + m * 2048 + k * 1024); } while (0)
#define PG8_LDB(dst, b, h) do { int _bo = boff; if constexpr (Epi::F8_FROM >= 0) { _bo = aoff + bdelta; asm volatile("" : "+v"(_bo)); } _Pragma("unroll") for (int n = 0; n < 2; ++n) _Pragma("unroll") for (int k = 0; k < 2; ++k) dst[n][k] = *(const PG8_LAS bf16x8*)(lds + PG8_SB(b, h) + _bo + n * 2048 + k * 1024); } while (0)
#define PG8_MMA(ai, bj, At, Bt) do { __builtin_amdgcn_s_setprio(1); \
        if (lrskip && ((bj) != 0 || wc != 0)) { } else \
        if constexpr (F8) { _Pragma("unroll") for (int m = 0; m < 4; ++m) _Pragma("unroll") for (int n = 0; n < 2; ++n) acc[ai][bj][m][n] = mfma_f8(Bt[n][0], Bt[n][1], At[m][0], At[m][1], acc[ai][bj][m][n]); } \
        else if (Epi::F8_FROM >= 0 && f8seg) { _Pragma("unroll") for (int m = 0; m < 4; ++m) _Pragma("unroll") for (int n = 0; n < 2; ++n) acc[ai][bj][m][n] = mfma_f8(Bt[n][0], Bt[n][1], At[m][0], At[m][1], acc[ai][bj][m][n]); } \
        else { _Pragma("unroll") for (int m = 0; m < 4; ++m) _Pragma("unroll") for (int n = 0; n < 2; ++n) _Pragma("unroll") for (int k = 0; k < 2; ++k) \
        acc[ai][bj][m][n] = __builtin_amdgcn_mfma_f32_16x16x32_bf16(Bt[n][k], At[m][k], acc[ai][bj][m][n], 0, 0, 0); } __builtin_amdgcn_s_setprio(0); } while (0)
#define PG8_WAIT_V(n) asm volatile("s_waitcnt vmcnt(" #n ")" ::: "memory")
#define PG8_WAIT_L(n) asm volatile("s_waitcnt lgkmcnt(" #n ")" ::: "memory")
#define PG8_BAR __builtin_amdgcn_s_barrier()
#define PG8_SCHED __builtin_amdgcn_sched_barrier(0)
    Unit cur, nxt; int ui = 0;
    if (!S.next(0, cur)) return;
    f32x4 acc[2][2][4][2];
#pragma unroll
    for (int a = 0; a < 2; ++a)
#pragma unroll
        for (int b = 0; b < 2; ++b)
#pragma unroll
            for (int m = 0; m < 4; ++m)
#pragma unroll
                for (int n = 0; n < 2; ++n) acc[a][b][m][n] = (f32x4){0.f, 0.f, 0.f, 0.f};
    bf16x8 At[4][2], B0[2][2], B1[2][2];
    const char* cA = (const char*)(F8 ? g.A8 : g.A) + ((size_t)cur.pm * BM * g.lda + cur.k0) * 2; const char* cB = (const char*)g.Bt + ((size_t)(cur.pn * BM + (F8 ? cur.tag * HALF : 0)) * g.ldb + cur.k0) * 2;
    { const size_t o0 = (size_t)(cur.rot & (cur.nt - 1)) * kstep, o1 = (size_t)((cur.rot + 1) & (cur.nt - 1)) * kstep;
    if constexpr (SP2) {
        PG8_STAGE(PG8_SB(0, 0), cB + o0, voffB); PG8_STAGE(PG8_SB(0, 1), cB + hstepB + o0, voffB); PG8_STAGE(PG8_SA(0, 0), cA + o0, voffA); PG8_STAGE(PG8_SA(0, 1), cA + hstepA + o0, voffA);
        if (wr == 1) PG8_BAR;
        PG8_WAIT_V(2); PG8_BAR;
        PG8_STAGE(PG8_SB(1, 0), cB + o1, voffB); PG8_STAGE(PG8_SA(1, 0), cA + o1, voffA); PG8_STAGE(PG8_SB(1, 1), cB + hstepB + o1, voffB);
        PG8_WAIT_V(6); PG8_BAR;
    } else {
        PG8_STAGE(PG8_SB(0, 0), cB + o0, voffB); PG8_STAGE(PG8_SA(0, 0), cA + o0, voffA); PG8_STAGE(PG8_SB(0, 1), cB + hstepB + o0, voffB); PG8_STAGE(PG8_SA(0, 1), cA + hstepA + o0, voffA);
        if (wr == 1) PG8_BAR;
        PG8_WAIT_V(4); PG8_BAR;
        PG8_STAGE(PG8_SB(1, 0), cB + o1, voffB); PG8_STAGE(PG8_SA(1, 0), cA + o1, voffA); PG8_STAGE(PG8_SB(1, 1), cB + hstepB + o1, voffB);
        PG8_WAIT_V(6); PG8_BAR;
    } }
    for (;;) {
        const bool has_next = S.next(ui + 1, nxt);
        const char* nA = has_next ? (const char*)(F8 ? g.A8 : g.A) + ((size_t)nxt.pm * BM * g.lda + nxt.k0) * 2 : cA; const char* nB = has_next ? (const char*)g.Bt + ((size_t)(nxt.pn * BM + (F8 ? nxt.tag * HALF : 0)) * g.ldb + nxt.k0) * 2 : cB;
        const int nt = cur.nt, rot = cur.rot, msk = nt - 1;
        const size_t n0 = has_next ? (size_t)(nxt.rot & (nxt.nt - 1)) * kstep : (size_t)(rot & msk) * kstep, n1 = has_next ? (size_t)((nxt.rot + 1) & (nxt.nt - 1)) * kstep : (size_t)((rot + 1) & msk) * kstep;
#define PG8_BODY(F8SEG, LRS) { \
            constexpr bool lrskip = (LRS); (void)lrskip; \
            if constexpr (Epi::HAS_MID) { if (t == Epi::MID0 || t == Epi::MID1) E.mid(acc, cur, t, wr, wc, fr, fq); } \
            constexpr bool f8seg = (F8SEG); (void)f8seg; \
            const bool last = (t == nt - 2); \
            const size_t k1 = rot ? (size_t)((t + 1 + rot) & msk) * kstep : (size_t)(t + 1) * kstep, k2 = rot ? (size_t)((t + 2 + rot) & msk) * kstep : (size_t)(t + 2) * kstep, k3 = rot ? (size_t)((t + 3 + rot) & msk) * kstep : (size_t)(t + 3) * kstep; \
            const char* a1 = cA + k1; \
            const char* a2 = last ? nA + n0 : cA + k2; const char* b2 = last ? nB + n0 : cB + k2; \
            const char* a3 = last ? nA + n1 : cA + k3; const char* b3 = last ? nB + n1 : cB + k3; \
            if constexpr (SP2) { \
            PG8_LDB(B0, 0, 0); PG8_LDB(B1, 0, 1); PG8_SCHED; PG8_LDA(At, 0, 0); PG8_STAGE(PG8_SA(1, 1), a1 + hstepA, voffA); \
            PG8_WAIT_V(8); PG8_WAIT_L(0); PG8_BAR; PG8_MMA(0, 0, At, B0); PG8_MMA(0, 1, At, B1); PG8_BAR; PG8_SCHED; \
            PG8_LDA(At, 0, 1); PG8_STAGE(PG8_SB(0, 0), b2, voffB); PG8_STAGE(PG8_SB(0, 1), b2 + hstepB, voffB); PG8_STAGE(PG8_SA(0, 0), a2, voffA); \
            PG8_WAIT_V(8); PG8_WAIT_L(0); PG8_BAR; PG8_MMA(1, 0, At, B0); PG8_MMA(1, 1, At, B1); PG8_BAR; PG8_SCHED; \
            PG8_LDB(B0, 1, 0); PG8_LDB(B1, 1, 1); PG8_SCHED; PG8_LDA(At, 1, 0); PG8_STAGE(PG8_SA(0, 1), a2 + hstepA, voffA); \
            PG8_WAIT_V(8); PG8_WAIT_L(0); PG8_BAR; PG8_MMA(0, 0, At, B0); PG8_MMA(0, 1, At, B1); PG8_BAR; PG8_SCHED; \
            PG8_LDA(At, 1, 1); PG8_STAGE(PG8_SB(1, 0), b3, voffB); PG8_STAGE(PG8_SB(1, 1), b3 + hstepB, voffB); PG8_STAGE(PG8_SA(1, 0), a3, voffA); \
            PG8_WAIT_V(8); PG8_WAIT_L(0); PG8_BAR; PG8_MMA(1, 0, At, B0); PG8_MMA(1, 1, At, B1); PG8_BAR; PG8_SCHED; \
            } else { \
            PG8_LDB(B0, 0, 0); PG8_SCHED; PG8_LDA(At, 0, 0); PG8_STAGE(PG8_SA(1, 1), a1 + hstepA, voffA); \
            PG8_WAIT_L(8); PG8_BAR; PG8_WAIT_L(0); PG8_MMA(0, 0, At, B0); PG8_BAR; PG8_SCHED; \
            PG8_LDB(B1, 0, 1); PG8_STAGE(PG8_SB(0, 0), b2, voffB); \
            PG8_BAR; PG8_WAIT_L(0); PG8_MMA(0, 1, At, B1); PG8_BAR; \
            PG8_LDA(At, 0, 1); PG8_STAGE(PG8_SA(0, 0), a2, voffA); \
            PG8_BAR; PG8_WAIT_L(0); PG8_MMA(1, 0, At, B0); PG8_BAR; PG8_SCHED; \
            PG8_STAGE(PG8_SB(0, 1), b2 + hstepB, voffB); \
            PG8_WAIT_V(6); PG8_BAR; PG8_MMA(1, 1, At, B1); PG8_BAR; \
            PG8_LDB(B0, 1, 0); PG8_SCHED; PG8_LDA(At, 1, 0); PG8_STAGE(PG8_SA(0, 1), a2 + hstepA, voffA); \
            PG8_WAIT_L(8); PG8_BAR; PG8_WAIT_L(0); PG8_MMA(0, 0, At, B0); PG8_BAR; PG8_SCHED; \
            PG8_LDB(B1, 1, 1); PG8_STAGE(PG8_SB(1, 0), b3, voffB); \
            PG8_BAR; PG8_WAIT_L(0); PG8_MMA(0, 1, At, B1); PG8_BAR; \
            PG8_LDA(At, 1, 1); PG8_STAGE(PG8_SA(1, 0), a3, voffA); \
            PG8_BAR; PG8_WAIT_L(0); PG8_MMA(1, 0, At, B0); PG8_BAR; PG8_SCHED; \
            PG8_STAGE(PG8_SB(1, 1), b3 + hstepB, voffB); \
            PG8_WAIT_V(6); PG8_BAR; PG8_MMA(1, 1, At, B1); PG8_BAR; \
            } \
        }
        if constexpr (Epi::F8_FROM >= 0) {
            for (int t = 0; t < Epi::F8_FROM; t += 2) PG8_BODY(false, false)
            for (int t = Epi::F8_FROM; t < nt; t += 2) PG8_BODY(true, false)
        } else if constexpr (Epi::LR_PN >= 0) {
            if (cur.pn == Epi::LR_PN) { for (int t = 0; t < nt; t += 2) PG8_BODY(false, true) }
            else { for (int t = 0; t < nt; t += 2) PG8_BODY(false, false) }
        } else {
            for (int t = 0; t < nt; t += 2) PG8_BODY(false, false)
        }
#undef PG8_BODY
        if constexpr (ALIGN_EPI) { if (wr == 0) PG8_BAR; }
        E(acc, cur, wr, wc, fr, fq);
        if (!has_next) break;
#pragma unroll
        for (int a = 0; a < 2; ++a)
#pragma unroll
            for (int b = 0; b < 2; ++b)
#pragma unroll
                for (int m = 0; m < 4; ++m)
#pragma unroll
                    for (int n = 0; n < 2; ++n) acc[a][b][m][n] = (f32x4){0.f, 0.f, 0.f, 0.f};
        cur = nxt; cA = nA; cB = nB; ++ui;
        if constexpr (ALIGN_EPI) { if (wr == 1) PG8_BAR; }
    }
    PG8_WAIT_V(0);
    if constexpr (!ALIGN_EPI) { if (wr == 0) PG8_BAR; }
    PG8_BAR;
#undef PG8_SA
#undef PG8_SB
#undef PG8_STAGE
#undef PG8_LDA
#undef PG8_LDB
#undef PG8_MMA
#undef PG8_WAIT_V
#undef PG8_WAIT_L
#undef PG8_BAR
#undef PG8_SCHED
}
}
using pg8::lane_id_v;

constexpr int NWAVES = 8;
constexpr int T = 32768, TP = 16384;
constexpr int D = 4096, NIN = 24096, DEPTH = 2;
constexpr int HP = 11776;
constexpr int NBROWS = 24320;
constexpr int C_AQ = 0, C_AK = 768, C_AV = 1536, C_AG = 3072, C_BU = 4608, C_BV = 5632, C_BG = 6656, C_CQ = 7680, C_CK = 9216, C_CV = 9728, C_CG = 10240, C_GM = 11776, C_LR = 24064;
constexpr int O_A = 0, O_B = 1536, O_C = 2560;
constexpr int F8_LO = 30, F8_N = F8_TILES, F8_HI = F8_LO + F8_N;
constexpr int N_PHASES = 17;
constexpr int N_LAUNCHES = MK_N_LAUNCHES;

constexpr size_t MiB = 1u << 20;
constexpr size_t WS_CTL = 0, CTL_ZERO_BYTES = 1 * MiB;
constexpr size_t WS_ROPE = 1 * MiB;
constexpr size_t WS_WIN = 3 * MiB, WIN_BYTES = (size_t)NBROWS * D * 2;
constexpr size_t WS_WBR = WS_WIN + 2 * 190 * MiB, WSQ_BYTES = (size_t)D * D * 2;
constexpr size_t WS_WOUT = WS_WBR + 64 * MiB;
constexpr size_t WS_XN = WS_WOUT + 64 * MiB;
constexpr size_t WS_H = WS_XN + 256 * MiB;
constexpr size_t WS_G = WS_H + 736 * MiB;
constexpr size_t WS_ST = WS_G + 768 * MiB;
constexpr size_t WS_MG = WS_ST + 384 * MiB;
constexpr size_t WS_LR = WS_MG + 256 * MiB;
constexpr size_t WS_DECC = WS_LR + 8 * MiB;
constexpr size_t WS_END = WS_DECC + 4 * MiB;
static_assert(WIN_BYTES <= 190 * MiB && (size_t)T * HP * 2 <= 736 * MiB && (size_t)T * 12288 * 2 <= 768 * MiB, "ws map");
__device__ __forceinline__ size_t gate_off(int b, int pm, int ct, int ai, int m, int bj, int wr, int wc, int fr, int fq) {
    return ((((size_t)(b * 128 + pm) * 16 + ct) * 16 + (size_t)((ai * 4 + m) * 2 + bj)) * 512 + (size_t)(((wr * 4 + wc) * 4 + fq) * 16 + fr)) * 16; }
constexpr int CW_TMO = 0, CW_CODE = 1;
constexpr int CW_BAR = 4096;

constexpr int RING_OFF = 0, RING_BYTES = 131072;
constexpr int LDSCTL_OFF = RING_BYTES, MISC_OFF = LDSCTL_OFF + 320;
constexpr int LDS_BYTES = 147456;

#define GAS __attribute__((address_space(1)))
#define LAS __attribute__((address_space(3)))
typedef unsigned short bf16;
typedef unsigned v4u __attribute__((ext_vector_type(4)));
typedef unsigned v2u __attribute__((ext_vector_type(2)));
typedef float f32x4 __attribute__((ext_vector_type(4)));
typedef GAS unsigned gu32;
#define RLX_AGENT __ATOMIC_RELAXED, __HIP_MEMORY_SCOPE_AGENT
#define LDS_WAIT() asm volatile("s_waitcnt lgkmcnt(0)" ::: "memory")
#define VM_WAIT() asm volatile("s_waitcnt vmcnt(0)" ::: "memory")
__device__ __forceinline__ unsigned f2bf(float f) { unsigned u = __builtin_bit_cast(unsigned, f); return (u + 0x7fffu + ((u >> 16) & 1u)) >> 16; }
__device__ __forceinline__ unsigned pk2(float lo, float hi) { return pg8::cvt_pk_bf16(lo, hi); }
__device__ __forceinline__ float bflo(unsigned w) { return __uint_as_float(w << 16); }
__device__ __forceinline__ float bfhi(unsigned w) { return __uint_as_float(w & 0xffff0000u); }
__device__ __forceinline__ float bf1(bf16 v) { return __uint_as_float((unsigned)v << 16); }
__device__ __forceinline__ void unpack8(const v4u w, float* x) { x[0] = bflo(w.x); x[1] = bfhi(w.x); x[2] = bflo(w.y); x[3] = bfhi(w.y); x[4] = bflo(w.z); x[5] = bfhi(w.z); x[6] = bflo(w.w); x[7] = bfhi(w.w); }
__device__ __forceinline__ float sigm(float x) { return __builtin_amdgcn_rcpf(1.0f + __builtin_amdgcn_exp2f(-1.44269504089f * x)); }

#define XB_TMO      128
#define XB_XCNT(j)  (256  + 64 * (j))
#define XB_XSUB(j)  (1280 + 64 * (j))
#define XB_XGEN(j)  (2304 + 64 * (j))
#define XB_TOP      3328
#define XB_TOPGEN   3392
#define XCD_BAR_WORDS 3456
#define XB_SPIN_CAP (1u << 24)
__device__ __forceinline__ unsigned xb_ld(unsigned* p)              { return __hip_atomic_load(p, __ATOMIC_RELAXED, __HIP_MEMORY_SCOPE_AGENT); }
__device__ __forceinline__ unsigned xb_add(unsigned* p, unsigned v) { return __hip_atomic_fetch_add(p, v, __ATOMIC_RELAXED, __HIP_MEMORY_SCOPE_AGENT); }
__device__ __forceinline__ unsigned xb_xcc_id() { return (unsigned)__builtin_amdgcn_s_getreg((3 << 11) | 20) & 0xFu; }
#define XB_SPIN(cond, bar) do { unsigned _sp = 0; while (cond) { __builtin_amdgcn_s_sleep(1); \
    if ((++_sp & 255u) == 0u) { if (xb_ld(&(bar)[XB_TMO])) break; if (_sp > XB_SPIN_CAP) { atomicAdd(&(bar)[XB_TMO], 1u); break; } } } } while (0)
struct XcdBarrier { unsigned* bar; unsigned x; volatile LAS unsigned* st; int wv; };
__device__ __forceinline__ XcdBarrier xcd_barrier_post(unsigned* bar, volatile LAS unsigned* st, int wv) {
    XcdBarrier b; b.bar = bar; b.x = xb_xcc_id(); b.st = st; b.wv = wv;
    if (threadIdx.x == 0) (void)xb_add(&bar[XB_XCNT(b.x)], 1u);
    return b;
}
__device__ __forceinline__ void xcd_barrier_complete(unsigned* bar, unsigned x, unsigned& nloc, unsigned& nx) {
    const unsigned G = gridDim.x * gridDim.y * gridDim.z;
    unsigned sum, cnt, mine, sp = 0u;
    for (;;) {
        sum = 0u; cnt = 0u; mine = 0u;
#pragma unroll
        for (unsigned j = 0; j < 16; ++j) { const unsigned c = xb_ld(&bar[XB_XCNT(j)]); sum += c; cnt += (c > 0u) ? 1u : 0u; mine = (j == x) ? c : mine; }
        if (sum == G) break;
        __builtin_amdgcn_s_sleep(1);
        if ((++sp & 255u) == 0u) { if (xb_ld(&bar[XB_TMO])) break; if (sp > XB_SPIN_CAP) { atomicAdd(&bar[XB_TMO], 1u); break; } }
    }
    nloc = mine > 0u ? mine : 1u; nx = cnt > 0u ? cnt : 1u;
}
__device__ __forceinline__ void xcd_barrier(const XcdBarrier& b) {
    asm volatile("s_waitcnt vmcnt(0)" ::: "memory");
    __syncthreads();
    if (((b.wv << 6) + lane_id_v()) == 0) {
        unsigned* bar = b.bar; asm volatile("" : "+s"(bar));
        __builtin_amdgcn_s_waitcnt(0);
        unsigned nloc = b.st[0], nx = b.st[1];
        if (nloc == 0u) { xcd_barrier_complete(bar, b.x, nloc, nx); b.st[0] = nloc; b.st[1] = nx; }
        const unsigned old = xb_add(&bar[XB_XSUB(b.x)], 1u);
        const unsigned gen = old / nloc;
        if (old + 1u == (gen + 1u) * nloc) {
            __builtin_amdgcn_fence(__ATOMIC_RELEASE, "agent");
            asm volatile("s_waitcnt vmcnt(0)" ::: "memory");
            const unsigned og = xb_add(&bar[XB_TOP], 1u);
            const unsigned tg = og / nx;
            if (og + 1u == (tg + 1u) * nx) xb_add(&bar[XB_TOPGEN], 1u);
            else XB_SPIN(xb_ld(&bar[XB_TOPGEN]) == tg, bar);
            __builtin_amdgcn_fence(__ATOMIC_ACQUIRE, "agent");
            xb_add(&bar[XB_XGEN(b.x)], 1u);
            asm volatile("s_waitcnt vmcnt(0)" ::: "memory");
        } else {
            XB_SPIN(xb_ld(&bar[XB_XGEN(b.x)]) == gen, bar);
            __builtin_amdgcn_fence(__ATOMIC_ACQUIRE, "agent");
            asm volatile("s_waitcnt vmcnt(0)" ::: "memory");
        }
    }
    __syncthreads();
}

struct Args { const float* in[17]; float* out; unsigned char* ws; int ph_lo, ph_hi; };
struct Frame {
    LAS unsigned char* lds;
    int vcu, G, wv;
};
#define PHASE_IDS() int tid_ = (F.wv << 6) + lane_id_v(); asm volatile("" : "+v"(tid_)); const int tid = tid_, lane = tid & 63, wave = __builtin_amdgcn_readfirstlane(tid >> 6); (void)tid; (void)lane; (void)wave
template <int M> __device__ __forceinline__ float shx(float v) { return __builtin_bit_cast(float, __builtin_amdgcn_ds_swizzle(__builtin_bit_cast(int, v), (M << 10) | 0x1f)); }
__device__ __forceinline__ int lane32x() { return (lane_id_v() ^ 32) << 2; }
__device__ __forceinline__ float xch32(float v, bool) { return __builtin_bit_cast(float, __builtin_amdgcn_ds_bpermute(lane32x(), __builtin_bit_cast(int, v))); }
__device__ __forceinline__ float sum32(float v) { return v + xch32(v, false); }
__device__ __forceinline__ float max32(float v) { return fmaxf(v, xch32(v, false)); }
__device__ __forceinline__ float wave_sum(float v) { v += shx<1>(v); v += shx<2>(v); v += shx<4>(v); v += shx<8>(v); v += shx<16>(v); return sum32(v); }
__device__ __forceinline__ float wave_max(float v) { v = fmaxf(v, shx<1>(v)); v = fmaxf(v, shx<2>(v)); v = fmaxf(v, shx<4>(v)); v = fmaxf(v, shx<8>(v)); v = fmaxf(v, shx<16>(v)); return max32(v); }

struct CvtItem { const float* W; const float* kgain; bf16* WT; int Nsrc, nsrc0, ndst0, k0, f8, kd; };
__device__ __forceinline__ CvtItem cvt_decode(const Args& a, int it) {
    constexpr int I_IN = 64 * (NBROWS / 32), I_SQ = 64 * (D / 32), I_L = I_IN + 2 * I_SQ;
    CvtItem c; const int l = it / I_L; int r = it - l * I_L;
    if (r < I_IN) { const int nb = r % (NBROWS / 32), kb = r / (NBROWS / 32), nm = nb * 32;
        c.W = a.in[3] + (size_t)l * D * NIN; c.Nsrc = NIN; c.nsrc0 = nm < 3072 ? nm : (nm < C_LR ? nm + 32 : (nm < C_LR + 32 ? 3072 + (nm - C_LR) : -1));
        c.kgain = a.in[2] + l * D; c.WT = (bf16*)(a.ws + WS_WIN + l * (190 * MiB)); c.ndst0 = nm; c.k0 = kb * 64; c.kd = c.k0; c.f8 = (FP8_ATT && nm >= F8_LO * 256 && nm < F8_HI * 256) ? 1 : 0; return c; }
    r -= I_IN; const bool br = r < I_SQ; if (!br) r -= I_SQ;
    const int nb = r % (D / 32), kb = r / (D / 32);
    c.W = a.in[br ? 15 : 16] + (size_t)l * D * D; c.Nsrc = D; c.nsrc0 = nb * 32; c.kgain = nullptr; c.WT = (bf16*)(a.ws + (br ? WS_WBR : WS_WOUT) + l * (32 * MiB)); c.ndst0 = nb * 32; c.k0 = kb * 64; c.kd = c.k0; c.f8 = 0;
    if (F8_OC && br && c.k0 >= 2560) { c.f8 = 1; c.kd = 5120 + (c.k0 - 2560); }
    return c;
}
__device__ __forceinline__ void cvt_load(const CvtItem& c, int lane, f32x4 (&v)[8]) {
    const int kr = lane >> 3, nq = (lane & 7) * 4;
#pragma unroll
    for (int i = 0; i < 8; ++i) { v[i] = (f32x4){0.f, 0.f, 0.f, 0.f};
        if (c.nsrc0 >= 0) { v[i] = *(const f32x4*)(c.W + (size_t)(c.k0 + kr + 8 * i) * c.Nsrc + c.nsrc0 + nq); if (c.kgain) v[i] = v[i] * c.kgain[c.k0 + kr + 8 * i]; } }
}
__device__ __forceinline__ void cvt_store(const CvtItem& c, int lane, const f32x4 (&v)[8], LAS float* scr) {
    const int kr = lane >> 3, nq = (lane & 7) * 4;
#pragma unroll
    for (int i = 0; i < 8; ++i) { LAS float* d = scr + (kr + 8 * i) * 33 + nq; d[0] = v[i].x; d[1] = v[i].y; d[2] = v[i].z; d[3] = v[i].w; }
    LDS_WAIT(); asm volatile("" ::: "memory");
    const int cc = lane & 7;
#pragma unroll
    for (int j = 0; j < 4; ++j) { const int n = (lane >> 3) + 8 * j; const LAS float* s = scr + (8 * cc) * 33 + n;
        if (c.f8) {
            int w0 = 0, w1 = 0;
#define F8C(x) __builtin_amdgcn_fmed3f(64.f * (x), -448.f, 448.f)
            w0 = __builtin_amdgcn_cvt_pk_fp8_f32(F8C(s[0 * 33]), F8C(s[1 * 33]), w0, false); w0 = __builtin_amdgcn_cvt_pk_fp8_f32(F8C(s[2 * 33]), F8C(s[3 * 33]), w0, true);
            w1 = __builtin_amdgcn_cvt_pk_fp8_f32(F8C(s[4 * 33]), F8C(s[5 * 33]), w1, false); w1 = __builtin_amdgcn_cvt_pk_fp8_f32(F8C(s[6 * 33]), F8C(s[7 * 33]), w1, true);
#undef F8C
            v2u o2; o2.x = (unsigned)w0; o2.y = (unsigned)w1;
            *(GAS v2u*)((GAS unsigned char*)c.WT + (size_t)(c.ndst0 + n) * 8192 + c.kd + 8 * cc) = o2;
        } else {
        v4u o; o.x = pk2(s[0 * 33], s[1 * 33]); o.y = pk2(s[2 * 33], s[3 * 33]); o.z = pk2(s[4 * 33], s[5 * 33]); o.w = pk2(s[6 * 33], s[7 * 33]);
        *(GAS v4u*)(c.WT + (size_t)(c.ndst0 + n) * D + c.kd + 8 * cc) = o; } }
    LDS_WAIT(); asm volatile("" ::: "memory");
}
__device__ __forceinline__ void phase_convert(Frame& F, const Args& a) {
    PHASE_IDS();
    LAS float* scr = (LAS float*)(F.lds + RING_OFF + wave * 16384);
    const int gw = F.vcu * NWAVES + wave, NGW = F.G * NWAVES;
    constexpr int I_IN = 64 * (NBROWS / 32), I_SQ = 64 * (D / 32), I_L = I_IN + 2 * I_SQ, NIT = DEPTH * I_L;
    if (gw < NIT) {
        CvtItem cur = cvt_decode(a, gw); f32x4 v[8]; cvt_load(cur, lane, v);
        for (int it = gw; it < NIT; it += NGW) {
            const int itn = it + NGW; CvtItem nxt = cur; f32x4 vn[8];
            if (itn < NIT) { nxt = cvt_decode(a, itn); cvt_load(nxt, lane, vn); }
            cvt_store(cur, lane, v, scr);
            cur = nxt;
#pragma unroll
            for (int i = 0; i < 8; ++i) v[i] = vn[i];
        }
    }
    float2* rt = (float2*)(a.ws + WS_ROPE);
    for (int e = (F.vcu * NWAVES + wave) * 64 + lane; e < 16384 * 16; e += F.G * NWAVES * 64) {
        const int pos = e >> 4, i = e & 15;
        const float inv = (float)pow(500000.0, -(double)(2 * i) / 32.0);
        const float ang = (float)pos * inv;
        double sn, cs; sincos((double)ang, &sn, &cs);
        rt[e] = make_float2((float)cs, (float)sn);
    }
}

__device__ __forceinline__ void phase_rmsnorm(Frame& F, const Args& a, int layer) {
    PHASE_IDS();
    const int gw = F.vcu * NWAVES + wave, NGW = F.G * NWAVES;
    bf16* XN = (bf16*)(a.ws + WS_XN);
    for (int m = gw; m < T; m += NGW) {
        const float* xrow = layer == 0 ? (m < TP ? a.in[0] + (size_t)m * D : a.in[1] + (size_t)(m - TP) * D) : a.out + (size_t)m * D;
        const GAS f32x4* xr = (const GAS f32x4*)xrow + lane;
        f32x4 v[16]; float s = 0.f;
#pragma unroll
        for (int j = 0; j < 16; ++j) { v[j] = xr[64 * j]; s += (v[j].x * v[j].x + v[j].y * v[j].y) + (v[j].z * v[j].z + v[j].w * v[j].w); }
        const float rstd = 1.0f / sqrtf(wave_sum(s) * (1.f / D) + 1e-6f);
        GAS v2u* o8 = (GAS v2u*)(XN + (size_t)m * D) + lane;
#pragma unroll
        for (int j = 0; j < 16; ++j) { v2u w; w.x = pk2(v[j].x * rstd, v[j].y * rstd); w.y = pk2(v[j].z * rstd, v[j].w * rstd); o8[64 * j] = w; }
#if FP8_ATT
        GAS unsigned* f8p = (GAS unsigned*)(a.ws + WS_MG + (size_t)m * 8192) + lane;
#pragma unroll
        for (int j = 0; j < 16; ++j) { int w = 0; w = __builtin_amdgcn_cvt_pk_fp8_f32(v[j].x * rstd, v[j].y * rstd, w, false); w = __builtin_amdgcn_cvt_pk_fp8_f32(v[j].z * rstd, v[j].w * rstd, w, true); f8p[64 * j] = (unsigned)w; }
#endif
    }
}

struct Sched1 {
    int c, G;
    __device__ __forceinline__ bool next(int i, pg8::Unit& u) const {
        constexpr int NT = FP8_ATT ? 94 - F8_N : 94;
        const bool hf = (c & 1) && G == 256;
        u.rot = 0;
        if (hf) { if (i == 0) { u.pm = c >> 1; u.pn = 94; u.k0 = 2048; u.nt = 32; u.tag = 1; return true; } i -= 1; }
        long L = (long)i * G + c;
        if (L < 128 * NT) { pg8::static_tile((int)L, 128, NT, u.pm, u.pn); if (FP8_ATT && u.pn >= F8_LO) u.pn += F8_N; u.k0 = 0; u.nt = 64; u.tag = 0; u.rot = KROT * (c & 7); return true; }
        if (hf) return false;
        L -= 128 * NT;
        if (G == 256) { if (L < 256 && !(L & 1)) { u.pm = (int)(L >> 1); u.pn = 94; u.k0 = 0; u.nt = 32; u.tag = 0; return true; } return false; }
        if (L < 256) { u.pm = (int)(L >> 1); u.pn = 94; u.k0 = (int)(L & 1) * 2048; u.nt = 32; u.tag = (int)(L & 1); return true; }
        return false;
    }
};
struct Sched1F8 {
    int c, G;
    __device__ __forceinline__ bool next(int i, pg8::Unit& u) const {
        const long L = (long)i * G + c; if (L >= 128 * F8_N) return false;
        pg8::static_tile((int)L, 128, F8_N, u.pm, u.pn); u.pn += F8_LO; u.k0 = 0; u.nt = 32; u.tag = 0; u.rot = 0; return true;
    }
};
struct Sched2 {
    int c, G;
    __device__ __forceinline__ bool next(int i, pg8::Unit& u) const {
        const long L = (long)i * G + c; if (L >= 128 * 16) return false;
        pg8::static_tile((int)L, 128, 16, u.pm, u.pn); u.k0 = 0; u.nt = F8_OC ? 52 : 64; u.tag = 0; u.rot = 0; return true;
    }
};
struct Sched3 {
    int c, G;
    __device__ __forceinline__ bool next(int i, pg8::Unit& u) const {
        const long L = (long)i * G + c; if (L >= 128 * 16) return false;
        pg8::static_tile((int)L, 128, 16, u.pm, u.pn); u.k0 = 0; u.nt = 64; u.tag = 0; u.rot = KROT * (c & 7); return true;
    }
};
struct Epi1 {
    static constexpr bool PERM = true, HAS_MID = false; static constexpr int MID0 = -1, MID1 = -1, F8_FROM = -1, LR_PN = 94;
    bf16* H; float* LR; const float* gbias; unsigned char* G;
    __device__ __forceinline__ void operator()(const f32x4 (&acc)[2][2][4][2], const pg8::Unit& u, int wr, int wc, int fr, int fq) const {
        using namespace pg8;
        const int row0 = u.pm * BM + wr * 64 + fr;
        if (u.pn == 94) {
            if (wc == 0) { float* base = LR + (size_t)u.tag * T * 32 + 8 * fq;
#pragma unroll
                for (int ai = 0; ai < 2; ++ai)
#pragma unroll
                    for (int m = 0; m < 4; ++m) { float* rp = base + (size_t)(row0 + ai * HALF + m * 16) * 32;
                        *(f32x4*)rp = acc[ai][0][m][0]; *(f32x4*)(rp + 4) = acc[ai][0][m][1]; } }
            return;
        }
        const int pn = u.pn;
        const int act = pn < 12 ? 0 : (pn < 18 ? 1 : (pn < 26 ? 2 : (pn < 30 ? 1 : (pn < 40 ? 0 : (pn < 46 ? 1 : 3)))));
        const int col0 = pn * BM + wc * 32 + 8 * fq;
        if (act == 0) {
#pragma unroll
            for (int ai = 0; ai < 2; ++ai)
#pragma unroll
                for (int m = 0; m < 4; ++m) { bf16* rowp = H + (size_t)(row0 + ai * HALF + m * 16) * HP + col0;
#pragma unroll
                    for (int bj = 0; bj < 2; ++bj) { const f32x4 v0 = acc[ai][bj][m][0], v1 = acc[ai][bj][m][1];
                        u32x4 w; w.x = cvt_pk_bf16(v0[0], v0[1]); w.y = cvt_pk_bf16(v0[2], v0[3]); w.z = cvt_pk_bf16(v1[0], v1[1]); w.w = cvt_pk_bf16(v1[2], v1[3]);
                        __builtin_nontemporal_store(w, (u32x4*)(rowp + bj * HALF)); } }
            return;
        }
        if (act == 3) {
            f32x4 bv[2][2];
#pragma unroll
            for (int bj = 0; bj < 2; ++bj)
#pragma unroll
                for (int n = 0; n < 2; ++n) bv[bj][n] = *(const f32x4*)(gbias + (pn - 46) * BM + wc * 32 + 8 * fq + bj * HALF + 4 * n);
            const int gb = (pn - 46) >> 4, gct = (pn - 46) & 15;
#pragma unroll
            for (int ai = 0; ai < 2; ++ai)
#pragma unroll
                for (int m = 0; m < 4; ++m) {
#pragma unroll
                    for (int bj = 0; bj < 2; ++bj) { float x[8];
#pragma unroll
                        for (int j = 0; j < 4; ++j) { x[j] = sigm(acc[ai][bj][m][0][j] + bv[bj][0][j]); x[4 + j] = sigm(acc[ai][bj][m][1][j] + bv[bj][1][j]); }
                        u32x4 w; w.x = cvt_pk_bf16(x[0], x[1]); w.y = cvt_pk_bf16(x[2], x[3]); w.z = cvt_pk_bf16(x[4], x[5]); w.w = cvt_pk_bf16(x[6], x[7]);
                        __builtin_nontemporal_store(w, (u32x4*)(G + gate_off(gb, u.pm, gct, ai, m, bj, wr, wc, fr, fq))); } }
        } else if (act == 1) {
#pragma unroll
            for (int ai = 0; ai < 2; ++ai)
#pragma unroll
                for (int m = 0; m < 4; ++m) { bf16* rowp = H + (size_t)(row0 + ai * HALF + m * 16) * HP + col0;
#pragma unroll
                    for (int bj = 0; bj < 2; ++bj) { float x[8];
#pragma unroll
                        for (int j = 0; j < 4; ++j) { const float a0 = acc[ai][bj][m][0][j], a1 = acc[ai][bj][m][1][j]; x[j] = a0 * sigm(a0); x[4 + j] = a1 * sigm(a1); }
                        u32x4 w; w.x = cvt_pk_bf16(x[0], x[1]); w.y = cvt_pk_bf16(x[2], x[3]); w.z = cvt_pk_bf16(x[4], x[5]); w.w = cvt_pk_bf16(x[6], x[7]);
                        __builtin_nontemporal_store(w, (u32x4*)(rowp + bj * HALF)); } }
        } else {
#pragma unroll
            for (int ai = 0; ai < 2; ++ai)
#pragma unroll
                for (int m = 0; m < 4; ++m) { bf16* rowp = H + (size_t)(row0 + ai * HALF + m * 16) * HP + col0;
#pragma unroll
                    for (int bj = 0; bj < 2; ++bj) { float x[8];
#pragma unroll
                        for (int j = 0; j < 4; ++j) { const float a0 = acc[ai][bj][m][0][j], a1 = acc[ai][bj][m][1][j];
                            x[j] = a0 * sigm(1.5957691216f * (a0 + 0.044715f * a0 * a0 * a0)); x[4 + j] = a1 * sigm(1.5957691216f * (a1 + 0.044715f * a1 * a1 * a1)); }
                        u32x4 w; w.x = cvt_pk_bf16(x[0], x[1]); w.y = cvt_pk_bf16(x[2], x[3]); w.z = cvt_pk_bf16(x[4], x[5]); w.w = cvt_pk_bf16(x[6], x[7]);
                        __builtin_nontemporal_store(w, (u32x4*)(rowp + bj * HALF)); } }
        }
    }
};
struct Epi1F8 {
    static constexpr bool PERM = true, HAS_MID = false; static constexpr int MID0 = -1, MID1 = -1, F8_FROM = -1, LR_PN = -1;
    bf16* H; const float* gbias; unsigned char* G;
    __device__ __forceinline__ void operator()(const f32x4 (&acc)[2][2][4][2], const pg8::Unit& u, int wr, int wc, int fr, int fq) const {
        using namespace pg8;
        { const int l = lane_id_v(); fr = l & 15; fq = l >> 4; }
        if (u.pn >= 46) {
            const int pn = u.pn; f32x4 bv[2][2];
#pragma unroll
            for (int bj = 0; bj < 2; ++bj)
#pragma unroll
                for (int n = 0; n < 2; ++n) bv[bj][n] = -1.44269504089f * *(const f32x4*)(gbias + (pn - 46) * BM + wc * 32 + 8 * fq + bj * HALF + 4 * n);
            const int gb = (pn - 46) >> 4, gct = (pn - 46) & 15;
            constexpr float KS = -1.44269504089f * 0.015625f;
#pragma unroll
            for (int ai = 0; ai < 2; ++ai)
#pragma unroll
                for (int m = 0; m < 4; ++m) {
#pragma unroll
                    for (int bj = 0; bj < 2; ++bj) { float x[8];
#pragma unroll
                        for (int j = 0; j < 4; ++j) { x[j] = __builtin_amdgcn_rcpf(1.0f + __builtin_amdgcn_exp2f(acc[ai][bj][m][0][j] * KS + bv[bj][0][j])); x[4 + j] = __builtin_amdgcn_rcpf(1.0f + __builtin_amdgcn_exp2f(acc[ai][bj][m][1][j] * KS + bv[bj][1][j])); }
                        u32x4 w; w.x = cvt_pk_bf16(x[0], x[1]); w.y = cvt_pk_bf16(x[2], x[3]); w.z = cvt_pk_bf16(x[4], x[5]); w.w = cvt_pk_bf16(x[6], x[7]);
                        __builtin_nontemporal_store(w, (u32x4*)(G + gate_off(gb, u.pm, gct, ai, m, bj, wr, wc, fr, fq))); } }
            return;
        }
        const int row0 = u.pm * BM + wr * 64 + fr, col0 = u.pn * BM + u.tag * HALF + wc * 32 + 8 * fq; const bool gate = u.pn >= 40;
#pragma unroll
        for (int ai = 0; ai < 2; ++ai)
#pragma unroll
            for (int m = 0; m < 4; ++m)
#pragma unroll
              for (int bj = 0; bj < 2; ++bj) { float x[8];
#pragma unroll
                for (int j = 0; j < 4; ++j) { x[j] = acc[ai][bj][m][0][j] * 0.015625f; x[4 + j] = acc[ai][bj][m][1][j] * 0.015625f; }
                if (gate) {
#pragma unroll
                    for (int j = 0; j < 8; ++j) x[j] = x[j] * sigm(x[j]); }
                u32x4 w; w.x = cvt_pk_bf16(x[0], x[1]); w.y = cvt_pk_bf16(x[2], x[3]); w.z = cvt_pk_bf16(x[4], x[5]); w.w = cvt_pk_bf16(x[6], x[7]);
                __builtin_nontemporal_store(w, (u32x4*)(H + (size_t)(row0 + ai * HALF + m * 16) * HP + col0 + bj * HALF)); }
    }
};
struct Epi2 {
    static constexpr bool PERM = true, HAS_MID = true; static constexpr int MID0 = 24, MID1 = 40, F8_FROM = F8_OC ? 40 : -1, LR_PN = -1;
    const unsigned char* G; bf16* MG;
    __device__ __forceinline__ void mid(f32x4 (&acc)[2][2][4][2], const pg8::Unit& u, int t, int wr, int wc, int fr, int fq) const {
        using namespace pg8;
        { const int l = lane_id_v(); fr = l & 15; fq = l >> 4; }
        const int row0 = u.pm * BM + wr * 64 + fr, col0 = u.pn * BM + wc * 32 + 8 * fq, b = t == MID0 ? 0 : 1;
        const float sc = (F8_OC && b == 1) ? 512.f : 1.f;
#pragma unroll
        for (int ai = 0; ai < 2; ++ai) {
            u32x4 ga[4][2], gb[4][2];
#pragma unroll
            for (int m = 0; m < 4; ++m) {
#pragma unroll
                for (int bj = 0; bj < 2; ++bj) { ga[m][bj] = *(const u32x4*)(G + gate_off(b, u.pm, u.pn, ai, m, bj, wr, wc, fr, fq)); gb[m][bj] = *(const u32x4*)(G + gate_off(b + 1, u.pm, u.pn, ai, m, bj, wr, wc, fr, fq)); } }
#pragma unroll
            for (int m = 0; m < 4; ++m)
#pragma unroll
                for (int bj = 0; bj < 2; ++bj) { float xa[8], xb[8]; unpack8(ga[m][bj], xa); unpack8(gb[m][bj], xb);
#pragma unroll
                    for (int j = 0; j < 4; ++j) { acc[ai][bj][m][0][j] *= xa[j] * __builtin_amdgcn_rcpf(xb[j]) * sc; acc[ai][bj][m][1][j] *= xa[4 + j] * __builtin_amdgcn_rcpf(xb[4 + j]) * sc; } }
        }
    }
    __device__ __forceinline__ void operator()(const f32x4 (&acc)[2][2][4][2], const pg8::Unit& u, int wr, int wc, int fr, int fq) const {
        using namespace pg8;
        { const int l = lane_id_v(); fr = l & 15; fq = l >> 4; }
        const int row0 = u.pm * BM + wr * 64 + fr, col0 = u.pn * BM + wc * 32 + 8 * fq;
#pragma unroll
        for (int ai = 0; ai < 2; ++ai)
#pragma unroll
            for (int m = 0; m < 4; ++m) { const size_t row = (size_t)(row0 + ai * HALF + m * 16);
                bf16* mp = MG + row * D + col0;
#pragma unroll
                for (int bj = 0; bj < 2; ++bj) { const u32x4 gw = *(const u32x4*)(G + gate_off(2, u.pm, u.pn, ai, m, bj, wr, wc, fr, fq));
                    float g[8]; unpack8(gw, g);
                    if (F8_OC) {
#pragma unroll
                        for (int j = 0; j < 8; ++j) g[j] *= (1.f / 512.f); }
                    u32x4 w; w.x = cvt_pk_bf16(acc[ai][bj][m][0][0] * g[0], acc[ai][bj][m][0][1] * g[1]); w.y = cvt_pk_bf16(acc[ai][bj][m][0][2] * g[2], acc[ai][bj][m][0][3] * g[3]);
                    w.z = cvt_pk_bf16(acc[ai][bj][m][1][0] * g[4], acc[ai][bj][m][1][1] * g[5]); w.w = cvt_pk_bf16(acc[ai][bj][m][1][2] * g[6], acc[ai][bj][m][1][3] * g[7]);
                    *(u32x4*)(mp + bj * HALF) = w; } }
    }
};
struct Epi3 {
    static constexpr bool PERM = false, HAS_MID = false; static constexpr int MID0 = -1, MID1 = -1, F8_FROM = -1, LR_PN = -1;
    const float* xp; const float* xs; float* out; int layer;
    __device__ __forceinline__ void operator()(const f32x4 (&acc)[2][2][4][2], const pg8::Unit& u, int wr, int wc, int fr, int fq) const {
        using namespace pg8;
        const int row0 = u.pm * BM + wr * 64 + fr, col0 = u.pn * BM + wc * 32 + 4 * fq;
#pragma unroll
        for (int ai = 0; ai < 2; ++ai)
#pragma unroll
            for (int m = 0; m < 4; ++m) { const int row = row0 + ai * HALF + m * 16;
                const float* xr = (layer == 0 ? (row < TP ? xp + (size_t)row * D : xs + (size_t)(row - TP) * D) : out + (size_t)row * D) + col0;
                float* op = out + (size_t)row * D + col0;
#pragma unroll
                for (int bj = 0; bj < 2; ++bj)
#pragma unroll
                    for (int n = 0; n < 2; ++n) { const f32x4 xv = *(const f32x4*)(xr + bj * HALF + n * 16); __builtin_nontemporal_store(xv + acc[ai][bj][m][n], (f32x4*)(op + bj * HALF + n * 16)); } }
    }
};

__device__ __forceinline__ void phase_prep(Frame& F, const Args& a, int layer) {
    PHASE_IDS();
    const int gw = F.vcu * NWAVES + wave, NGW = F.G * NWAVES;
    bf16* H = (bf16*)(a.ws + WS_H);
    const float2* rt = (const float2*)(a.ws + WS_ROPE);
    const float* qg = a.in[11] + layer * 128; const float* kg = a.in[12] + layer * 128;
#if !(MFMA_ATT && ATT_FUSED_NORM)
    {
        const int li = lane & 15;
        float qgv[8], kgv[8];
#pragma unroll
        for (int i = 0; i < 8; ++i) { qgv[i] = qg[8 * li + i]; kgv[i] = kg[8 * li + i]; }
        v4u w[4], wn[4];
        if (gw < T) { const v4u* p = (const v4u*)(H + (size_t)gw * HP + C_CQ) + lane;
#pragma unroll
            for (int j = 0; j < 4; ++j) w[j] = p[64 * j]; }
        for (int row = gw; row < T; row += NGW) {
            const int rn = row + NGW;
            if (rn < T) { const v4u* p = (const v4u*)(H + (size_t)rn * HP + C_CQ) + lane;
#pragma unroll
                for (int j = 0; j < 4; ++j) wn[j] = p[64 * j]; }
            const int pos = row < TP ? (row & 2047) : row - TP;
            float cs[8], sn[8];
            if (li < 4) { const f32x4* r4 = (const f32x4*)(rt + pos * 16 + 8 * (li & 1));
#pragma unroll
                for (int i = 0; i < 4; ++i) { const f32x4 t4 = r4[i]; cs[2 * i] = t4.x; sn[2 * i] = t4.y; cs[2 * i + 1] = t4.z; sn[2 * i + 1] = t4.w; } }
            v4u* po = (v4u*)(H + (size_t)row * HP + C_CQ) + lane;
#pragma unroll
            for (int j = 0; j < 4; ++j) { float x[8]; unpack8(w[j], x);
                float ss = 0.f;
#pragma unroll
                for (int i = 0; i < 8; ++i) ss += x[i] * x[i];
                ss += shx<1>(ss); ss += shx<2>(ss); ss += shx<4>(ss); ss += shx<8>(ss);
                const float rstd = 1.0f / sqrtf(ss * (1.f / 128.f) + 1e-6f);
                const bool isq = j < 3;
#pragma unroll
                for (int i = 0; i < 8; ++i) x[i] = x[i] * rstd * (isq ? qgv[i] : kgv[i]);
                float pv[8];
#pragma unroll
                for (int i = 0; i < 8; ++i) pv[i] = shx<2>(x[i]);
                if (li < 4) {
#pragma unroll
                    for (int i = 0; i < 8; ++i) x[i] = li < 2 ? x[i] * cs[i] - pv[i] * sn[i] : x[i] * cs[i] + pv[i] * sn[i]; }
                if (isq) {
#pragma unroll
                    for (int i = 0; i < 8; ++i) x[i] *= (MFMA_ATT ? 0.12751743082459868f : 0.08838834764831845f); }
                v4u o; o.x = pk2(x[0], x[1]); o.y = pk2(x[2], x[3]); o.z = pk2(x[4], x[5]); o.w = pk2(x[6], x[7]);
                po[64 * j] = o; }
#pragma unroll
            for (int j = 0; j < 4; ++j) w[j] = wn[j];
        }
    }
#endif
#if !MFMA_SGU
    const float* lg = a.in[7] + layer * 1024; const float* lb = a.in[8] + layer * 1024;
    for (int row = gw; row < T; row += NGW) {
        v4u* p = (v4u*)(H + (size_t)row * HP + C_BV) + lane;
        v4u w0 = p[0], w1 = p[64]; float x[16];
        x[0] = bflo(w0.x); x[1] = bfhi(w0.x); x[2] = bflo(w0.y); x[3] = bfhi(w0.y); x[4] = bflo(w0.z); x[5] = bfhi(w0.z); x[6] = bflo(w0.w); x[7] = bfhi(w0.w);
        x[8] = bflo(w1.x); x[9] = bfhi(w1.x); x[10] = bflo(w1.y); x[11] = bfhi(w1.y); x[12] = bflo(w1.z); x[13] = bfhi(w1.z); x[14] = bflo(w1.w); x[15] = bfhi(w1.w);
        float s = 0.f;
#pragma unroll
        for (int j = 0; j < 16; ++j) s += x[j];
        const float mean = wave_sum(s) * (1.f / 1024.f); float q = 0.f;
#pragma unroll
        for (int j = 0; j < 16; ++j) { x[j] -= mean; q += x[j] * x[j]; }
        const float rstd = 1.0f / sqrtf(wave_sum(q) * (1.f / 1024.f) + 1e-5f);
#pragma unroll
        for (int j = 0; j < 16; ++j) { const int c = (j < 8 ? 8 * lane + j : 512 + 8 * lane + (j - 8)); x[j] = x[j] * rstd * lg[c] + lb[c]; }
        w0.x = pk2(x[0], x[1]); w0.y = pk2(x[2], x[3]); w0.z = pk2(x[4], x[5]); w0.w = pk2(x[6], x[7]);
        w1.x = pk2(x[8], x[9]); w1.y = pk2(x[10], x[11]); w1.z = pk2(x[12], x[13]); w1.w = pk2(x[14], x[15]);
        p[0] = w0; p[64] = w1;
    }
#endif
#if MFMA_GLA
    {
        const float* up = a.in[4] + (size_t)layer * 2 * 16 * 768; const float* gb = a.in[5] + layer * 2 * 768;
        const float* LR0 = (const float*)(a.ws + WS_LR); const float* LR1 = LR0 + (size_t)T * 32;
        float* Bc = (float*)(a.ws + WS_MG);
        LAS float* lrs = (LAS float*)(F.lds + RING_OFF);
        for (int rep8 = 0; rep8 < ((DUP_MASK & 8) ? (F.G > 100 ? 2 : 1) : 1); ++rep8)
        for (int chunk = blockIdx.x; chunk < 512; chunk += F.G) {
            __syncthreads();
            { const size_t o = (size_t)chunk * 2048 + tid * 4; const f32x4 x0 = *(const f32x4*)(LR0 + o), x1 = *(const f32x4*)(LR1 + o); *(LAS f32x4*)(lrs + tid * 4) = x0 + x1; }
            __syncthreads();
#pragma unroll 1
            for (int rr = 0; rr < 3; ++rr) { const int r = tid + 512 * rr, dir = r >= 768 ? 1 : 0, k = r - dir * 768;
                float upv[16];
#pragma unroll
                for (int j = 0; j < 16; ++j) upv[j] = up[(dir * 16 + j) * 768 + k];
                const float bias = gb[dir * 768 + k]; float b = 0.f;
#pragma unroll 4
                for (int i = 0; i < 64; ++i) { const int ri = dir == 0 ? i : 63 - i; const LAS f32x4* l4 = (const LAS f32x4*)(lrs + ri * 32 + dir * 16);
                    float z = bias;
#pragma unroll
                    for (int j = 0; j < 4; ++j) { const f32x4 x = l4[j]; z += x.x * upv[4 * j] + x.y * upv[4 * j + 1] + x.z * upv[4 * j + 2] + x.w * upv[4 * j + 3]; }
                    const float ls = fminf(z, 0.f) - __logf(1.0f + __expf(-fabsf(z)));
                    b += ls * (1.f / 16.f); Bc[((size_t)chunk * 64 + ri) * 1536 + r] = b; }
            }
        }
    }
#endif
#if !MFMA_GLA
    const float* up = a.in[4] + (size_t)layer * 2 * 16 * 768; const float* gb = a.in[5] + layer * 2 * 768;
    const float* LR0 = (const float*)(a.ws + WS_LR); const float* LR1 = LR0 + (size_t)T * 32;
    float* DEC = (float*)(a.ws + WS_MG);
    for (size_t e = (size_t)(F.vcu * NWAVES + wave) * 64 + lane; e < (size_t)T * 1536; e += (size_t)F.G * NWAVES * 64) {
        const int row = (int)(e / 1536), r = (int)(e - (size_t)row * 1536), dir = r / 768, k = r - dir * 768;
        float z = gb[dir * 768 + k];
#pragma unroll
        for (int j = 0; j < 16; ++j) z += (LR0[(size_t)row * 32 + dir * 16 + j] + LR1[(size_t)row * 32 + dir * 16 + j]) * up[(dir * 16 + j) * 768 + k];
        const float ls = fminf(z, 0.f) - log1pf(expf(-fabsf(z)));
        DEC[e] = expf(ls * (1.f / 16.f));
    }
#endif
}

__device__ __forceinline__ void phase_mix_naive(Frame& F, const Args& a, int layer) {
    PHASE_IDS();
    bf16* H = (bf16*)(a.ws + WS_H); bf16* O = (bf16*)(a.ws + WS_XN);
#if !MFMA_SGU
    {
        const float* W = a.in[9] + (size_t)layer * 8 * 128 * 128; const float* sb = a.in[10] + layer * 8 * 128;
        const int c = tid & 127, pq = tid >> 7;
        for (int it = blockIdx.x; it < 256 * 8; it += F.G) {
            const int chunk = it >> 3, g = it & 7; const size_t r0 = (size_t)chunk * 128;
            for (int pp = 0; pp < 32; ++pp) { const int p = pp * 4 + pq; const float* wr = W + ((size_t)g * 128 + p) * 128;
                float acc = 0.f;
                for (int q = 0; q < 128; ++q) acc += wr[q] * bf1(H[(r0 + q) * HP + C_BV + g * 128 + c]);
                const size_t row = r0 + p;
                const float u = bf1(H[row * HP + C_BU + g * 128 + c]), sg = bf1(H[row * HP + C_BG + g * 128 + c]);
                O[row * D + O_B + g * 128 + c] = (bf16)f2bf((acc + sb[g * 128 + p]) * u * sg); }
        }
    }
#endif
#if !MFMA_ATT
    {
        LAS float* wq = (LAS float*)(F.lds + RING_OFF + wave * 2048);
        LAS float* sc = wq + 128;
        const float* sink = a.in[13] + layer * 12;
        const int gw = F.vcu * NWAVES + wave, NGW = F.G * NWAVES;
        for (int it = gw; it < T * 12; it += NGW) {
            const int row = it / 12, hq = it - row * 12, kvh = hq / 3;
            const int s0 = row < TP ? (row & ~2047) : TP, L = row < TP ? 2048 : 16384, qpos = row - s0;
            { const unsigned w = *((const unsigned*)(H + (size_t)row * HP + C_CQ + hq * 128) + lane); wq[2 * lane] = bflo(w); wq[2 * lane + 1] = bfhi(w); }
            LDS_WAIT(); asm volatile("" ::: "memory");
            float mx = -INFINITY;
            for (int pass = 0; pass < 5; ++pass) { const int jj = pass * 64 + lane, kpos = qpos - 128 + jj; float s = -INFINITY;
                if (jj <= 256 && kpos >= 0 && kpos < L) { const v4u* kr = (const v4u*)(H + (size_t)(s0 + kpos) * HP + C_CK + kvh * 128); float d = 0.f;
#pragma unroll 4
                    for (int i = 0; i < 16; ++i) { const v4u w = kr[i]; const LAS float* q8 = wq + 8 * i;
                        d += q8[0] * bflo(w.x) + q8[1] * bfhi(w.x) + q8[2] * bflo(w.y) + q8[3] * bfhi(w.y) + q8[4] * bflo(w.z) + q8[5] * bfhi(w.z) + q8[6] * bflo(w.w) + q8[7] * bfhi(w.w); }
                    s = d; }
                sc[jj] = s; mx = fmaxf(mx, s); }
            const float sk = sink[hq];
            const float m = fmaxf(wave_max(mx), sk);
            LDS_WAIT(); asm volatile("" ::: "memory");
            float ps = 0.f;
            for (int pass = 0; pass < 5; ++pass) { const int jj = pass * 64 + lane; const float s = sc[jj]; const float p = (s == -INFINITY) ? 0.f : __expf(s - m); sc[jj] = p; ps += p; }
            const float denom = wave_sum(ps) + __expf(sk - m);
            LDS_WAIT(); asm volatile("" ::: "memory");
            float o0 = 0.f, o1 = 0.f;
            const int jlo = qpos >= 128 ? 0 : 128 - qpos, jhi = (qpos + 128 < L) ? 256 : (L - 1 - qpos + 128);
            for (int jj = jlo; jj <= jhi; ++jj) { const float p = sc[jj]; const unsigned w = *((const unsigned*)(H + (size_t)(s0 + qpos - 128 + jj) * HP + C_CV + kvh * 128) + lane);
                o0 += p * bflo(w); o1 += p * bfhi(w); }
            const float inv = 1.0f / denom;
            const unsigned gwd = *((const unsigned*)(H + (size_t)row * HP + C_CG + hq * 128) + lane);
            *((unsigned*)(O + (size_t)row * D + O_C + hq * 128) + lane) = pk2(o0 * inv * bflo(gwd), o1 * inv * bfhi(gwd));
            LDS_WAIT(); asm volatile("" ::: "memory");
        }
    }
#endif
    __syncthreads();
    if (blockIdx.x < 108) {
        const int b = blockIdx.x, seq = b / 12, hd = (b % 12) >> 1, dir = b & 1;
        const int s0 = seq < 8 ? seq * 2048 : TP, L = seq < 8 ? 2048 : 16384;
        LAS float* la = (LAS float*)(F.lds + RING_OFF + 32768); LAS float* lq = la + 128; LAS float* lk = lq + 128; LAS float* lo = lk + 128;
        const float* DEC = (const float*)(a.ws + WS_MG);
        float* OUT = (float*)(a.ws + WS_ST) + (size_t)dir * T * 1536;
        const int dv = tid & 255, half = tid >> 8;
        float S[64];
#pragma unroll
        for (int j = 0; j < 64; ++j) S[j] = 0.f;
        float na = 0.f, nq = 0.f, nk = 0.f, nv;
        { const size_t p = (size_t)(dir == 0 ? s0 : s0 + L - 1);
          if (tid < 128) { na = DEC[p * 1536 + dir * 768 + hd * 128 + tid]; nq = bf1(H[p * HP + C_AQ + hd * 128 + tid]) * 0.08838834764831845f; nk = bf1(H[p * HP + C_AK + hd * 128 + tid]); }
          nv = bf1(H[p * HP + C_AV + hd * 256 + dv]); }
        for (int t = 0; t < L; ++t) {
            const size_t p = (size_t)(dir == 0 ? s0 + t : s0 + L - 1 - t);
            if (tid < 128) { la[tid] = na; lq[tid] = nq; lk[tid] = nk; }
            const float v = nv;
            __syncthreads();
            if (t + 1 < L) { const size_t pn = (size_t)(dir == 0 ? p + 1 : p - 1);
                if (tid < 128) { na = DEC[pn * 1536 + dir * 768 + hd * 128 + tid]; nq = bf1(H[pn * HP + C_AQ + hd * 128 + tid]) * 0.08838834764831845f; nk = bf1(H[pn * HP + C_AK + hd * 128 + tid]); }
                nv = bf1(H[pn * HP + C_AV + hd * 256 + dv]); }
            float acc = 0.f;
#pragma unroll
            for (int j = 0; j < 64; ++j) { const int dk = half * 64 + j; S[j] = la[dk] * S[j] + lk[dk] * v; acc += lq[dk] * S[j]; }
            if (half == 1) lo[dv] = acc;
            __syncthreads();
            if (half == 0) OUT[p * 1536 + hd * 256 + dv] = acc + lo[dv];
        }
    }
}

__device__ __forceinline__ void phase_gla_fin(Frame& F, const Args& a, int layer) {
    PHASE_IDS();
    const int gw = F.vcu * NWAVES + wave, NGW = F.G * NWAVES;
    const bf16* H = (const bf16*)(a.ws + WS_H); bf16* O = (bf16*)(a.ws + WS_XN);
    const float* OF = (const float*)(a.ws + WS_ST); const float* OB = OF + (size_t)T * 1536;
    const float* gn = a.in[6] + layer * 256;
    for (int it = gw; it < T * 6; it += NGW) {
        const int row = it / 6, hd = it - row * 6;
        const f32x4 f = *((const f32x4*)(OF + (size_t)row * 1536 + hd * 256) + lane), b = *((const f32x4*)(OB + (size_t)row * 1536 + hd * 256) + lane);
        const f32x4 s = f + b;
        const float rstd = 1.0f / sqrtf(wave_sum((s.x * s.x + s.y * s.y) + (s.z * s.z + s.w * s.w)) * (1.f / 256.f) + 1e-6f);
        const f32x4 g = *((const f32x4*)gn + lane);
        const v2u gt = *((const v2u*)(H + (size_t)row * HP + C_AG + hd * 256) + lane);
        v2u w; w.x = pk2(s.x * rstd * g.x * bflo(gt.x), s.y * rstd * g.y * bfhi(gt.x)); w.y = pk2(s.z * rstd * g.z * bflo(gt.y), s.w * rstd * g.w * bfhi(gt.y));
        *((v2u*)(O + (size_t)row * D + O_A + hd * 256) + lane) = w;
    }
}


typedef short bf16x8 __attribute__((ext_vector_type(8)));
#define MFMA16(a_, b_, c_) __builtin_amdgcn_mfma_f32_16x16x32_bf16(a_, b_, c_, 0, 0, 0)
__device__ __forceinline__ bf16x8 ldsfrag(const LAS unsigned char* base, int pitch, int row0, int k0, int fr, int fq) {
    return *(const LAS bf16x8*)(base + (row0 + fr) * pitch + (k0 + 8 * fq) * 2);
}

__device__ __forceinline__ void phase_sgu(Frame& F, const Args& a, int layer) {
    PHASE_IDS();
    const int fr = lane & 15, fq = lane >> 4;
    constexpr int PIT = 272;
    LAS unsigned char* VT = F.lds + RING_OFF;
    LAS unsigned char* WA = VT + 128 * PIT;
    LAS float* STt = (LAS float*)(WA + 128 * PIT);
    const bf16* H = (const bf16*)(a.ws + WS_H); bf16* O = (bf16*)(a.ws + WS_XN);
    const float* lg = a.in[7] + layer * 1024; const float* lb = a.in[8] + layer * 1024;
    const float* W = a.in[9] + (size_t)layer * 8 * 128 * 128; const float* sb = a.in[10] + layer * 8 * 128;
    for (int chunk = blockIdx.x; chunk < 256; chunk += F.G) {
        const size_t r0 = (size_t)chunk * 128;
        __syncthreads();
#pragma unroll 1
        for (int ib = 0; ib < 2; ++ib) {
            v4u ra[8], rb[8];
#pragma unroll
            for (int i = 0; i < 8; ++i) { const v4u* p = (const v4u*)(H + (r0 + 16 * wave + 8 * ib + i) * HP + C_BV) + lane; ra[i] = p[0]; rb[i] = p[64]; }
            float s[8], q[8];
#pragma unroll
            for (int i = 0; i < 8; ++i) { float x[16]; unpack8(ra[i], x); unpack8(rb[i], x + 8); s[i] = 0.f;
#pragma unroll
                for (int j = 0; j < 16; ++j) s[i] += x[j]; }
#pragma unroll
            for (int i = 0; i < 8; ++i) s[i] = wave_sum(s[i]) * (1.f / 1024.f);
#pragma unroll
            for (int i = 0; i < 8; ++i) { float x[16]; unpack8(ra[i], x); unpack8(rb[i], x + 8); q[i] = 0.f;
#pragma unroll
                for (int j = 0; j < 16; ++j) { const float d = x[j] - s[i]; q[i] += d * d; } }
#pragma unroll
            for (int i = 0; i < 8; ++i) q[i] = wave_sum(q[i]);
#pragma unroll
            for (int i = 0; i < 8; ++i) { const float rstd = 1.0f / sqrtf(q[i] * (1.f / 1024.f) + 1e-5f);
                if (lane == 0) { STt[2 * (16 * wave + 8 * ib + i)] = s[i]; STt[2 * (16 * wave + 8 * ib + i) + 1] = rstd; } }
        }
        __syncthreads();
        v4u vraw[4]; f32x4 wraw[8];
#define SGU_LOAD(g_) do { const v4u* vs_ = (const v4u*)(H + (r0 + (tid & 127)) * HP + C_BV + (g_) * 128 + (tid >> 7) * 32); _Pragma("unroll") for (int i_ = 0; i_ < 4; ++i_) vraw[i_] = vs_[i_]; \
        const f32x4* ws_ = (const f32x4*)(W + ((size_t)(g_) * 128 + (tid >> 2)) * 128 + (tid & 3) * 32); _Pragma("unroll") for (int i_ = 0; i_ < 8; ++i_) wraw[i_] = ws_[i_]; } while (0)
        SGU_LOAD(0);
        for (int g = 0; g < 8; ++g) {
            { const int q = tid & 127, cb = (tid >> 7) * 32; const float st_x = STt[2 * q], st_y = STt[2 * q + 1];
#pragma unroll
              for (int i = 0; i < 4; ++i) { float x[8]; unpack8(vraw[i], x);
#pragma unroll
                  for (int j = 0; j < 8; ++j) { const int c = cb + 8 * i + j; const float y = (x[j] - st_x) * st_y * lg[g * 128 + c] + lb[g * 128 + c];
                      *(LAS bf16*)(VT + c * PIT + q * 2) = (bf16)f2bf(y); } } }
            { const int p = tid >> 2, qb = (tid & 3) * 32;
#pragma unroll
              for (int i = 0; i < 4; ++i) { const f32x4 u0 = wraw[2 * i], u1 = wraw[2 * i + 1]; v4u w; w.x = pk2(u0.x, u0.y); w.y = pk2(u0.z, u0.w); w.z = pk2(u1.x, u1.y); w.w = pk2(u1.z, u1.w);
                  *(LAS v4u*)(WA + p * PIT + (qb + 8 * i) * 2) = w; } }
            if (g < 7) SGU_LOAD(g + 1);
            const int p = 16 * wave + fr; const size_t row = r0 + p; const float sbv = sb[g * 128 + p];
            v2u gu[8], sg[8];
#pragma unroll
            for (int n = 0; n < 8; ++n) { const int c = g * 128 + 16 * n + 4 * fq; gu[n] = *(const v2u*)(H + row * HP + C_BU + c); sg[n] = *(const v2u*)(H + row * HP + C_BG + c); }
            __syncthreads();
            f32x4 acc[8];
#pragma unroll
            for (int n = 0; n < 8; ++n) acc[n] = (f32x4){0.f, 0.f, 0.f, 0.f};
#pragma unroll
            for (int ks = 0; ks < 4; ++ks) { const bf16x8 af = ldsfrag(WA, PIT, 16 * wave, 32 * ks, fr, fq);
#pragma unroll
                for (int n = 0; n < 8; ++n) acc[n] = MFMA16(ldsfrag(VT, PIT, 16 * n, 32 * ks, fr, fq), af, acc[n]); }
#pragma unroll
            for (int n = 0; n < 8; ++n) { const int c = g * 128 + 16 * n + 4 * fq;
                v2u w; w.x = pk2((acc[n][0] + sbv) * bflo(gu[n].x) * bflo(sg[n].x), (acc[n][1] + sbv) * bfhi(gu[n].x) * bfhi(sg[n].x));
                w.y = pk2((acc[n][2] + sbv) * bflo(gu[n].y) * bflo(sg[n].y), (acc[n][3] + sbv) * bfhi(gu[n].y) * bfhi(sg[n].y));
                *(v2u*)(O + row * D + O_B + c) = w; }
            __syncthreads();
        }
#undef SGU_LOAD
    }
}

__device__ __forceinline__ void phase_attn(Frame& F, const Args& a, int layer) {
    PHASE_IDS();
    const int fr = lane & 15, fq = lane >> 4;
    constexpr int PIT = 272;
    LAS unsigned char* Kt = F.lds + RING_OFF;
    LAS unsigned char* Vt = Kt + 128 * PIT;
    LAS unsigned char* Pm = Vt + 128 * PIT;
    const bf16* H = (const bf16*)(a.ws + WS_H); bf16* O = (bf16*)(a.ws + WS_XN);
    const float* sink = a.in[13] + layer * 12;
    const float* qg = a.in[11] + layer * 128; const float* kg = a.in[12] + layer * 128;
    const float* rt = (const float*)(a.ws + WS_ROPE);
    constexpr int NU = 256 * 12;
    int u = F.vcu; if (u >= NU) return;
#define ATT_DECODE(u_, qb_, hq_, r0_, s0_, nblk_, qi_) const int qb_ = (u_) / 12, hq_ = (u_) - qb_ * 12, r0_ = qb_ * 128, s0_ = r0_ < TP ? (r0_ & ~2047) : TP, nblk_ = r0_ < TP ? 16 : 128, qi_ = (r0_ - s0_) >> 7
#define ATT_LOAD_KV(s0_, kbi_, kvh_) do { const size_t kr0_ = (size_t)((s0_) + (kbi_) * 128); \
        const v4u* ks_ = (const v4u*)(H + (kr0_ + (tid >> 2)) * HP + C_CK + (kvh_) * 128 + (tid & 3) * 32); const v4u* vs_ = (const v4u*)(H + (kr0_ + (tid & 127)) * HP + C_CV + (kvh_) * 128 + (tid >> 7) * 32); \
        _Pragma("unroll") for (int i_ = 0; i_ < 4; ++i_) { kraw[i_] = ks_[i_]; vraw[i_] = vs_[i_]; } } while (0)
#define ATT_LOAD_Q(r0_, hq_) do { const bf16* qp_ = H + (size_t)((r0_) + 16 * wave + fr) * HP + C_CQ + (hq_) * 128 + 8 * fq; \
        _Pragma("unroll") for (int i_ = 0; i_ < 4; ++i_) qraw[i_] = *(const v4u*)(qp_ + 32 * i_); } while (0)
    v4u kraw[4], vraw[4], qraw[4];
    int t;
    { ATT_DECODE(u, qb, hq, r0, s0, nblk, qi); (void)nblk; t = qi == 0 ? 0 : -1; ATT_LOAD_KV(s0, qi + t, hq / 3); ATT_LOAD_Q(r0, hq); }
    for (;;) {
        ATT_DECODE(u, qb, hq, r0, s0, nblk, qi); const int kvh = hq / 3;
        const size_t qrow = (size_t)(r0 + 16 * wave + fr);
        bf16x8 qf[4];
#if ATT_FUSED_NORM
        { float x[4][8]; float ss = 0.f;
#pragma unroll
          for (int ks = 0; ks < 4; ++ks) { unpack8(qraw[ks], x[ks]);
#pragma unroll
              for (int j = 0; j < 8; ++j) ss += x[ks][j] * x[ks][j]; }
          ss += shx<16>(ss); ss = sum32(ss);
          const float rstd = 1.0f / sqrtf(ss * (1.f / 128.f) + 1e-6f);
#pragma unroll
          for (int ks = 0; ks < 4; ++ks) { const f32x4 g0 = *(const f32x4*)(qg + 32 * ks + 8 * fq), g1 = *(const f32x4*)(qg + 32 * ks + 8 * fq + 4);
              x[ks][0] *= rstd * g0.x; x[ks][1] *= rstd * g0.y; x[ks][2] *= rstd * g0.z; x[ks][3] *= rstd * g0.w; x[ks][4] *= rstd * g1.x; x[ks][5] *= rstd * g1.y; x[ks][6] *= rstd * g1.z; x[ks][7] *= rstd * g1.w; }
          { const int pos = (int)qrow - s0; const f32x4* c4 = (const f32x4*)(rt + (pos * 16 + 8 * (fq & 1)) * 2);
#pragma unroll
            for (int j2 = 0; j2 < 4; ++j2) { const f32x4 cs = c4[j2]; const float pa = xch32(x[0][2 * j2], fq >= 2), pb = xch32(x[0][2 * j2 + 1], fq >= 2);
                x[0][2 * j2] = fq < 2 ? x[0][2 * j2] * cs.x - pa * cs.y : x[0][2 * j2] * cs.x + pa * cs.y;
                x[0][2 * j2 + 1] = fq < 2 ? x[0][2 * j2 + 1] * cs.z - pb * cs.w : x[0][2 * j2 + 1] * cs.z + pb * cs.w; } }
#pragma unroll
          for (int ks = 0; ks < 4; ++ks) { v4u w; const float sc = 0.12751743082459868f;
              w.x = pk2(x[ks][0] * sc, x[ks][1] * sc); w.y = pk2(x[ks][2] * sc, x[ks][3] * sc); w.z = pk2(x[ks][4] * sc, x[ks][5] * sc); w.w = pk2(x[ks][6] * sc, x[ks][7] * sc);
              qf[ks] = __builtin_bit_cast(bf16x8, w); } }
#else
#pragma unroll
        for (int ks = 0; ks < 4; ++ks) qf[ks] = __builtin_bit_cast(bf16x8, qraw[ks]);
#endif
        float m = sink[hq] * 1.44269504089f, l = fq == 0 ? 1.f : 0.f;
        f32x4 Oa[8];
#pragma unroll
        for (int n = 0; n < 8; ++n) Oa[n] = (f32x4){0.f, 0.f, 0.f, 0.f};
        int un = u, tn = t; bool more = true;
        for (;;) {
            const size_t kr0 = (size_t)(s0 + (qi + t) * 128);
            __syncthreads();
#if ATT_FUSED_NORM
            { const int key = tid >> 2, dq = tid & 3, db = dq * 32; float ss = 0.f;
#pragma unroll
              for (int i = 0; i < 4; ++i) { float x[8]; unpack8(kraw[i], x);
#pragma unroll
                  for (int j = 0; j < 8; ++j) ss += x[j] * x[j]; }
              ss += shx<1>(ss); ss += shx<2>(ss);
              const float rstd = 1.0f / sqrtf(ss * (1.f / 128.f) + 1e-6f);
              if (dq == 0) {
                  const int pos = (int)(kr0 - s0) + key; const f32x4* c4 = (const f32x4*)(rt + pos * 32);
#pragma unroll
                  for (int h = 0; h < 2; ++h) { float xa[8], xb[8]; unpack8(kraw[h], xa); unpack8(kraw[h + 2], xb);
#pragma unroll
                      for (int j = 0; j < 8; ++j) { xa[j] *= rstd * kg[8 * h + j]; xb[j] *= rstd * kg[16 + 8 * h + j]; }
#pragma unroll
                      for (int j2 = 0; j2 < 4; ++j2) { const f32x4 cs = c4[4 * h + j2];
                          const float a0 = xa[2 * j2], b0 = xb[2 * j2], a1 = xa[2 * j2 + 1], b1 = xb[2 * j2 + 1];
                          xa[2 * j2] = a0 * cs.x - b0 * cs.y; xb[2 * j2] = b0 * cs.x + a0 * cs.y; xa[2 * j2 + 1] = a1 * cs.z - b1 * cs.w; xb[2 * j2 + 1] = b1 * cs.z + a1 * cs.w; }
                      v4u w; w.x = pk2(xa[0], xa[1]); w.y = pk2(xa[2], xa[3]); w.z = pk2(xa[4], xa[5]); w.w = pk2(xa[6], xa[7]); *(LAS v4u*)(Kt + key * PIT + (8 * h) * 2) = w;
                      w.x = pk2(xb[0], xb[1]); w.y = pk2(xb[2], xb[3]); w.z = pk2(xb[4], xb[5]); w.w = pk2(xb[6], xb[7]); *(LAS v4u*)(Kt + key * PIT + (16 + 8 * h) * 2) = w; }
              } else {
#pragma unroll
                  for (int i = 0; i < 4; ++i) { float x[8]; unpack8(kraw[i], x);
#pragma unroll
                      for (int j = 0; j < 8; ++j) x[j] *= rstd * kg[db + 8 * i + j];
                      v4u w; w.x = pk2(x[0], x[1]); w.y = pk2(x[2], x[3]); w.z = pk2(x[4], x[5]); w.w = pk2(x[6], x[7]); *(LAS v4u*)(Kt + key * PIT + (db + 8 * i) * 2) = w; } } }
#else
            { const int key = tid >> 2, db = (tid & 3) * 32;
#pragma unroll
              for (int i = 0; i < 4; ++i) *(LAS v4u*)(Kt + key * PIT + (db + 8 * i) * 2) = kraw[i]; }
#endif
            { const int key = tid & 127, db = (tid >> 7) * 32;
#pragma unroll
              for (int i = 0; i < 4; ++i) { const v4u w = vraw[i]; const unsigned ww[4] = {w.x, w.y, w.z, w.w};
#pragma unroll
                  for (int j = 0; j < 4; ++j) { *(LAS bf16*)(Vt + (db + 8 * i + 2 * j) * PIT + key * 2) = (bf16)(ww[j] & 0xffffu); *(LAS bf16*)(Vt + (db + 8 * i + 2 * j + 1) * PIT + key * 2) = (bf16)(ww[j] >> 16); } } }
            if (t + 1 <= 1 && qi + t + 1 < nblk) { tn = t + 1; ATT_LOAD_KV(s0, qi + tn, kvh); }
            else { un = u + F.G; if (un < NU) { ATT_DECODE(un, qb2, hq2, r02, s02, nblk2, qi2); (void)nblk2; tn = qi2 == 0 ? 0 : -1; ATT_LOAD_KV(s02, qi2 + tn, hq2 / 3); ATT_LOAD_Q(r02, hq2); } else more = false; }
            __syncthreads();
            f32x4 S[8];
#pragma unroll
            for (int n = 0; n < 8; ++n) S[n] = (f32x4){0.f, 0.f, 0.f, 0.f};
#pragma unroll
            for (int ks = 0; ks < 4; ++ks)
#pragma unroll
                for (int n = 0; n < 8; ++n) S[n] = MFMA16(ldsfrag(Kt, PIT, 16 * n, 32 * ks, fr, fq), qf[ks], S[n]);
            const int qi_ = 16 * wave + fr; float mx = -INFINITY;
            if (t != 0) {
#pragma unroll
                for (int n = 0; n < 8; ++n)
#pragma unroll
                    for (int j = 0; j < 4; ++j) { const int kj = 16 * n + 4 * fq + j; const bool ok = t < 0 ? kj >= qi_ : kj <= qi_; S[n][j] = ok ? S[n][j] : -INFINITY; } }
#pragma unroll
            for (int n = 0; n < 8; ++n) mx = fmaxf(mx, fmaxf(fmaxf(S[n][0], S[n][1]), fmaxf(S[n][2], S[n][3])));
            mx = fmaxf(mx, shx<16>(mx)); mx = max32(mx);
            const float mn = fmaxf(m, mx), alpha = __builtin_amdgcn_exp2f(m - mn); m = mn;
            float ps = 0.f;
#pragma unroll
            for (int n = 0; n < 8; ++n) { float p0 = __builtin_amdgcn_exp2f(S[n][0] - mn), p1 = __builtin_amdgcn_exp2f(S[n][1] - mn), p2 = __builtin_amdgcn_exp2f(S[n][2] - mn), p3 = __builtin_amdgcn_exp2f(S[n][3] - mn);
                ps += (p0 + p1) + (p2 + p3); v2u w; w.x = pk2(p0, p1); w.y = pk2(p2, p3);
                *(LAS v2u*)(Pm + (16 * wave + fr) * PIT + (16 * n + 4 * fq) * 2) = w; Oa[n] = Oa[n] * alpha; }
            l = l * alpha + ps;
            LDS_WAIT(); asm volatile("" ::: "memory");
#pragma unroll
            for (int ks = 0; ks < 4; ++ks) { const bf16x8 pf = ldsfrag(Pm, PIT, 16 * wave, 32 * ks, fr, fq);
#pragma unroll
                for (int n = 0; n < 8; ++n) Oa[n] = MFMA16(ldsfrag(Vt, PIT, 16 * n, 32 * ks, fr, fq), pf, Oa[n]); }
            if (un != u || !more) break;
            t = tn;
        }
        l += shx<16>(l); l = sum32(l);
        const float inv = 1.0f / l;
#pragma unroll
        for (int n = 0; n < 8; ++n) { const int d = hq * 128 + 16 * n + 4 * fq; const v2u gt = *(const v2u*)(H + qrow * HP + C_CG + d);
            v2u w; w.x = pk2(Oa[n][0] * inv * bflo(gt.x), Oa[n][1] * inv * bfhi(gt.x)); w.y = pk2(Oa[n][2] * inv * bflo(gt.y), Oa[n][3] * inv * bfhi(gt.y));
#if F8_OC
#define F8C(x) __builtin_amdgcn_fmed3f(8.f * (x), -448.f, 448.f)
            int w8 = 0; w8 = __builtin_amdgcn_cvt_pk_fp8_f32(F8C(Oa[n][0] * inv * bflo(gt.x)), F8C(Oa[n][1] * inv * bfhi(gt.x)), w8, false); w8 = __builtin_amdgcn_cvt_pk_fp8_f32(F8C(Oa[n][2] * inv * bflo(gt.y)), F8C(Oa[n][3] * inv * bfhi(gt.y)), w8, true);
#undef F8C
            *(unsigned*)((unsigned char*)O + qrow * 8192 + 5120 + d) = (unsigned)w8; (void)w; }
#else
            *(v2u*)(O + qrow * D + O_C + d) = w; }
#endif
        if (!more) break;
        u = un; t = tn;
    }
#undef ATT_DECODE
#undef ATT_LOAD_KV
#undef ATT_LOAD_Q
}

__device__ __forceinline__ void phase_gla_c1(Frame& F, const Args& a, int layer) {
    PHASE_IDS();
    const int fr = lane & 15, fq = lane >> 4;
    constexpr int PV = 144;
    LAS unsigned char* VT = F.lds + RING_OFF;
    LAS unsigned char* K1T = VT + 256 * PV;
    const bf16* H = (const bf16*)(a.ws + WS_H); const float* Bc = (const float*)(a.ws + WS_MG);
    bf16* STb = (bf16*)(a.ws + WS_ST); float* DECC = (float*)(a.ws + WS_DECC);
    v4u vraw[4], kraw[2]; f32x4 braw[2][4];
#define C1_LOAD(u_) do { const int c_ = (u_) / 6, hd_ = (u_) - c_ * 6; const size_t r0_ = (size_t)c_ * 64; const int s_ = tid & 63; \
        const v4u* vs_ = (const v4u*)(H + (r0_ + s_) * HP + C_AV + hd_ * 256 + (tid >> 6) * 32); _Pragma("unroll") for (int i_ = 0; i_ < 4; ++i_) vraw[i_] = vs_[i_]; \
        const v4u* ks_ = (const v4u*)(H + (r0_ + s_) * HP + C_AK + hd_ * 128 + (tid >> 6) * 16); kraw[0] = ks_[0]; kraw[1] = ks_[1]; \
        _Pragma("unroll") for (int d_ = 0; d_ < 2; ++d_) { const f32x4* bs_ = (const f32x4*)(Bc + (r0_ + s_) * 1536 + d_ * 768 + hd_ * 128 + (tid >> 6) * 16); _Pragma("unroll") for (int i_ = 0; i_ < 4; ++i_) braw[d_][i_] = bs_[i_]; } } while (0)
    if (F.vcu < 512 * 6) C1_LOAD(F.vcu);
    for (int u = F.vcu; u < 512 * 6; u += F.G) {
        const int c = u / 6, hd = u - c * 6; const size_t r0 = (size_t)c * 64;
        __syncthreads();
        { const int s = tid & 63, dvb = (tid >> 6) * 32;
#pragma unroll
          for (int i = 0; i < 4; ++i) { const v4u w = vraw[i]; const unsigned ww[4] = {w.x, w.y, w.z, w.w};
#pragma unroll
              for (int j = 0; j < 4; ++j) { *(LAS bf16*)(VT + (dvb + 8 * i + 2 * j) * PV + s * 2) = (bf16)(ww[j] & 0xffffu); *(LAS bf16*)(VT + (dvb + 8 * i + 2 * j + 1) * PV + s * 2) = (bf16)(ww[j] >> 16); } } }
        { const int s = tid & 63, dkb = (tid >> 6) * 16; float kx[16]; unpack8(kraw[0], kx); unpack8(kraw[1], kx + 8);
#pragma unroll
          for (int dir = 0; dir < 2; ++dir)
#pragma unroll
            for (int i = 0; i < 4; ++i) { const f32x4 bb = braw[dir][i];
#pragma unroll
                for (int j = 0; j < 4; ++j) *(LAS bf16*)(K1T + (dir * 128 + dkb + 4 * i + j) * PV + s * 2) = (bf16)f2bf(kx[4 * i + j] * __expf(-bb[j])); } }
        if (u + F.G < 512 * 6) C1_LOAD(u + F.G);
        __syncthreads();
#pragma unroll
        for (int dir = 0; dir < 2; ++dir) {
            f32x4 acc[2][8];
#pragma unroll
            for (int m = 0; m < 2; ++m)
#pragma unroll
                for (int n = 0; n < 8; ++n) acc[m][n] = (f32x4){0.f, 0.f, 0.f, 0.f};
#pragma unroll
            for (int ks = 0; ks < 2; ++ks) { const bf16x8 a0 = ldsfrag(VT, PV, 32 * wave, 32 * ks, fr, fq), a1 = ldsfrag(VT, PV, 32 * wave + 16, 32 * ks, fr, fq);
#pragma unroll
                for (int n = 0; n < 8; ++n) { const bf16x8 bfr = ldsfrag(K1T + dir * 128 * PV, PV, 16 * n, 32 * ks, fr, fq); acc[0][n] = MFMA16(bfr, a0, acc[0][n]); acc[1][n] = MFMA16(bfr, a1, acc[1][n]); } }
            const size_t lastrow = r0 + (dir == 0 ? 63 : 0); const int slot = (c * 6 + hd) * 2 + dir; bf16* dst = STb + (size_t)slot * 32768;
#pragma unroll
            for (int n = 0; n < 8; ++n) { const int dk = 16 * n + 4 * fq; const f32x4 bl = *(const f32x4*)(Bc + lastrow * 1536 + dir * 768 + hd * 128 + dk);
                const float e0 = __expf(bl.x), e1 = __expf(bl.y), e2 = __expf(bl.z), e3 = __expf(bl.w);
#pragma unroll
                for (int m = 0; m < 2; ++m) { const int dv = 32 * wave + 16 * m + fr; v2u w; w.x = pk2(acc[m][n][0] * e0, acc[m][n][1] * e1); w.y = pk2(acc[m][n][2] * e2, acc[m][n][3] * e3);
                    *(v2u*)(dst + dv * 128 + dk) = w; } }
            if (tid < 128) DECC[slot * 128 + tid] = __expf(Bc[lastrow * 1536 + dir * 768 + hd * 128 + tid]);
        }
    }
#undef C1_LOAD
}
__device__ __forceinline__ void gla_scan_item(int it, bf16* STb, const float* DECC, int lane) {
    int seq, hdir, slab;
    if (it < 768) { seq = 8; hdir = it >> 6; slab = it & 63; } else { const int j = it - 768; const int sh = j >> 6; seq = sh / 12; hdir = sh - seq * 12; slab = j & 63; }
    const int c0 = seq < 8 ? seq * 32 : 256, nc = seq < 8 ? 32 : 256, hd = hdir >> 1, dir = hdir & 1;
    const int e0 = slab * 512 + lane * 8, dk0 = e0 & 127;
    float S[8];
#pragma unroll
    for (int j = 0; j < 8; ++j) S[j] = 0.f;
    v4u kvn[8];
#pragma unroll
    for (int i = 0; i < 8; ++i) { const int c = dir == 0 ? c0 + i : c0 + nc - 1 - i; kvn[i] = *(const v4u*)(STb + (size_t)((c * 6 + hd) * 2 + dir) * 32768 + e0); }
    for (int st = 0; st < nc; st += 8) {
        v4u kv[8]; f32x4 d0[8], d1[8];
#pragma unroll
        for (int i = 0; i < 8; ++i) { const int c = dir == 0 ? c0 + st + i : c0 + nc - 1 - (st + i); const int slot = (c * 6 + hd) * 2 + dir;
            kv[i] = kvn[i]; d0[i] = *(const f32x4*)(DECC + slot * 128 + dk0); d1[i] = *(const f32x4*)(DECC + slot * 128 + dk0 + 4); }
        if (st + 8 < nc) {
#pragma unroll
            for (int i = 0; i < 8; ++i) { const int c = dir == 0 ? c0 + st + 8 + i : c0 + nc - 1 - (st + 8 + i); kvn[i] = *(const v4u*)(STb + (size_t)((c * 6 + hd) * 2 + dir) * 32768 + e0); } }
#pragma unroll
        for (int i = 0; i < 8; ++i) { const int c = dir == 0 ? c0 + st + i : c0 + nc - 1 - (st + i); const int slot = (c * 6 + hd) * 2 + dir;
            v4u w; w.x = pk2(S[0], S[1]); w.y = pk2(S[2], S[3]); w.z = pk2(S[4], S[5]); w.w = pk2(S[6], S[7]);
            *(v4u*)(STb + (size_t)slot * 32768 + e0) = w;
            float x[8]; unpack8(kv[i], x);
            S[0] = d0[i].x * S[0] + x[0]; S[1] = d0[i].y * S[1] + x[1]; S[2] = d0[i].z * S[2] + x[2]; S[3] = d0[i].w * S[3] + x[3];
            S[4] = d1[i].x * S[4] + x[4]; S[5] = d1[i].y * S[5] + x[5]; S[6] = d1[i].z * S[6] + x[6]; S[7] = d1[i].w * S[7] + x[7]; }
    }
}
__device__ __forceinline__ void phase_gla_scan(Frame& F, const Args& a) {
    PHASE_IDS();
    bf16* STb = (bf16*)(a.ws + WS_ST); const float* DECC = (const float*)(a.ws + WS_DECC);
    const int gw = F.vcu * NWAVES + wave, NGW = F.G * NWAVES;
    if (F.G == 256) {
        const int cu = blockIdx.x;
        if (wave < 3) gla_scan_item(cu * 3 + wave, STb, DECC, lane);
        else for (int it = 768 + cu * 5 + (wave - 3); it < 768 + 6144; it += 1280) gla_scan_item(it, STb, DECC, lane);
    }
    else for (int it = gw; it < 768 + 6144; it += NGW) gla_scan_item(it, STb, DECC, lane);
}
__device__ __forceinline__ void phase_gla_c3(Frame& F, const Args& a, int layer) {
    PHASE_IDS();
    const int fr = lane & 15, fq = lane >> 4;
    constexpr int PQ = 272, PV = 144;
    LAS unsigned char* Q1 = F.lds + RING_OFF;
    LAS unsigned char* K1 = Q1 + 2 * 64 * PQ;
    LAS unsigned char* VT = K1 + 2 * 64 * PQ;
    LAS unsigned char* Pm = VT + 256 * PV;
    LAS float* red = (LAS float*)(Pm + 2 * 64 * PV);
    const bf16* H = (const bf16*)(a.ws + WS_H); const float* Bc = (const float*)(a.ws + WS_MG);
    const bf16* STb = (const bf16*)(a.ws + WS_ST); bf16* O = (bf16*)(a.ws + WS_XN);
    const float* gn = a.in[6] + layer * 256;
    v4u qraw[2], kraw[2], vraw[4]; f32x4 braw[2][4];
#define C3_LOAD(u_) do { const int c_ = (u_) / 6, hd_ = (u_) - c_ * 6; const size_t r0_ = (size_t)c_ * 64; const int s_ = tid >> 3, dkb_ = (tid & 7) * 16; \
        const v4u* qs_ = (const v4u*)(H + (r0_ + s_) * HP + C_AQ + hd_ * 128 + dkb_); const v4u* ks_ = (const v4u*)(H + (r0_ + s_) * HP + C_AK + hd_ * 128 + dkb_); \
        qraw[0] = qs_[0]; qraw[1] = qs_[1]; kraw[0] = ks_[0]; kraw[1] = ks_[1]; \
        _Pragma("unroll") for (int d_ = 0; d_ < 2; ++d_) { const f32x4* bs_ = (const f32x4*)(Bc + (r0_ + s_) * 1536 + d_ * 768 + hd_ * 128 + dkb_); _Pragma("unroll") for (int i_ = 0; i_ < 4; ++i_) braw[d_][i_] = bs_[i_]; } \
        const v4u* vs_ = (const v4u*)(H + (r0_ + (tid & 63)) * HP + C_AV + hd_ * 256 + (tid >> 6) * 32); _Pragma("unroll") for (int i_ = 0; i_ < 4; ++i_) vraw[i_] = vs_[i_]; } while (0)
    if (F.vcu < 512 * 6) C3_LOAD(F.vcu);
    for (int u = F.vcu; u < 512 * 6; u += F.G) {
        const int c = u / 6, hd = u - c * 6; const size_t r0 = (size_t)c * 64;
        bf16x8 sfr[2][4][2];
#pragma unroll
        for (int dir = 0; dir < 2; ++dir) { const bf16* Sg = STb + (size_t)((c * 6 + hd) * 2 + dir) * 32768;
#pragma unroll
            for (int ks = 0; ks < 4; ++ks)
#pragma unroll
                for (int n = 0; n < 2; ++n) sfr[dir][ks][n] = *(const bf16x8*)(Sg + (32 * wave + 16 * n + fr) * 128 + 32 * ks + 8 * fq); }
        __syncthreads();
        { const int s = tid >> 3, dkb = (tid & 7) * 16; float q0[16], k0[16]; unpack8(qraw[0], q0); unpack8(qraw[1], q0 + 8); unpack8(kraw[0], k0); unpack8(kraw[1], k0 + 8);
#pragma unroll
          for (int dir = 0; dir < 2; ++dir) { float qx[16], kx[16];
#pragma unroll
            for (int i = 0; i < 4; ++i) { const f32x4 bb = braw[dir][i];
#pragma unroll
                for (int j = 0; j < 4; ++j) { const float e = __expf(bb[j]); qx[4 * i + j] = q0[4 * i + j] * e * 0.08838834764831845f; kx[4 * i + j] = k0[4 * i + j] * __builtin_amdgcn_rcpf(e); } }
            v4u w;
            w.x = pk2(qx[0], qx[1]); w.y = pk2(qx[2], qx[3]); w.z = pk2(qx[4], qx[5]); w.w = pk2(qx[6], qx[7]); *(LAS v4u*)(Q1 + (dir * 64 + s) * PQ + dkb * 2) = w;
            w.x = pk2(qx[8], qx[9]); w.y = pk2(qx[10], qx[11]); w.z = pk2(qx[12], qx[13]); w.w = pk2(qx[14], qx[15]); *(LAS v4u*)(Q1 + (dir * 64 + s) * PQ + dkb * 2 + 16) = w;
            w.x = pk2(kx[0], kx[1]); w.y = pk2(kx[2], kx[3]); w.z = pk2(kx[4], kx[5]); w.w = pk2(kx[6], kx[7]); *(LAS v4u*)(K1 + (dir * 64 + s) * PQ + dkb * 2) = w;
            w.x = pk2(kx[8], kx[9]); w.y = pk2(kx[10], kx[11]); w.z = pk2(kx[12], kx[13]); w.w = pk2(kx[14], kx[15]); *(LAS v4u*)(K1 + (dir * 64 + s) * PQ + dkb * 2 + 16) = w; } }
        { const int s = tid & 63, dvb = (tid >> 6) * 32;
#pragma unroll
          for (int i = 0; i < 4; ++i) { const v4u w = vraw[i]; const unsigned ww[4] = {w.x, w.y, w.z, w.w};
#pragma unroll
              for (int j = 0; j < 4; ++j) { *(LAS bf16*)(VT + (dvb + 8 * i + 2 * j) * PV + s * 2) = (bf16)(ww[j] & 0xffffu); *(LAS bf16*)(VT + (dvb + 8 * i + 2 * j + 1) * PV + s * 2) = (bf16)(ww[j] >> 16); } } }
        if (u + F.G < 512 * 6) C3_LOAD(u + F.G);
        __syncthreads();
        { const int mt = wave >> 1, nt0 = (wave & 1) * 2;
#pragma unroll
          for (int dir = 0; dir < 2; ++dir) { f32x4 sc[2] = {(f32x4){0.f, 0.f, 0.f, 0.f}, (f32x4){0.f, 0.f, 0.f, 0.f}};
#pragma unroll
              for (int ks = 0; ks < 4; ++ks) { const bf16x8 af = ldsfrag(Q1 + dir * 64 * PQ, PQ, 16 * mt, 32 * ks, fr, fq);
#pragma unroll
                  for (int nn = 0; nn < 2; ++nn) sc[nn] = MFMA16(ldsfrag(K1 + dir * 64 * PQ, PQ, 16 * (nt0 + nn), 32 * ks, fr, fq), af, sc[nn]); }
              const int t = 16 * mt + fr;
#pragma unroll
              for (int nn = 0; nn < 2; ++nn) { const int sb_ = 16 * (nt0 + nn) + 4 * fq; float p[4];
#pragma unroll
                  for (int j = 0; j < 4; ++j) { const int s_ = sb_ + j; const bool ok = dir == 0 ? s_ <= t : s_ >= t; p[j] = ok ? sc[nn][j] : 0.f; }
                  v2u w; w.x = pk2(p[0], p[1]); w.y = pk2(p[2], p[3]); *(LAS v2u*)(Pm + (dir * 64 + t) * PV + sb_ * 2) = w; } } }
        __syncthreads();
        f32x4 acc[4][2];
#pragma unroll
        for (int m = 0; m < 4; ++m) { acc[m][0] = (f32x4){0.f, 0.f, 0.f, 0.f}; acc[m][1] = (f32x4){0.f, 0.f, 0.f, 0.f}; }
#pragma unroll
        for (int dir = 0; dir < 2; ++dir) {
#pragma unroll
            for (int ks = 0; ks < 4; ++ks) {
#pragma unroll
                for (int m = 0; m < 4; ++m) { const bf16x8 af = ldsfrag(Q1 + dir * 64 * PQ, PQ, 16 * m, 32 * ks, fr, fq); acc[m][0] = MFMA16(sfr[dir][ks][0], af, acc[m][0]); acc[m][1] = MFMA16(sfr[dir][ks][1], af, acc[m][1]); } }
#pragma unroll
            for (int ks = 0; ks < 2; ++ks) { const bf16x8 b0 = ldsfrag(VT, PV, 32 * wave, 32 * ks, fr, fq), b1 = ldsfrag(VT, PV, 32 * wave + 16, 32 * ks, fr, fq);
#pragma unroll
                for (int m = 0; m < 4; ++m) { const bf16x8 af = ldsfrag(Pm + dir * 64 * PV, PV, 16 * m, 32 * ks, fr, fq); acc[m][0] = MFMA16(b0, af, acc[m][0]); acc[m][1] = MFMA16(b1, af, acc[m][1]); } } }
#pragma unroll
        for (int m = 0; m < 4; ++m) { float ss = 0.f;
#pragma unroll
            for (int n = 0; n < 2; ++n)
#pragma unroll
                for (int j = 0; j < 4; ++j) ss += acc[m][n][j] * acc[m][n][j];
            ss += shx<16>(ss); ss = sum32(ss);
            if (fq == 0) red[(16 * m + fr) * 8 + wave] = ss; }
        __syncthreads();
#pragma unroll
        for (int m = 0; m < 4; ++m) { const int t = 16 * m + fr; const f32x4 ra = *(const LAS f32x4*)(red + t * 8), rb = *(const LAS f32x4*)(red + t * 8 + 4);
            const float tot = ((ra.x + ra.y) + (ra.z + ra.w)) + ((rb.x + rb.y) + (rb.z + rb.w)); const float rstd = 1.0f / sqrtf(tot * (1.f / 256.f) + 1e-6f);
            const size_t row = r0 + t;
#pragma unroll
            for (int n = 0; n < 2; ++n) { const int dv = 32 * wave + 16 * n + 4 * fq; const f32x4 g = *(const f32x4*)(gn + dv); const v2u gt = *(const v2u*)(H + row * HP + C_AG + hd * 256 + dv);
                v2u w; w.x = pk2(acc[m][n][0] * rstd * g.x * bflo(gt.x), acc[m][n][1] * rstd * g.y * bfhi(gt.x)); w.y = pk2(acc[m][n][2] * rstd * g.z * bflo(gt.y), acc[m][n][3] * rstd * g.w * bfhi(gt.y));
                *(v2u*)(O + row * D + O_A + hd * 256 + dv) = w; } }
    }
#undef C3_LOAD
}

__global__ void __launch_bounds__(NWAVES * 64, 2) fwd_kernel(Args args) {
    extern __shared__ __attribute__((aligned(16))) unsigned char lds[];
    Frame F;
    F.lds = (LAS unsigned char*)lds;
    F.wv = __builtin_amdgcn_readfirstlane((int)threadIdx.x >> 6);
    volatile LAS unsigned* MISC = (volatile LAS unsigned*)(F.lds + MISC_OFF);
    F.G = gridDim.x; { const int bx = blockIdx.x; F.vcu = (F.G % 8 == 0) ? (bx % 8) * (F.G / 8) + bx / 8 : bx; }
    unsigned char* ws = args.ws;
    gu32* ctl = (gu32*)(ws + WS_CTL);
    for (int u = threadIdx.x; u < (LDS_BYTES - LDSCTL_OFF) / 4; u += NWAVES * 64) ((LAS unsigned*)(F.lds + LDSCTL_OFF))[u] = 0u;
    __syncthreads();
    XcdBarrier bar; bar.bar = (unsigned*)(ctl + CW_BAR); bar.x = 0; bar.st = nullptr; bar.wv = F.wv;
    if (N_LAUNCHES == 1) bar = xcd_barrier_post((unsigned*)(ctl + CW_BAR), MISC + 8, F.wv);
    const int lo = args.ph_lo, hi = args.ph_hi;
#define IN(k) (lo <= (k) && (k) < hi)
#define REPS(bit) ((DUP_MASK & (bit)) ? (hi > 16 ? 2 : 1) : 1)
#define SEAM(k) do { if (IN(k) && IN((k) + 1)) xcd_barrier(bar); } while (0)

    if (IN(0)) { for (int rep = 0; rep < REPS(1); ++rep) phase_convert(F, args); }
    SEAM(0);
    for (int layer = 0; layer < DEPTH; ++layer) {
        const int pb = 1 + 8 * layer;
        if (IN(pb + 0)) { for (int rep = 0; rep < REPS(2); ++rep) phase_rmsnorm(F, args, layer); }
        SEAM(pb + 0);
        if (IN(pb + 1)) {
            pg8::Gemm g{(const bf16*)(ws + WS_XN), (const bf16*)(ws + WS_WIN + layer * (190 * MiB)), (const bf16*)(ws + WS_MG)};
            Sched1 S{(int)blockIdx.x, F.G};
            Epi1 E{(bf16*)(ws + WS_H), (float*)(ws + WS_LR), args.in[14] + layer * 3 * D, ws + WS_G};
            for (int rep = 0; rep < REPS(4); ++rep) {
                pg8::gemm_phase<Epi1, Sched1, true, true>(F.lds + RING_OFF, g, S, E, F.wv);
#if FP8_ATT
                { int c8 = (int)blockIdx.x, g8 = F.G; asm volatile("" : "+s"(c8), "+s"(g8));
                  Sched1F8 S8{c8, g8}; Epi1F8 E8{(bf16*)(ws + WS_H), args.in[14] + layer * 3 * D, ws + WS_G}; pg8::gemm_phase<Epi1F8, Sched1F8, true, true, true>(F.lds + RING_OFF, g, S8, E8, F.wv); }
#endif
            }
        }
        SEAM(pb + 1);
        if (IN(pb + 2)) { phase_prep(F, args, layer); }
        SEAM(pb + 2);
        if (IN(pb + 3)) {
#if MFMA_SGU
            for (int rep = 0; rep < REPS(16); ++rep) phase_sgu(F, args, layer);
#endif
#if MFMA_ATT
            for (int rep = 0; rep < REPS(32); ++rep) phase_attn(F, args, layer);
#endif
#if MFMA_GLA
            for (int rep = 0; rep < REPS(64); ++rep) phase_gla_c1(F, args, layer);
#else
            phase_mix_naive(F, args, layer);
#endif
        }
        SEAM(pb + 3);
        if (IN(pb + 4)) {
#if MFMA_GLA
            phase_gla_scan(F, args);
#endif
        }
        SEAM(pb + 4);
        if (IN(pb + 5)) {
#if MFMA_GLA
            for (int rep = 0; rep < REPS(128); ++rep) phase_gla_c3(F, args, layer);
#else
            phase_gla_fin(F, args, layer);
#endif
        }
        SEAM(pb + 5);
        if (IN(pb + 6)) {
            pg8::Gemm g{(const bf16*)(ws + WS_XN), (const bf16*)(ws + WS_WBR + layer * (32 * MiB)), nullptr};
            Sched2 S{(int)blockIdx.x, F.G};
            Epi2 E{ws + WS_G, (bf16*)(ws + WS_MG)};
            if (STAG2 && (blockIdx.x & 1)) { const unsigned long long t0 = __builtin_amdgcn_s_memrealtime(); while (__builtin_amdgcn_s_memrealtime() - t0 < (unsigned long long)STAG2) __builtin_amdgcn_s_sleep(8); }
            for (int rep = 0; rep < REPS(256); ++rep) pg8::gemm_phase<Epi2, Sched2, true, true>(F.lds + RING_OFF, g, S, E, F.wv);
        }
        SEAM(pb + 6);
        if (IN(pb + 7)) {
            pg8::Gemm g{(const bf16*)(ws + WS_MG), (const bf16*)(ws + WS_WOUT + layer * (32 * MiB)), nullptr};
            Sched3 S{(int)blockIdx.x, F.G};
            Epi3 E{args.in[0], args.in[1], args.out, layer};
            if (STAG3 && (blockIdx.x & 1)) { const unsigned long long t0 = __builtin_amdgcn_s_memrealtime(); while (__builtin_amdgcn_s_memrealtime() - t0 < (unsigned long long)STAG3) __builtin_amdgcn_s_sleep(8); }
            for (int rep = 0; rep < (layer == 0 ? REPS(512) : 1); ++rep) pg8::gemm_phase<Epi3, Sched3, true, true>(F.lds + RING_OFF, g, S, E, F.wv);
        }
        SEAM(pb + 7);
    }
#undef IN
#undef SEAM
}

extern "C" void kernel_launch(void* const* d_in, const int* in_sizes, int n_in, void* d_out, int out_size, void* d_ws, size_t ws_size, hipStream_t stream) {
    static int grid = 0;
    if (grid == 0) {
        if (n_in != 17 || ws_size < WS_END) { fprintf(stderr, "kernel_launch: bad inputs / workspace (%d, %zu < %zu)\n", n_in, ws_size, (size_t)WS_END); grid = -1; return; }
        int dev = 0, cus = 0;
        if (hipGetDevice(&dev) != hipSuccess || hipDeviceGetAttribute(&cus, hipDeviceAttributeMultiprocessorCount, dev) != hipSuccess) { grid = -1; return; }
        if (hipFuncSetAttribute((const void*)fwd_kernel, hipFuncAttributeMaxDynamicSharedMemorySize, LDS_BYTES) != hipSuccess) { grid = -1; return; }
        int per_cu = 0;
        (void)hipOccupancyMaxActiveBlocksPerMultiprocessor(&per_cu, (const void*)fwd_kernel, NWAVES * 64, LDS_BYTES);
        (void)hipGetLastError();
        grid = cus;
    }
    if (grid < 0) return;
    (void)hipMemsetAsync((char*)d_ws + WS_CTL, 0, CTL_ZERO_BYTES, stream);
    Args a{};
    for (int i = 0; i < 17; ++i) a.in[i] = (const float*)d_in[i];
    a.out = (float*)d_out; a.ws = (unsigned char*)d_ws;
    if (N_LAUNCHES == 1) { a.ph_lo = 0; a.ph_hi = N_PHASES; hipLaunchKernelGGL(fwd_kernel, dim3(grid), dim3(NWAVES * 64), LDS_BYTES, stream, a); }
    else for (int p = 0; p < N_PHASES; ++p) { a.ph_lo = p; a.ph_hi = p + 1; hipLaunchKernelGGL(fwd_kernel, dim3(grid), dim3(NWAVES * 64), LDS_BYTES, stream, a); }
}
```

```cpp
#include <hip/hip_runtime.h>
#include <cstdio>
#include <cstdint>

#ifndef MFMA_SGU
#define MFMA_SGU 1
#endif
#ifndef MFMA_ATT
#define MFMA_ATT 1
#endif
#ifndef ATT_FUSED_NORM
#define ATT_FUSED_NORM 0
#endif
#ifndef MFMA_GLA
#define MFMA_GLA 1
#endif
#ifndef KROT
#define KROT 0
#endif
#ifndef STAG2
#define STAG2 0
#endif
#ifndef STAG3
#define STAG3 0
#endif
#ifndef FP8_ATT
#define FP8_ATT 1
#endif
#ifndef F8_TILES
#define F8_TILES 64
#endif
#ifndef F8_OC
#define F8_OC 1
#endif
#ifndef DUP_MASK
#define DUP_MASK 0
#endif
#ifndef MK_N_LAUNCHES
#define MK_N_LAUNCHES 1
#endif

namespace pg8 {
#define PG8_LAS __attribute__((address_space(3)))
typedef unsigned short bf16_t;
typedef short bf16x8 __attribute__((ext_vector_type(8)));
typedef float f32x4 __attribute__((ext_vector_type(4)));
typedef unsigned u32x4 __attribute__((ext_vector_type(4)));
constexpr int BM = 256, BK = 64, HALF = 128, HTB = HALF * BK * 2, STAGE_BYTES = 8 * HTB, NXCD = 8, WGM = 8;

__host__ __device__ __forceinline__ int lds_byte(int r, int c) { const int st = (r >> 4) * 2 + (c >> 5), rr = r & 15, cc = c & 31, ob = rr * 64 + cc * 2; return st * 1024 + (ob ^ (((ob >> 9) & 1) << 5)); }
__host__ __device__ __forceinline__ void stage_rc(int b, int& R, int& C) { const int st = b / 1024, sb = b % 1024, swz = sb ^ (((sb >> 9) & 1) << 5); R = (st >> 1) * 16 + swz / 64; C = (st & 1) * 32 + (swz % 64) / 2; }
__host__ __device__ __forceinline__ int perm32(int rho) { const int n = rho >> 4, i = rho & 15; return 8 * (i >> 2) + 4 * n + (i & 3); }

__device__ __forceinline__ int lane_id_v() { int l; asm volatile("v_mbcnt_lo_u32_b32 %0, -1, 0\n\tv_mbcnt_hi_u32_b32 %0, -1, %0" : "=v"(l)); return l; }
struct Unit { int pm, pn, k0, nt, tag, rot; };
struct Gemm { const bf16_t* A; const bf16_t* Bt; const bf16_t* A8; static constexpr int lda = 4096, ldb = 4096; };

__host__ __device__ __forceinline__ void static_tile(int L, int nM, int nN, int& pm, int& pn) {
    const int nwg = nM * nN; int wgid = L;
    { const int q = nwg / NXCD, r = nwg % NXCD, xcd = wgid % NXCD, off = wgid / NXCD; wgid = (xcd < r ? xcd * (q + 1) : r * (q + 1) + (xcd - r) * q) + off; }
    const int nig = WGM * nN, gid = wgid / nig, fm = gid * WGM, gsz = (nM - fm) < WGM ? (nM - fm) : WGM;
    pm = fm + ((wgid % nig) % gsz); pn = (wgid % nig) / gsz;
}

typedef __bf16 bf16x2v __attribute__((ext_vector_type(2)));
typedef float f32x2v __attribute__((ext_vector_type(2)));
__device__ __forceinline__ unsigned cvt_pk_bf16(float lo, float hi) { const f32x2v v = {lo, hi}; return __builtin_bit_cast(unsigned, __builtin_convertvector(v, bf16x2v)); }

typedef int v8i_t __attribute__((ext_vector_type(8)));
typedef int v4i_t __attribute__((ext_vector_type(4)));
__device__ __forceinline__ f32x4 mfma_f8(bf16x8 b0, bf16x8 b1, bf16x8 a0, bf16x8 a1, f32x4 c) {
    const v8i_t bb = __builtin_shufflevector(__builtin_bit_cast(v4i_t, b0), __builtin_bit_cast(v4i_t, b1), 0, 1, 2, 3, 4, 5, 6, 7);
    const v8i_t aa = __builtin_shufflevector(__builtin_bit_cast(v4i_t, a0), __builtin_bit_cast(v4i_t, a1), 0, 1, 2, 3, 4, 5, 6, 7);
    return __builtin_amdgcn_mfma_scale_f32_16x16x128_f8f6f4(bb, aa, c, 0, 0, 0, 0x7F7F7F7F, 0, 0x7F7F7F7F);
}
template <class Epi, class Sched, bool ALIGN_EPI, bool SP2, bool F8 = false>
__device__ __forceinline__ void gemm_phase(PG8_LAS unsigned char* lds, const Gemm g, const Sched& S, const Epi& E, const int wv) {
    int tid_ = (wv << 6) + lane_id_v(); asm volatile("" : "+v"(tid_));
    const int tid = tid_, wid = __builtin_amdgcn_readfirstlane(tid >> 6), lane = tid & 63, wr = wid >> 2, wc = wid & 3, fr = lane & 15, fq = lane >> 4;
    unsigned voffA[2], voffB[2];
#pragma unroll
    for (int i = 0; i < 2; ++i) { int R, C; stage_rc(tid * 16 + i * 8192, R, C); const int Rb = Epi::PERM ? ((R & ~31) + perm32(R & 31)) : R;
        voffA[i] = (unsigned)(R * g.lda + C) * 2u; voffB[i] = (unsigned)(Rb * g.ldb + C) * 2u; }
    const size_t kstep = (size_t)(BK * 2);
    const size_t hstepA = (size_t)HALF * g.lda * 2, hstepB = (size_t)HALF * g.ldb * 2;
    const unsigned ldsw = (unsigned)wid * 1024u;
    const int aoff = lds_byte(wr * 64 + fr, fq * 8), boff = lds_byte(wc * 32 + fr, fq * 8);
    const int bdelta = (4 * wc - 8 * wr) * 1024; (void)bdelta;
#define PG8_SA(b, h) (((b) * 2 + (h)) * HTB)
#define PG8_SB(b, h) ((4 + (b) * 2 + (h)) * HTB)
#define PG8_STAGE(bufoff, gbase, voff) do { const char* _gb = (const char*)(gbase); asm volatile("" : "+s"(_gb)); _Pragma("unroll") for (int _i = 0; _i < 2; ++_i) { unsigned _vo = (voff)[_i]; asm volatile("" : "+v"(_vo)); \
        __builtin_amdgcn_global_load_lds((const unsigned*)(_gb + _vo), (PG8_LAS unsigned*)(lds + (bufoff) + ldsw + _i * 8192), 16, 0, 0); } } while (0)
#define PG8_LDA(dst, b, h) do { _Pragma("unroll") for (int m = 0; m < 4; ++m) _Pragma("unroll") for (int k = 0; k < 2; ++k) dst[m][k] = *(const PG8_LAS bf16x8*)(lds + PG8_SA(b, h) + aoff + m * 2048 + k * 1024); } while (0)
#define PG8_LDB(dst, b, h) do { int _bo = boff; if constexpr (Epi::F8_FROM >= 0) { _bo = aoff + bdelta; asm volatile("" : "+v"(_bo)); } _Pragma("unroll") for (int n = 0; n < 2; ++n) _Pragma("unroll") for (int k = 0; k < 2; ++k) dst[n][k] = *(const PG8_LAS bf16x8*)(lds + PG8_SB(b, h) + _bo + n * 2048 + k * 1024); } while (0)
#define PG8_MMA(ai, bj, At, Bt) do { __builtin_amdgcn_s_setprio(1); \
        if (lrskip && ((bj) != 0 || wc != 0)) { } else \
        if constexpr (F8) { _Pragma("unroll") for (int m = 0; m < 4; ++m) _Pragma("unroll") for (int n = 0; n < 2; ++n) acc[ai][bj][m][n] = mfma_f8(Bt[n][0], Bt[n][1], At[m][0], At[m][1], acc[ai][bj][m][n]); } \
        else if (Epi::F8_FROM >= 0 && f8seg) { _Pragma("unroll") for (int m = 0; m < 4; ++m) _Pragma("unroll") for (int n = 0; n < 2; ++n) acc[ai][bj][m][n] = mfma_f8(Bt[n][0], Bt[n][1], At[m][0], At[m][1], acc[ai][bj][m][n]); } \
        else { _Pragma("unroll") for (int m = 0; m < 4; ++m) _Pragma("unroll") for (int n = 0; n < 2; ++n) _Pragma("unroll") for (int k = 0; k < 2; ++k) \
        acc[ai][bj][m][n] = __builtin_amdgcn_mfma_f32_16x16x32_bf16(Bt[n][k], At[m][k], acc[ai][bj][m][n], 0, 0, 0); } __builtin_amdgcn_s_setprio(0); } while (0)
#define PG8_WAIT_V(n) asm volatile("s_waitcnt vmcnt(" #n ")" ::: "memory")
#define PG8_WAIT_L(n) asm volatile("s_waitcnt lgkmcnt(" #n ")" ::: "memory")
#define PG8_BAR __builtin_amdgcn_s_barrier()
#define PG8_SCHED __builtin_amdgcn_sched_barrier(0)
    Unit cur, nxt; int ui = 0;
    if (!S.next(0, cur)) return;
    f32x4 acc[2][2][4][2];
#pragma unroll
    for (int a = 0; a < 2; ++a)
#pragma unroll
        for (int b = 0; b < 2; ++b)
#pragma unroll
            for (int m = 0; m < 4; ++m)
#pragma unroll
                for (int n = 0; n < 2; ++n) acc[a][b][m][n] = (f32x4){0.f, 0.f, 0.f, 0.f};
    bf16x8 At[4][2], B0[2][2], B1[2][2];
    const char* cA = (const char*)(F8 ? g.A8 : g.A) + ((size_t)cur.pm * BM * g.lda + cur.k0) * 2; const char* cB = (const char*)g.Bt + ((size_t)(cur.pn * BM + (F8 ? cur.tag * HALF : 0)) * g.ldb + cur.k0) * 2;
    { const size_t o0 = (size_t)(cur.rot & (cur.nt - 1)) * kstep, o1 = (size_t)((cur.rot + 1) & (cur.nt - 1)) * kstep;
    if constexpr (SP2) {
        PG8_STAGE(PG8_SB(0, 0), cB + o0, voffB); PG8_STAGE(PG8_SB(0, 1), cB + hstepB + o0, voffB); PG8_STAGE(PG8_SA(0, 0), cA + o0, voffA); PG8_STAGE(PG8_SA(0, 1), cA + hstepA + o0, voffA);
        if (wr == 1) PG8_BAR;
        PG8_WAIT_V(2); PG8_BAR;
        PG8_STAGE(PG8_SB(1, 0), cB + o1, voffB); PG8_STAGE(PG8_SA(1, 0), cA + o1, voffA); PG8_STAGE(PG8_SB(1, 1), cB + hstepB + o1, voffB);
        PG8_WAIT_V(6); PG8_BAR;
    } else {
        PG8_STAGE(PG8_SB(0, 0), cB + o0, voffB); PG8_STAGE(PG8_SA(0, 0), cA + o0, voffA); PG8_STAGE(PG8_SB(0, 1), cB + hstepB + o0, voffB); PG8_STAGE(PG8_SA(0, 1), cA + hstepA + o0, voffA);
        if (wr == 1) PG8_BAR;
        PG8_WAIT_V(4); PG8_BAR;
        PG8_STAGE(PG8_SB(1, 0), cB + o1, voffB); PG8_STAGE(PG8_SA(1, 0), cA + o1, voffA); PG8_STAGE(PG8_SB(1, 1), cB + hstepB + o1, voffB);
        PG8_WAIT_V(6); PG8_BAR;
    } }
    for (;;) {
        const bool has_next = S.next(ui + 1, nxt);
        const char* nA = has_next ? (const char*)(F8 ? g.A8 : g.A) + ((size_t)nxt.pm * BM * g.lda + nxt.k0) * 2 : cA; const char* nB = has_next ? (const char*)g.Bt + ((size_t)(nxt.pn * BM + (F8 ? nxt.tag * HALF : 0)) * g.ldb + nxt.k0) * 2 : cB;
        const int nt = cur.nt, rot = cur.rot, msk = nt - 1;
        const size_t n0 = has_next ? (size_t)(nxt.rot & (nxt.nt - 1)) * kstep : (size_t)(rot & msk) * kstep, n1 = has_next ? (size_t)((nxt.rot + 1) & (nxt.nt - 1)) * kstep : (size_t)((rot + 1) & msk) * kstep;
#define PG8_BODY(F8SEG, LRS) { \
            constexpr bool lrskip = (LRS); (void)lrskip; \
            if constexpr (Epi::HAS_MID) { if (t == Epi::MID0 || t == Epi::MID1) E.mid(acc, cur, t, wr, wc, fr, fq); } \
            constexpr bool f8seg = (F8SEG); (void)f8seg; \
            const bool last = (t == nt - 2); \
            const size_t k1 = rot ? (size_t)((t + 1 + rot) & msk) * kstep : (size_t)(t + 1) * kstep, k2 = rot ? (size_t)((t + 2 + rot) & msk) * kstep : (size_t)(t + 2) * kstep, k3 = rot ? (size_t)((t + 3 + rot) & msk) * kstep : (size_t)(t + 3) * kstep; \
            const char* a1 = cA + k1; \
            const char* a2 = last ? nA + n0 : cA + k2; const char* b2 = last ? nB + n0 : cB + k2; \
            const char* a3 = last ? nA + n1 : cA + k3; const char* b3 = last ? nB + n1 : cB + k3; \
            if constexpr (SP2) { \
            PG8_LDB(B0, 0, 0); PG8_LDB(B1, 0, 1); PG8_SCHED; PG8_LDA(At, 0, 0); PG8_STAGE(PG8_SA(1, 1), a1 + hstepA, voffA); \
            PG8_WAIT_V(8); PG8_WAIT_L(0); PG8_BAR; PG8_MMA(0, 0, At, B0); PG8_MMA(0, 1, At, B1); PG8_BAR; PG8_SCHED; \
            PG8_LDA(At, 0, 1); PG8_STAGE(PG8_SB(0, 0), b2, voffB); PG8_STAGE(PG8_SB(0, 1), b2 + hstepB, voffB); PG8_STAGE(PG8_SA(0, 0), a2, voffA); \
            PG8_WAIT_V(8); PG8_WAIT_L(0); PG8_BAR; PG8_MMA(1, 0, At, B0); PG8_MMA(1, 1, At, B1); PG8_BAR; PG8_SCHED; \
            PG8_LDB(B0, 1, 0); PG8_LDB(B1, 1, 1); PG8_SCHED; PG8_LDA(At, 1, 0); PG8_STAGE(PG8_SA(0, 1), a2 + hstepA, voffA); \
            PG8_WAIT_V(8); PG8_WAIT_L(0); PG8_BAR; PG8_MMA(0, 0, At, B0); PG8_MMA(0, 1, At, B1); PG8_BAR; PG8_SCHED; \
            PG8_LDA(At, 1, 1); PG8_STAGE(PG8_SB(1, 0), b3, voffB); PG8_STAGE(PG8_SB(1, 1), b3 + hstepB, voffB); PG8_STAGE(PG8_SA(1, 0), a3, voffA); \
            PG8_WAIT_V(8); PG8_WAIT_L(0); PG8_BAR; PG8_MMA(1, 0, At, B0); PG8_MMA(1, 1, At, B1); PG8_BAR; PG8_SCHED; \
            } else { \
            PG8_LDB(B0, 0, 0); PG8_SCHED; PG8_LDA(At, 0, 0); PG8_STAGE(PG8_SA(1, 1), a1 + hstepA, voffA); \
            PG8_WAIT_L(8); PG8_BAR; PG8_WAIT_L(0); PG8_MMA(0, 0, At, B0); PG8_BAR; PG8_SCHED; \
            PG8_LDB(B1, 0, 1); PG8_STAGE(PG8_SB(0, 0), b2, voffB); \
            PG8_BAR; PG8_WAIT_L(0); PG8_MMA(0, 1, At, B1); PG8_BAR; \
            PG8_LDA(At, 0, 1); PG8_STAGE(PG8_SA(0, 0), a2, voffA); \
            PG8_BAR; PG8_WAIT_L(0); PG8_MMA(1, 0, At, B0); PG8_BAR; PG8_SCHED; \
            PG8_STAGE(PG8_SB(0, 1), b2 + hstepB, voffB); \
            PG8_WAIT_V(6); PG8_BAR; PG8_MMA(1, 1, At, B1); PG8_BAR; \
            PG8_LDB(B0, 1, 0); PG8_SCHED; PG8_LDA(At, 1, 0); PG8_STAGE(PG8_SA(0, 1), a2 + hstepA, voffA); \
            PG8_WAIT_L(8); PG8_BAR; PG8_WAIT_L(0); PG8_MMA(0, 0, At, B0); PG8_BAR; PG8_SCHED; \
            PG8_LDB(B1, 1, 1); PG8_STAGE(PG8_SB(1, 0), b3, voffB); \
            PG8_BAR; PG8_WAIT_L(0); PG8_MMA(0, 1, At, B1); PG8_BAR; \
            PG8_LDA(At, 1, 1); PG8_STAGE(PG8_SA(1, 0), a3, voffA); \
            PG8_BAR; PG8_WAIT_L(0); PG8_MMA(1, 0, At, B0); PG8_BAR; PG8_SCHED; \
            PG8_STAGE(PG8_SB(1, 1), b3 + hstepB, voffB); \
            PG8_WAIT_V(6); PG8_BAR; PG8_MMA(1, 1, At, B1); PG8_BAR; \
            } \
        }
        if constexpr (Epi::F8_FROM >= 0) {
            for (int t = 0; t < Epi::F8_FROM; t += 2) PG8_BODY(false, false)
            for (int t = Epi::F8_FROM; t < nt; t += 2) PG8_BODY(true, false)
        } else if constexpr (Epi::LR_PN >= 0) {
            if (cur.pn == Epi::LR_PN) { for (int t = 0; t < nt; t += 2) PG8_BODY(false, true) }
            else { for (int t = 0; t < nt; t += 2) PG8_BODY(false, false) }
        } else {
            for (int t = 0; t < nt; t += 2) PG8_BODY(false, false)
        }
#undef PG8_BODY
        if constexpr (ALIGN_EPI) { if (wr == 0) PG8_BAR; }
        E(acc, cur, wr, wc, fr, fq);
        if (!has_next) break;
#pragma unroll
        for (int a = 0; a < 2; ++a)
#pragma unroll
            for (int b = 0; b < 2; ++b)
#pragma unroll
                for (int m = 0; m < 4; ++m)
#pragma unroll
                    for (int n = 0; n < 2; ++n) acc[a][b][m][n] = (f32x4){0.f, 0.f, 0.f, 0.f};
        cur = nxt; cA = nA; cB = nB; ++ui;
        if constexpr (ALIGN_EPI) { if (wr == 1) PG8_BAR; }
    }
    PG8_WAIT_V(0);
    if constexpr (!ALIGN_EPI) { if (wr == 0) PG8_BAR; }
    PG8_BAR;
#undef PG8_SA
#undef PG8_SB
#undef PG8_STAGE
#undef PG8_LDA
#undef PG8_LDB
#undef PG8_MMA
#undef PG8_WAIT_V
#undef PG8_WAIT_L
#undef PG8_BAR
#undef PG8_SCHED
}
}
using pg8::lane_id_v;

constexpr int NWAVES = 8;
constexpr int T = 32768, TP = 16384;
constexpr int D = 4096, NIN = 24096, DEPTH = 2;
constexpr int HP = 11776;
constexpr int NBROWS = 24320;
constexpr int C_AQ = 0, C_AK = 768, C_AV = 1536, C_AG = 3072, C_BU = 4608, C_BV = 5632, C_BG = 6656, C_CQ = 7680, C_CK = 9216, C_CV = 9728, C_CG = 10240, C_GM = 11776, C_LR = 24064;
constexpr int O_A = 0, O_B = 1536, O_C = 2560;
constexpr int F8_LO = 30, F8_N = F8_TILES, F8_HI = F8_LO + F8_N;
constexpr int N_PHASES = 17;
constexpr int N_LAUNCHES = MK_N_LAUNCHES;

constexpr size_t MiB = 1u << 20;
constexpr size_t WS_CTL = 0, CTL_ZERO_BYTES = 1 * MiB;
constexpr size_t WS_ROPE = 1 * MiB;
constexpr size_t WS_WIN = 3 * MiB, WIN_BYTES = (size_t)NBROWS * D * 2;
constexpr size_t WS_WBR = WS_WIN + 2 * 190 * MiB, WSQ_BYTES = (size_t)D * D * 2;
constexpr size_t WS_WOUT = WS_WBR + 64 * MiB;
constexpr size_t WS_XN = WS_WOUT + 64 * MiB;
constexpr size_t WS_H = WS_XN + 256 * MiB;
constexpr size_t WS_G = WS_H + 736 * MiB;
constexpr size_t WS_ST = WS_G + 768 * MiB;
constexpr size_t WS_MG = WS_ST + 384 * MiB;
constexpr size_t WS_LR = WS_MG + 256 * MiB;
constexpr size_t WS_DECC = WS_LR + 8 * MiB;
constexpr size_t WS_END = WS_DECC + 4 * MiB;
static_assert(WIN_BYTES <= 190 * MiB && (size_t)T * HP * 2 <= 736 * MiB && (size_t)T * 12288 * 2 <= 768 * MiB, "ws map");
__device__ __forceinline__ size_t gate_off(int b, int pm, int ct, int ai, int m, int bj, int wr, int wc, int fr, int fq) {
    return ((((size_t)(b * 128 + pm) * 16 + ct) * 16 + (size_t)((ai * 4 + m) * 2 + bj)) * 512 + (size_t)(((wr * 4 + wc) * 4 + fq) * 16 + fr)) * 16; }
constexpr int CW_TMO = 0, CW_CODE = 1;
constexpr int CW_BAR = 4096;

constexpr int RING_OFF = 0, RING_BYTES = 131072;
constexpr int LDSCTL_OFF = RING_BYTES, MISC_OFF = LDSCTL_OFF + 320;
constexpr int LDS_BYTES = 147456;

#define GAS __attribute__((address_space(1)))
#define LAS __attribute__((address_space(3)))
typedef unsigned short bf16;
typedef unsigned v4u __attribute__((ext_vector_type(4)));
typedef unsigned v2u __attribute__((ext_vector_type(2)));
typedef float f32x4 __attribute__((ext_vector_type(4)));
typedef GAS unsigned gu32;
#define RLX_AGENT __ATOMIC_RELAXED, __HIP_MEMORY_SCOPE_AGENT
#define LDS_WAIT() asm volatile("s_waitcnt lgkmcnt(0)" ::: "memory")
#define VM_WAIT() asm volatile("s_waitcnt vmcnt(0)" ::: "memory")
__device__ __forceinline__ unsigned f2bf(float f) { unsigned u = __builtin_bit_cast(unsigned, f); return (u + 0x7fffu + ((u >> 16) & 1u)) >> 16; }
__device__ __forceinline__ unsigned pk2(float lo, float hi) { return pg8::cvt_pk_bf16(lo, hi); }
__device__ __forceinline__ float bflo(unsigned w) { return __uint_as_float(w << 16); }
__device__ __forceinline__ float bfhi(unsigned w) { return __uint_as_float(w & 0xffff0000u); }
__device__ __forceinline__ float bf1(bf16 v) { return __uint_as_float((unsigned)v << 16); }
__device__ __forceinline__ void unpack8(const v4u w, float* x) { x[0] = bflo(w.x); x[1] = bfhi(w.x); x[2] = bflo(w.y); x[3] = bfhi(w.y); x[4] = bflo(w.z); x[5] = bfhi(w.z); x[6] = bflo(w.w); x[7] = bfhi(w.w); }
__device__ __forceinline__ float sigm(float x) { return __builtin_amdgcn_rcpf(1.0f + __builtin_amdgcn_exp2f(-1.44269504089f * x)); }

#define XB_TMO      128
#define XB_XCNT(j)  (256  + 64 * (j))
#define XB_XSUB(j)  (1280 + 64 * (j))
#define XB_XGEN(j)  (2304 + 64 * (j))
#define XB_TOP      3328
#define XB_TOPGEN   3392
#define XCD_BAR_WORDS 3456
#define XB_SPIN_CAP (1u << 24)
__device__ __forceinline__ unsigned xb_ld(unsigned* p)              { return __hip_atomic_load(p, __ATOMIC_RELAXED, __HIP_MEMORY_SCOPE_AGENT); }
__device__ __forceinline__ unsigned xb_add(unsigned* p, unsigned v) { return __hip_atomic_fetch_add(p, v, __ATOMIC_RELAXED, __HIP_MEMORY_SCOPE_AGENT); }
__device__ __forceinline__ unsigned xb_xcc_id() { return (unsigned)__builtin_amdgcn_s_getreg((3 << 11) | 20) & 0xFu; }
#define XB_SPIN(cond, bar) do { unsigned _sp = 0; while (cond) { __builtin_amdgcn_s_sleep(1); \
    if ((++_sp & 255u) == 0u) { if (xb_ld(&(bar)[XB_TMO])) break; if (_sp > XB_SPIN_CAP) { atomicAdd(&(bar)[XB_TMO], 1u); break; } } } } while (0)
struct XcdBarrier { unsigned* bar; unsigned x; volatile LAS unsigned* st; int wv; };
__device__ __forceinline__ XcdBarrier xcd_barrier_post(unsigned* bar, volatile LAS unsigned* st, int wv) {
    XcdBarrier b; b.bar = bar; b.x = xb_xcc_id(); b.st = st; b.wv = wv;
    if (threadIdx.x == 0) (void)xb_add(&bar[XB_XCNT(b.x)], 1u);
    return b;
}
__device__ __forceinline__ void xcd_barrier_complete(unsigned* bar, unsigned x, unsigned& nloc, unsigned& nx) {
    const unsigned G = gridDim.x * gridDim.y * gridDim.z;
    unsigned sum, cnt, mine, sp = 0u;
    for (;;) {
        sum = 0u; cnt = 0u; mine = 0u;
#pragma unroll
        for (unsigned j = 0; j < 16; ++j) { const unsigned c = xb_ld(&bar[XB_XCNT(j)]); sum += c; cnt += (c > 0u) ? 1u : 0u; mine = (j == x) ? c : mine; }
        if (sum == G) break;
        __builtin_amdgcn_s_sleep(1);
        if ((++sp & 255u) == 0u) { if (xb_ld(&bar[XB_TMO])) break; if (sp > XB_SPIN_CAP) { atomicAdd(&bar[XB_TMO], 1u); break; } }
    }
    nloc = mine > 0u ? mine : 1u; nx = cnt > 0u ? cnt : 1u;
}
__device__ __forceinline__ void xcd_barrier(const XcdBarrier& b) {
    asm volatile("s_waitcnt vmcnt(0)" ::: "memory");
    __syncthreads();
    if (((b.wv << 6) + lane_id_v()) == 0) {
        unsigned* bar = b.bar; asm volatile("" : "+s"(bar));
        __builtin_amdgcn_s_waitcnt(0);
        unsigned nloc = b.st[0], nx = b.st[1];
        if (nloc == 0u) { xcd_barrier_complete(bar, b.x, nloc, nx); b.st[0] = nloc; b.st[1] = nx; }
        const unsigned old = xb_add(&bar[XB_XSUB(b.x)], 1u);
        const unsigned gen = old / nloc;
        if (old + 1u == (gen + 1u) * nloc) {
            __builtin_amdgcn_fence(__ATOMIC_RELEASE, "agent");
            asm volatile("s_waitcnt vmcnt(0)" ::: "memory");
            const unsigned og = xb_add(&bar[XB_TOP], 1u);
            const unsigned tg = og / nx;
            if (og + 1u == (tg + 1u) * nx) xb_add(&bar[XB_TOPGEN], 1u);
            else XB_SPIN(xb_ld(&bar[XB_TOPGEN]) == tg, bar);
            __builtin_amdgcn_fence(__ATOMIC_ACQUIRE, "agent");
            xb_add(&bar[XB_XGEN(b.x)], 1u);
            asm volatile("s_waitcnt vmcnt(0)" ::: "memory");
        } else {
            XB_SPIN(xb_ld(&bar[XB_XGEN(b.x)]) == gen, bar);
            __builtin_amdgcn_fence(__ATOMIC_ACQUIRE, "agent");
            asm volatile("s_waitcnt vmcnt(0)" ::: "memory");
        }
    }
    __syncthreads();
}

struct Args { const float* in[17]; float* out; unsigned char* ws; int ph_lo, ph_hi; };
struct Frame {
    LAS unsigned char* lds;
    int vcu, G, wv;
};
#define PHASE_IDS() int tid_ = (F.wv << 6) + lane_id_v(); asm volatile("" : "+v"(tid_)); const int tid = tid_, lane = tid & 63, wave = __builtin_amdgcn_readfirstlane(tid >> 6); (void)tid; (void)lane; (void)wave
template <int M> __device__ __forceinline__ float shx(float v) { return __builtin_bit_cast(float, __builtin_amdgcn_ds_swizzle(__builtin_bit_cast(int, v), (M << 10) | 0x1f)); }
__device__ __forceinline__ int lane32x() { return (lane_id_v() ^ 32) << 2; }
__device__ __forceinline__ float xch32(float v, bool) { return __builtin_bit_cast(float, __builtin_amdgcn_ds_bpermute(lane32x(), __builtin_bit_cast(int, v))); }
__device__ __forceinline__ float sum32(float v) { return v + xch32(v, false); }
__device__ __forceinline__ float max32(float v) { return fmaxf(v, xch32(v, false)); }
__device__ __forceinline__ float wave_sum(float v) { v += shx<1>(v); v += shx<2>(v); v += shx<4>(v); v += shx<8>(v); v += shx<16>(v); return sum32(v); }
__device__ __forceinline__ float wave_max(float v) { v = fmaxf(v, shx<1>(v)); v = fmaxf(v, shx<2>(v)); v = fmaxf(v, shx<4>(v)); v = fmaxf(v, shx<8>(v)); v = fmaxf(v, shx<16>(v)); return max32(v); }

struct CvtItem { const float* W; const float* kgain; bf16* WT; int Nsrc, nsrc0, ndst0, k0, f8, kd; };
__device__ __forceinline__ CvtItem cvt_decode(const Args& a, int it) {
    constexpr int I_IN = 64 * (NBROWS / 32), I_SQ = 64 * (D / 32), I_L = I_IN + 2 * I_SQ;
    CvtItem c; const int l = it / I_L; int r = it - l * I_L;
    if (r < I_IN) { const int nb = r % (NBROWS / 32), kb = r / (NBROWS / 32), nm = nb * 32;
        c.W = a.in[3] + (size_t)l * D * NIN; c.Nsrc = NIN; c.nsrc0 = nm < 3072 ? nm : (nm < C_LR ? nm + 32 : (nm < C_LR + 32 ? 3072 + (nm - C_LR) : -1));
        c.kgain = a.in[2] + l * D; c.WT = (bf16*)(a.ws + WS_WIN + l * (190 * MiB)); c.ndst0 = nm; c.k0 = kb * 64; c.kd = c.k0; c.f8 = (FP8_ATT && nm >= F8_LO * 256 && nm < F8_HI * 256) ? 1 : 0; return c; }
    r -= I_IN; const bool br = r < I_SQ; if (!br) r -= I_SQ;
    const int nb = r % (D / 32), kb = r / (D / 32);
    c.W = a.in[br ? 15 : 16] + (size_t)l * D * D; c.Nsrc = D; c.nsrc0 = nb * 32; c.kgain = nullptr; c.WT = (bf16*)(a.ws + (br ? WS_WBR : WS_WOUT) + l * (32 * MiB)); c.ndst0 = nb * 32; c.k0 = kb * 64; c.kd = c.k0; c.f8 = 0;
    if (F8_OC && br && c.k0 >= 2560) { c.f8 = 1; c.kd = 5120 + (c.k0 - 2560); }
    return c;
}
__device__ __forceinline__ void cvt_load(const CvtItem& c, int lane, f32x4 (&v)[8]) {
    const int kr = lane >> 3, nq = (lane & 7) * 4;
#pragma unroll
    for (int i = 0; i < 8; ++i) { v[i] = (f32x4){0.f, 0.f, 0.f, 0.f};
        if (c.nsrc0 >= 0) { v[i] = *(const f32x4*)(c.W + (size_t)(c.k0 + kr + 8 * i) * c.Nsrc + c.nsrc0 + nq); if (c.kgain) v[i] = v[i] * c.kgain[c.k0 + kr + 8 * i]; } }
}
__device__ __forceinline__ void cvt_store(const CvtItem& c, int lane, const f32x4 (&v)[8], LAS float* scr) {
    const int kr = lane >> 3, nq = (lane & 7) * 4;
#pragma unroll
    for (int i = 0; i < 8; ++i) { LAS float* d = scr + (kr + 8 * i) * 33 + nq; d[0] = v[i].x; d[1] = v[i].y; d[2] = v[i].z; d[3] = v[i].w; }
    LDS_WAIT(); asm volatile("" ::: "memory");
    const int cc = lane & 7;
#pragma unroll
    for (int j = 0; j < 4; ++j) { const int n = (lane >> 3) + 8 * j; const LAS float* s = scr + (8 * cc) * 33 + n;
        if (c.f8) {
            int w0 = 0, w1 = 0;
#define F8C(x) __builtin_amdgcn_fmed3f(64.f * (x), -448.f, 448.f)
            w0 = __builtin_amdgcn_cvt_pk_fp8_f32(F8C(s[0 * 33]), F8C(s[1 * 33]), w0, false); w0 = __builtin_amdgcn_cvt_pk_fp8_f32(F8C(s[2 * 33]), F8C(s[3 * 33]), w0, true);
            w1 = __builtin_amdgcn_cvt_pk_fp8_f32(F8C(s[4 * 33]), F8C(s[5 * 33]), w1, false); w1 = __builtin_amdgcn_cvt_pk_fp8_f32(F8C(s[6 * 33]), F8C(s[7 * 33]), w1, true);
#undef F8C
            v2u o2; o2.x = (unsigned)w0; o2.y = (unsigned)w1;
            *(GAS v2u*)((GAS unsigned char*)c.WT + (size_t)(c.ndst0 + n) * 8192 + c.kd + 8 * cc) = o2;
        } else {
        v4u o; o.x = pk2(s[0 * 33], s[1 * 33]); o.y = pk2(s[2 * 33], s[3 * 33]); o.z = pk2(s[4 * 33], s[5 * 33]); o.w = pk2(s[6 * 33], s[7 * 33]);
        *(GAS v4u*)(c.WT + (size_t)(c.ndst0 + n) * D + c.kd + 8 * cc) = o; } }
    LDS_WAIT(); asm volatile("" ::: "memory");
}
__device__ __forceinline__ void phase_convert(Frame& F, const Args& a) {
    PHASE_IDS();
    LAS float* scr = (LAS float*)(F.lds + RING_OFF + wave * 16384);
    const int gw = F.vcu * NWAVES + wave, NGW = F.G * NWAVES;
    constexpr int I_IN = 64 * (NBROWS / 32), I_SQ = 64 * (D / 32), I_L = I_IN + 2 * I_SQ, NIT = DEPTH * I_L;
    if (gw < NIT) {
        CvtItem cur = cvt_decode(a, gw); f32x4 v[8]; cvt_load(cur, lane, v);
        for (int it = gw; it < NIT; it += NGW) {
            const int itn = it + NGW; CvtItem nxt = cur; f32x4 vn[8];
            if (itn < NIT) { nxt = cvt_decode(a, itn); cvt_load(nxt, lane, vn); }
            cvt_store(cur, lane, v, scr);
            cur = nxt;
#pragma unroll
            for (int i = 0; i < 8; ++i) v[i] = vn[i];
        }
    }
    float2* rt = (float2*)(a.ws + WS_ROPE);
    for (int e = (F.vcu * NWAVES + wave) * 64 + lane; e < 16384 * 16; e += F.G * NWAVES * 64) {
        const int pos = e >> 4, i = e & 15;
        const float inv = (float)pow(500000.0, -(double)(2 * i) / 32.0);
        const float ang = (float)pos * inv;
        double sn, cs; sincos((double)ang, &sn, &cs);
        rt[e] = make_float2((float)cs, (float)sn);
    }
}

__device__ __forceinline__ void phase_rmsnorm(Frame& F, const Args& a, int layer) {
    PHASE_IDS();
    const int gw = F.vcu * NWAVES + wave, NGW = F.G * NWAVES;
    bf16* XN = (bf16*)(a.ws + WS_XN);
    for (int m = gw; m < T; m += NGW) {
        const float* xrow = layer == 0 ? (m < TP ? a.in[0] + (size_t)m * D : a.in[1] + (size_t)(m - TP) * D) : a.out + (size_t)m * D;
        const GAS f32x4* xr = (const GAS f32x4*)xrow + lane;
        f32x4 v[16]; float s = 0.f;
#pragma unroll
        for (int j = 0; j < 16; ++j) { v[j] = xr[64 * j]; s += (v[j].x * v[j].x + v[j].y * v[j].y) + (v[j].z * v[j].z + v[j].w * v[j].w); }
        const float rstd = 1.0f / sqrtf(wave_sum(s) * (1.f / D) + 1e-6f);
        GAS v2u* o8 = (GAS v2u*)(XN + (size_t)m * D) + lane;
#pragma unroll
        for (int j = 0; j < 16; ++j) { v2u w; w.x = pk2(v[j].x * rstd, v[j].y * rstd); w.y = pk2(v[j].z * rstd, v[j].w * rstd); o8[64 * j] = w; }
#if FP8_ATT
        GAS unsigned* f8p = (GAS unsigned*)(a.ws + WS_MG + (size_t)m * 8192) + lane;
#pragma unroll
        for (int j = 0; j < 16; ++j) { int w = 0; w = __builtin_amdgcn_cvt_pk_fp8_f32(v[j].x * rstd, v[j].y * rstd, w, false); w = __builtin_amdgcn_cvt_pk_fp8_f32(v[j].z * rstd, v[j].w * rstd, w, true); f8p[64 * j] = (unsigned)w; }
#endif
    }
}

struct Sched1 {
    int c, G;
    __device__ __forceinline__ bool next(int i, pg8::Unit& u) const {
        constexpr int NT = FP8_ATT ? 94 - F8_N : 94;
        const bool hf = (c & 1) && G == 256;
        u.rot = 0;
        if (hf) { if (i == 0) { u.pm = c >> 1; u.pn = 94; u.k0 = 2048; u.nt = 32; u.tag = 1; return true; } i -= 1; }
        long L = (long)i * G + c;
        if (L < 128 * NT) { pg8::static_tile((int)L, 128, NT, u.pm, u.pn); if (FP8_ATT && u.pn >= F8_LO) u.pn += F8_N; u.k0 = 0; u.nt = 64; u.tag = 0; u.rot = KROT * (c & 7); return true; }
        if (hf) return false;
        L -= 128 * NT;
        if (G == 256) { if (L < 256 && !(L & 1)) { u.pm = (int)(L >> 1); u.pn = 94; u.k0 = 0; u.nt = 32; u.tag = 0; return true; } return false; }
        if (L < 256) { u.pm = (int)(L >> 1); u.pn = 94; u.k0 = (int)(L & 1) * 2048; u.nt = 32; u.tag = (int)(L & 1); return true; }
        return false;
    }
};
struct Sched1F8 {
    int c, G;
    __device__ __forceinline__ bool next(int i, pg8::Unit& u) const {
        const long L = (long)i * G + c; if (L >= 128 * F8_N) return false;
        pg8::static_tile((int)L, 128, F8_N, u.pm, u.pn); u.pn += F8_LO; u.k0 = 0; u.nt = 32; u.tag = 0; u.rot = 0; return true;
    }
};
struct Sched2 {
    int c, G;
    __device__ __forceinline__ bool next(int i, pg8::Unit& u) const {
        const long L = (long)i * G + c; if (L >= 128 * 16) return false;
        pg8::static_tile((int)L, 128, 16, u.pm, u.pn); u.k0 = 0; u.nt = F8_OC ? 52 : 64; u.tag = 0; u.rot = 0; return true;
    }
};
struct Sched3 {
    int c, G;
    __device__ __forceinline__ bool next(int i, pg8::Unit& u) const {
        const long L = (long)i * G + c; if (L >= 128 * 16) return false;
        pg8::static_tile((int)L, 128, 16, u.pm, u.pn); u.k0 = 0; u.nt = 64; u.tag = 0; u.rot = KROT * (c & 7); return true;
    }
};
struct Epi1 {
    static constexpr bool PERM = true, HAS_MID = false; static constexpr int MID0 = -1, MID1 = -1, F8_FROM = -1, LR_PN = 94;
    bf16* H; float* LR; const float* gbias; unsigned char* G;
    __device__ __forceinline__ void operator()(const f32x4 (&acc)[2][2][4][2], const pg8::Unit& u, int wr, int wc, int fr, int fq) const {
        using namespace pg8;
        const int row0 = u.pm * BM + wr * 64 + fr;
        if (u.pn == 94) {
            if (wc == 0) { float* base = LR + (size_t)u.tag * T * 32 + 8 * fq;
#pragma unroll
                for (int ai = 0; ai < 2; ++ai)
#pragma unroll
                    for (int m = 0; m < 4; ++m) { float* rp = base + (size_t)(row0 + ai * HALF + m * 16) * 32;
                        *(f32x4*)rp = acc[ai][0][m][0]; *(f32x4*)(rp + 4) = acc[ai][0][m][1]; } }
            return;
        }
        const int pn = u.pn;
        const int act = pn < 12 ? 0 : (pn < 18 ? 1 : (pn < 26 ? 2 : (pn < 30 ? 1 : (pn < 40 ? 0 : (pn < 46 ? 1 : 3)))));
        const int col0 = pn * BM + wc * 32 + 8 * fq;
        if (act == 0) {
#pragma unroll
            for (int ai = 0; ai < 2; ++ai)
#pragma unroll
                for (int m = 0; m < 4; ++m) { bf16* rowp = H + (size_t)(row0 + ai * HALF + m * 16) * HP + col0;
#pragma unroll
                    for (int bj = 0; bj < 2; ++bj) { const f32x4 v0 = acc[ai][bj][m][0], v1 = acc[ai][bj][m][1];
                        u32x4 w; w.x = cvt_pk_bf16(v0[0], v0[1]); w.y = cvt_pk_bf16(v0[2], v0[3]); w.z = cvt_pk_bf16(v1[0], v1[1]); w.w = cvt_pk_bf16(v1[2], v1[3]);
                        __builtin_nontemporal_store(w, (u32x4*)(rowp + bj * HALF)); } }
            return;
        }
        if (act == 3) {
            f32x4 bv[2][2];
#pragma unroll
            for (int bj = 0; bj < 2; ++bj)
#pragma unroll
                for (int n = 0; n < 2; ++n) bv[bj][n] = *(const f32x4*)(gbias + (pn - 46) * BM + wc * 32 + 8 * fq + bj * HALF + 4 * n);
            const int gb = (pn - 46) >> 4, gct = (pn - 46) & 15;
#pragma unroll
            for (int ai = 0; ai < 2; ++ai)
#pragma unroll
                for (int m = 0; m < 4; ++m) {
#pragma unroll
                    for (int bj = 0; bj < 2; ++bj) { float x[8];
#pragma unroll
                        for (int j = 0; j < 4; ++j) { x[j] = sigm(acc[ai][bj][m][0][j] + bv[bj][0][j]); x[4 + j] = sigm(acc[ai][bj][m][1][j] + bv[bj][1][j]); }
                        u32x4 w; w.x = cvt_pk_bf16(x[0], x[1]); w.y = cvt_pk_bf16(x[2], x[3]); w.z = cvt_pk_bf16(x[4], x[5]); w.w = cvt_pk_bf16(x[6], x[7]);
                        __builtin_nontemporal_store(w, (u32x4*)(G + gate_off(gb, u.pm, gct, ai, m, bj, wr, wc, fr, fq))); } }
        } else if (act == 1) {
#pragma unroll
            for (int ai = 0; ai < 2; ++ai)
#pragma unroll
                for (int m = 0; m < 4; ++m) { bf16* rowp = H + (size_t)(row0 + ai * HALF + m * 16) * HP + col0;
#pragma unroll
                    for (int bj = 0; bj < 2; ++bj) { float x[8];
#pragma unroll
                        for (int j = 0; j < 4; ++j) { const float a0 = acc[ai][bj][m][0][j], a1 = acc[ai][bj][m][1][j]; x[j] = a0 * sigm(a0); x[4 + j] = a1 * sigm(a1); }
                        u32x4 w; w.x = cvt_pk_bf16(x[0], x[1]); w.y = cvt_pk_bf16(x[2], x[3]); w.z = cvt_pk_bf16(x[4], x[5]); w.w = cvt_pk_bf16(x[6], x[7]);
                        __builtin_nontemporal_store(w, (u32x4*)(rowp + bj * HALF)); } }
        } else {
#pragma unroll
            for (int ai = 0; ai < 2; ++ai)
#pragma unroll
                for (int m = 0; m < 4; ++m) { bf16* rowp = H + (size_t)(row0 + ai * HALF + m * 16) * HP + col0;
#pragma unroll
                    for (int bj = 0; bj < 2; ++bj) { float x[8];
#pragma unroll
                        for (int j = 0; j < 4; ++j) { const float a0 = acc[ai][bj][m][0][j], a1 = acc[ai][bj][m][1][j];
                            x[j] = a0 * sigm(1.5957691216f * (a0 + 0.044715f * a0 * a0 * a0)); x[4 + j] = a1 * sigm(1.5957691216f * (a1 + 0.044715f * a1 * a1 * a1)); }
                        u32x4 w; w.x = cvt_pk_bf16(x[0], x[1]); w.y = cvt_pk_bf16(x[2], x[3]); w.z = cvt_pk_bf16(x[4], x[5]); w.w = cvt_pk_bf16(x[6], x[7]);
                        __builtin_nontemporal_store(w, (u32x4*)(rowp + bj * HALF)); } }
        }
    }
};
struct Epi1F8 {
    static constexpr bool PERM = true, HAS_MID = false; static constexpr int MID0 = -1, MID1 = -1, F8_FROM = -1, LR_PN = -1;
    bf16* H; const float* gbias; unsigned char* G;
    __device__ __forceinline__ void operator()(const f32x4 (&acc)[2][2][4][2], const pg8::Unit& u, int wr, int wc, int fr, int fq) const {
        using namespace pg8;
        { const int l = lane_id_v(); fr = l & 15; fq = l >> 4; }
        if (u.pn >= 46) {
            const int pn = u.pn; f32x4 bv[2][2];
#pragma unroll
            for (int bj = 0; bj < 2; ++bj)
#pragma unroll
                for (int n = 0; n < 2; ++n) bv[bj][n] = -1.44269504089f * *(const f32x4*)(gbias + (pn - 46) * BM + wc * 32 + 8 * fq + bj * HALF + 4 * n);
            const int gb = (pn - 46) >> 4, gct = (pn - 46) & 15;
            constexpr float KS = -1.44269504089f * 0.015625f;
#pragma unroll
            for (int ai = 0; ai < 2; ++ai)
#pragma unroll
                for (int m = 0; m < 4; ++m) {
#pragma unroll
                    for (int bj = 0; bj < 2; ++bj) { float x[8];
#pragma unroll
                        for (int j = 0; j < 4; ++j) { x[j] = __builtin_amdgcn_rcpf(1.0f + __builtin_amdgcn_exp2f(acc[ai][bj][m][0][j] * KS + bv[bj][0][j])); x[4 + j] = __builtin_amdgcn_rcpf(1.0f + __builtin_amdgcn_exp2f(acc[ai][bj][m][1][j] * KS + bv[bj][1][j])); }
                        u32x4 w; w.x = cvt_pk_bf16(x[0], x[1]); w.y = cvt_pk_bf16(x[2], x[3]); w.z = cvt_pk_bf16(x[4], x[5]); w.w = cvt_pk_bf16(x[6], x[7]);
                        __builtin_nontemporal_store(w, (u32x4*)(G + gate_off(gb, u.pm, gct, ai, m, bj, wr, wc, fr, fq))); } }
            return;
        }
        const int row0 = u.pm * BM + wr * 64 + fr, col0 = u.pn * BM + u.tag * HALF + wc * 32 + 8 * fq; const bool gate = u.pn >= 40;
#pragma unroll
        for (int ai = 0; ai < 2; ++ai)
#pragma unroll
            for (int m = 0; m < 4; ++m)
#pragma unroll
              for (int bj = 0; bj < 2; ++bj) { float x[8];
#pragma unroll
                for (int j = 0; j < 4; ++j) { x[j] = acc[ai][bj][m][0][j] * 0.015625f; x[4 + j] = acc[ai][bj][m][1][j] * 0.015625f; }
                if (gate) {
#pragma unroll
                    for (int j = 0; j < 8; ++j) x[j] = x[j] * sigm(x[j]); }
                u32x4 w; w.x = cvt_pk_bf16(x[0], x[1]); w.y = cvt_pk_bf16(x[2], x[3]); w.z = cvt_pk_bf16(x[4], x[5]); w.w = cvt_pk_bf16(x[6], x[7]);
                __builtin_nontemporal_store(w, (u32x4*)(H + (size_t)(row0 + ai * HALF + m * 16) * HP + col0 + bj * HALF)); }
    }
};
struct Epi2 {
    static constexpr bool PERM = true, HAS_MID = true; static constexpr int MID0 = 24, MID1 = 40, F8_FROM = F8_OC ? 40 : -1, LR_PN = -1;
    const unsigned char* G; bf16* MG;
    __device__ __forceinline__ void mid(f32x4 (&acc)[2][2][4][2], const pg8::Unit& u, int t, int wr, int wc, int fr, int fq) const {
        using namespace pg8;
        { const int l = lane_id_v(); fr = l & 15; fq = l >> 4; }
        const int row0 = u.pm * BM + wr * 64 + fr, col0 = u.pn * BM + wc * 32 + 8 * fq, b = t == MID0 ? 0 : 1;
        const float sc = (F8_OC && b == 1) ? 512.f : 1.f;
#pragma unroll
        for (int ai = 0; ai < 2; ++ai) {
            u32x4 ga[4][2], gb[4][2];
#pragma unroll
            for (int m = 0; m < 4; ++m) {
#pragma unroll
                for (int bj = 0; bj < 2; ++bj) { ga[m][bj] = *(const u32x4*)(G + gate_off(b, u.pm, u.pn, ai, m, bj, wr, wc, fr, fq)); gb[m][bj] = *(const u32x4*)(G + gate_off(b + 1, u.pm, u.pn, ai, m, bj, wr, wc, fr, fq)); } }
#pragma unroll
            for (int m = 0; m < 4; ++m)
#pragma unroll
                for (int bj = 0; bj < 2; ++bj) { float xa[8], xb[8]; unpack8(ga[m][bj], xa); unpack8(gb[m][bj], xb);
#pragma unroll
                    for (int j = 0; j < 4; ++j) { acc[ai][bj][m][0][j] *= xa[j] * __builtin_amdgcn_rcpf(xb[j]) * sc; acc[ai][bj][m][1][j] *= xa[4 + j] * __builtin_amdgcn_rcpf(xb[4 + j]) * sc; } }
        }
    }
    __device__ __forceinline__ void operator()(const f32x4 (&acc)[2][2][4][2], const pg8::Unit& u, int wr, int wc, int fr, int fq) const {
        using namespace pg8;
        { const int l = lane_id_v(); fr = l & 15; fq = l >> 4; }
        const int row0 = u.pm * BM + wr * 64 + fr, col0 = u.pn * BM + wc * 32 + 8 * fq;
#pragma unroll
        for (int ai = 0; ai < 2; ++ai)
#pragma unroll
            for (int m = 0; m < 4; ++m) { const size_t row = (size_t)(row0 + ai * HALF + m * 16);
                bf16* mp = MG + row * D + col0;
#pragma unroll
                for (int bj = 0; bj < 2; ++bj) { const u32x4 gw = *(const u32x4*)(G + gate_off(2, u.pm, u.pn, ai, m, bj, wr, wc, fr, fq));
                    float g[8]; unpack8(gw, g);
                    if (F8_OC) {
#pragma unroll
                        for (int j = 0; j < 8; ++j) g[j] *= (1.f / 512.f); }
                    u32x4 w; w.x = cvt_pk_bf16(acc[ai][bj][m][0][0] * g[0], acc[ai][bj][m][0][1] * g[1]); w.y = cvt_pk_bf16(acc[ai][bj][m][0][2] * g[2], acc[ai][bj][m][0][3] * g[3]);
                    w.z = cvt_pk_bf16(acc[ai][bj][m][1][0] * g[4], acc[ai][bj][m][1][1] * g[5]); w.w = cvt_pk_bf16(acc[ai][bj][m][1][2] * g[6], acc[ai][bj][m][1][3] * g[7]);
                    *(u32x4*)(mp + bj * HALF) = w; } }
    }
};
struct Epi3 {
    static constexpr bool PERM = false, HAS_MID = false; static constexpr int MID0 = -1, MID1 = -1, F8_FROM = -1, LR_PN = -1;
    const float* xp; const float* xs; float* out; int layer;
    __device__ __forceinline__ void operator()(const f32x4 (&acc)[2][2][4][2], const pg8::Unit& u, int wr, int wc, int fr, int fq) const {
        using namespace pg8;
        const int row0 = u.pm * BM + wr * 64 + fr, col0 = u.pn * BM + wc * 32 + 4 * fq;
#pragma unroll
        for (int ai = 0; ai < 2; ++ai)
#pragma unroll
            for (int m = 0; m < 4; ++m) { const int row = row0 + ai * HALF + m * 16;
                const float* xr = (layer == 0 ? (row < TP ? xp + (size_t)row * D : xs + (size_t)(row - TP) * D) : out + (size_t)row * D) + col0;
                float* op = out + (size_t)row * D + col0;
#pragma unroll
                for (int bj = 0; bj < 2; ++bj)
#pragma unroll
                    for (int n = 0; n < 2; ++n) { const f32x4 xv = *(const f32x4*)(xr + bj * HALF + n * 16); __builtin_nontemporal_store(xv + acc[ai][bj][m][n], (f32x4*)(op + bj * HALF + n * 16)); } }
    }
};

__device__ __forceinline__ void phase_prep(Frame& F, const Args& a, int layer) {
    PHASE_IDS();
    const int gw = F.vcu * NWAVES + wave, NGW = F.G * NWAVES;
    bf16* H = (bf16*)(a.ws + WS_H);
    const float2* rt = (const float2*)(a.ws + WS_ROPE);
    const float* qg = a.in[11] + layer * 128; const float* kg = a.in[12] + layer * 128;
#if !(MFMA_ATT && ATT_FUSED_NORM)
    {
        const int li = lane & 15;
        float qgv[8], kgv[8];
#pragma unroll
        for (int i = 0; i < 8; ++i) { qgv[i] = qg[8 * li + i]; kgv[i] = kg[8 * li + i]; }
        v4u w[4], wn[4];
        if (gw < T) { const v4u* p = (const v4u*)(H + (size_t)gw * HP + C_CQ) + lane;
#pragma unroll
            for (int j = 0; j < 4; ++j) w[j] = p[64 * j]; }
        for (int row = gw; row < T; row += NGW) {
            const int rn = row + NGW;
            if (rn < T) { const v4u* p = (const v4u*)(H + (size_t)rn * HP + C_CQ) + lane;
#pragma unroll
                for (int j = 0; j < 4; ++j) wn[j] = p[64 * j]; }
            const int pos = row < TP ? (row & 2047) : row - TP;
            float cs[8], sn[8];
            if (li < 4) { const f32x4* r4 = (const f32x4*)(rt + pos * 16 + 8 * (li & 1));
#pragma unroll
                for (int i = 0; i < 4; ++i) { const f32x4 t4 = r4[i]; cs[2 * i] = t4.x; sn[2 * i] = t4.y; cs[2 * i + 1] = t4.z; sn[2 * i + 1] = t4.w; } }
            v4u* po = (v4u*)(H + (size_t)row * HP + C_CQ) + lane;
#pragma unroll
            for (int j = 0; j < 4; ++j) { float x[8]; unpack8(w[j], x);
                float ss = 0.f;
#pragma unroll
                for (int i = 0; i < 8; ++i) ss += x[i] * x[i];
                ss += shx<1>(ss); ss += shx<2>(ss); ss += shx<4>(ss); ss += shx<8>(ss);
                const float rstd = 1.0f / sqrtf(ss * (1.f / 128.f) + 1e-6f);
                const bool isq = j < 3;
#pragma unroll
                for (int i = 0; i < 8; ++i) x[i] = x[i] * rstd * (isq ? qgv[i] : kgv[i]);
                float pv[8];
#pragma unroll
                for (int i = 0; i < 8; ++i) pv[i] = shx<2>(x[i]);
                if (li < 4) {
#pragma unroll
                    for (int i = 0; i < 8; ++i) x[i] = li < 2 ? x[i] * cs[i] - pv[i] * sn[i] : x[i] * cs[i] + pv[i] * sn[i]; }
                if (isq) {
#pragma unroll
                    for (int i = 0; i < 8; ++i) x[i] *= (MFMA_ATT ? 0.12751743082459868f : 0.08838834764831845f); }
                v4u o; o.x = pk2(x[0], x[1]); o.y = pk2(x[2], x[3]); o.z = pk2(x[4], x[5]); o.w = pk2(x[6], x[7]);
                po[64 * j] = o; }
#pragma unroll
            for (int j = 0; j < 4; ++j) w[j] = wn[j];
        }
    }
#endif
#if !MFMA_SGU
    const float* lg = a.in[7] + layer * 1024; const float* lb = a.in[8] + layer * 1024;
    for (int row = gw; row < T; row += NGW) {
        v4u* p = (v4u*)(H + (size_t)row * HP + C_BV) + lane;
        v4u w0 = p[0], w1 = p[64]; float x[16];
        x[0] = bflo(w0.x); x[1] = bfhi(w0.x); x[2] = bflo(w0.y); x[3] = bfhi(w0.y); x[4] = bflo(w0.z); x[5] = bfhi(w0.z); x[6] = bflo(w0.w); x[7] = bfhi(w0.w);
        x[8] = bflo(w1.x); x[9] = bfhi(w1.x); x[10] = bflo(w1.y); x[11] = bfhi(w1.y); x[12] = bflo(w1.z); x[13] = bfhi(w1.z); x[14] = bflo(w1.w); x[15] = bfhi(w1.w);
        float s = 0.f;
#pragma unroll
        for (int j = 0; j < 16; ++j) s += x[j];
        const float mean = wave_sum(s) * (1.f / 1024.f); float q = 0.f;
#pragma unroll
        for (int j = 0; j < 16; ++j) { x[j] -= mean; q += x[j] * x[j]; }
        const float rstd = 1.0f / sqrtf(wave_sum(q) * (1.f / 1024.f) + 1e-5f);
#pragma unroll
        for (int j = 0; j < 16; ++j) { const int c = (j < 8 ? 8 * lane + j : 512 + 8 * lane + (j - 8)); x[j] = x[j] * rstd * lg[c] + lb[c]; }
        w0.x = pk2(x[0], x[1]); w0.y = pk2(x[2], x[3]); w0.z = pk2(x[4], x[5]); w0.w = pk2(x[6], x[7]);
        w1.x = pk2(x[8], x[9]); w1.y = pk2(x[10], x[11]); w1.z = pk2(x[12], x[13]); w1.w = pk2(x[14], x[15]);
        p[0] = w0; p[64] = w1;
    }
#endif
#if MFMA_GLA
    {
        const float* up = a.in[4] + (size_t)layer * 2 * 16 * 768; const float* gb = a.in[5] + layer * 2 * 768;
        const float* LR0 = (const float*)(a.ws + WS_LR); const float* LR1 = LR0 + (size_t)T * 32;
        float* Bc = (float*)(a.ws + WS_MG);
        LAS float* lrs = (LAS float*)(F.lds + RING_OFF);
        for (int rep8 = 0; rep8 < ((DUP_MASK & 8) ? (F.G > 100 ? 2 : 1) : 1); ++rep8)
        for (int chunk = blockIdx.x; chunk < 512; chunk += F.G) {
            __syncthreads();
            { const size_t o = (size_t)chunk * 2048 + tid * 4; const f32x4 x0 = *(const f32x4*)(LR0 + o), x1 = *(const f32x4*)(LR1 + o); *(LAS f32x4*)(lrs + tid * 4) = x0 + x1; }
            __syncthreads();
#pragma unroll 1
            for (int rr = 0; rr < 3; ++rr) { const int r = tid + 512 * rr, dir = r >= 768 ? 1 : 0, k = r - dir * 768;
                float upv[16];
#pragma unroll
                for (int j = 0; j < 16; ++j) upv[j] = up[(dir * 16 + j) * 768 + k];
                const float bias = gb[dir * 768 + k]; float b = 0.f;
#pragma unroll 4
                for (int i = 0; i < 64; ++i) { const int ri = dir == 0 ? i : 63 - i; const LAS f32x4* l4 = (const LAS f32x4*)(lrs + ri * 32 + dir * 16);
                    float z = bias;
#pragma unroll
                    for (int j = 0; j < 4; ++j) { const f32x4 x = l4[j]; z += x.x * upv[4 * j] + x.y * upv[4 * j + 1] + x.z * upv[4 * j + 2] + x.w * upv[4 * j + 3]; }
                    const float ls = fminf(z, 0.f) - __logf(1.0f + __expf(-fabsf(z)));
                    b += ls * (1.f / 16.f); Bc[((size_t)chunk * 64 + ri) * 1536 + r] = b; }
            }
        }
    }
#endif
#if !MFMA_GLA
    const float* up = a.in[4] + (size_t)layer * 2 * 16 * 768; const float* gb = a.in[5] + layer * 2 * 768;
    const float* LR0 = (const float*)(a.ws + WS_LR); const float* LR1 = LR0 + (size_t)T * 32;
    float* DEC = (float*)(a.ws + WS_MG);
    for (size_t e = (size_t)(F.vcu * NWAVES + wave) * 64 + lane; e < (size_t)T * 1536; e += (size_t)F.G * NWAVES * 64) {
        const int row = (int)(e / 1536), r = (int)(e - (size_t)row * 1536), dir = r / 768, k = r - dir * 768;
        float z = gb[dir * 768 + k];
#pragma unroll
        for (int j = 0; j < 16; ++j) z += (LR0[(size_t)row * 32 + dir * 16 + j] + LR1[(size_t)row * 32 + dir * 16 + j]) * up[(dir * 16 + j) * 768 + k];
        const float ls = fminf(z, 0.f) - log1pf(expf(-fabsf(z)));
        DEC[e] = expf(ls * (1.f / 16.f));
    }
#endif
}

__device__ __forceinline__ void phase_mix_naive(Frame& F, const Args& a, int layer) {
    PHASE_IDS();
    bf16* H = (bf16*)(a.ws + WS_H); bf16* O = (bf16*)(a.ws + WS_XN);
#if !MFMA_SGU
    {
        const float* W = a.in[9] + (size_t)layer * 8 * 128 * 128; const float* sb = a.in[10] + layer * 8 * 128;
        const int c = tid & 127, pq = tid >> 7;
        for (int it = blockIdx.x; it < 256 * 8; it += F.G) {
            const int chunk = it >> 3, g = it & 7; const size_t r0 = (size_t)chunk * 128;
            for (int pp = 0; pp < 32; ++pp) { const int p = pp * 4 + pq; const float* wr = W + ((size_t)g * 128 + p) * 128;
                float acc = 0.f;
                for (int q = 0; q < 128; ++q) acc += wr[q] * bf1(H[(r0 + q) * HP + C_BV + g * 128 + c]);
                const size_t row = r0 + p;
                const float u = bf1(H[row * HP + C_BU + g * 128 + c]), sg = bf1(H[row * HP + C_BG + g * 128 + c]);
                O[row * D + O_B + g * 128 + c] = (bf16)f2bf((acc + sb[g * 128 + p]) * u * sg); }
        }
    }
#endif
#if !MFMA_ATT
    {
        LAS float* wq = (LAS float*)(F.lds + RING_OFF + wave * 2048);
        LAS float* sc = wq + 128;
        const float* sink = a.in[13] + layer * 12;
        const int gw = F.vcu * NWAVES + wave, NGW = F.G * NWAVES;
        for (int it = gw; it < T * 12; it += NGW) {
            const int row = it / 12, hq = it - row * 12, kvh = hq / 3;
            const int s0 = row < TP ? (row & ~2047) : TP, L = row < TP ? 2048 : 16384, qpos = row - s0;
            { const unsigned w = *((const unsigned*)(H + (size_t)row * HP + C_CQ + hq * 128) + lane); wq[2 * lane] = bflo(w); wq[2 * lane + 1] = bfhi(w); }
            LDS_WAIT(); asm volatile("" ::: "memory");
            float mx = -INFINITY;
            for (int pass = 0; pass < 5; ++pass) { const int jj = pass * 64 + lane, kpos = qpos - 128 + jj; float s = -INFINITY;
                if (jj <= 256 && kpos >= 0 && kpos < L) { const v4u* kr = (const v4u*)(H + (size_t)(s0 + kpos) * HP + C_CK + kvh * 128); float d = 0.f;
#pragma unroll 4
                    for (int i = 0; i < 16; ++i) { const v4u w = kr[i]; const LAS float* q8 = wq + 8 * i;
                        d += q8[0] * bflo(w.x) + q8[1] * bfhi(w.x) + q8[2] * bflo(w.y) + q8[3] * bfhi(w.y) + q8[4] * bflo(w.z) + q8[5] * bfhi(w.z) + q8[6] * bflo(w.w) + q8[7] * bfhi(w.w); }
                    s = d; }
                sc[jj] = s; mx = fmaxf(mx, s); }
            const float sk = sink[hq];
            const float m = fmaxf(wave_max(mx), sk);
            LDS_WAIT(); asm volatile("" ::: "memory");
            float ps = 0.f;
            for (int pass = 0; pass < 5; ++pass) { const int jj = pass * 64 + lane; const float s = sc[jj]; const float p = (s == -INFINITY) ? 0.f : __expf(s - m); sc[jj] = p; ps += p; }
            const float denom = wave_sum(ps) + __expf(sk - m);
            LDS_WAIT(); asm volatile("" ::: "memory");
            float o0 = 0.f, o1 = 0.f;
            const int jlo = qpos >= 128 ? 0 : 128 - qpos, jhi = (qpos + 128 < L) ? 256 : (L - 1 - qpos + 128);
            for (int jj = jlo; jj <= jhi; ++jj) { const float p = sc[jj]; const unsigned w = *((const unsigned*)(H + (size_t)(s0 + qpos - 128 + jj) * HP + C_CV + kvh * 128) + lane);
                o0 += p * bflo(w); o1 += p * bfhi(w); }
            const float inv = 1.0f / denom;
            const unsigned gwd = *((const unsigned*)(H + (size_t)row * HP + C_CG + hq * 128) + lane);
            *((unsigned*)(O + (size_t)row * D + O_C + hq * 128) + lane) = pk2(o0 * inv * bflo(gwd), o1 * inv * bfhi(gwd));
            LDS_WAIT(); asm volatile("" ::: "memory");
        }
    }
#endif
    __syncthreads();
    if (blockIdx.x < 108) {
        const int b = blockIdx.x, seq = b / 12, hd = (b % 12) >> 1, dir = b & 1;
        const int s0 = seq < 8 ? seq * 2048 : TP, L = seq < 8 ? 2048 : 16384;
        LAS float* la = (LAS float*)(F.lds + RING_OFF + 32768); LAS float* lq = la + 128; LAS float* lk = lq + 128; LAS float* lo = lk + 128;
        const float* DEC = (const float*)(a.ws + WS_MG);
        float* OUT = (float*)(a.ws + WS_ST) + (size_t)dir * T * 1536;
        const int dv = tid & 255, half = tid >> 8;
        float S[64];
#pragma unroll
        for (int j = 0; j < 64; ++j) S[j] = 0.f;
        float na = 0.f, nq = 0.f, nk = 0.f, nv;
        { const size_t p = (size_t)(dir == 0 ? s0 : s0 + L - 1);
          if (tid < 128) { na = DEC[p * 1536 + dir * 768 + hd * 128 + tid]; nq = bf1(H[p * HP + C_AQ + hd * 128 + tid]) * 0.08838834764831845f; nk = bf1(H[p * HP + C_AK + hd * 128 + tid]); }
          nv = bf1(H[p * HP + C_AV + hd * 256 + dv]); }
        for (int t = 0; t < L; ++t) {
            const size_t p = (size_t)(dir == 0 ? s0 + t : s0 + L - 1 - t);
            if (tid < 128) { la[tid] = na; lq[tid] = nq; lk[tid] = nk; }
            const float v = nv;
            __syncthreads();
            if (t + 1 < L) { const size_t pn = (size_t)(dir == 0 ? p + 1 : p - 1);
                if (tid < 128) { na = DEC[pn * 1536 + dir * 768 + hd * 128 + tid]; nq = bf1(H[pn * HP + C_AQ + hd * 128 + tid]) * 0.08838834764831845f; nk = bf1(H[pn * HP + C_AK + hd * 128 + tid]); }
                nv = bf1(H[pn * HP + C_AV + hd * 256 + dv]); }
            float acc = 0.f;
#pragma unroll
            for (int j = 0; j < 64; ++j) { const int dk = half * 64 + j; S[j] = la[dk] * S[j] + lk[dk] * v; acc += lq[dk] * S[j]; }
            if (half == 1) lo[dv] = acc;
            __syncthreads();
            if (half == 0) OUT[p * 1536 + hd * 256 + dv] = acc + lo[dv];
        }
    }
}

__device__ __forceinline__ void phase_gla_fin(Frame& F, const Args& a, int layer) {
    PHASE_IDS();
    const int gw = F.vcu * NWAVES + wave, NGW = F.G * NWAVES;
    const bf16* H = (const bf16*)(a.ws + WS_H); bf16* O = (bf16*)(a.ws + WS_XN);
    const float* OF = (const float*)(a.ws + WS_ST); const float* OB = OF + (size_t)T * 1536;
    const float* gn = a.in[6] + layer * 256;
    for (int it = gw; it < T * 6; it += NGW) {
        const int row = it / 6, hd = it - row * 6;
        const f32x4 f = *((const f32x4*)(OF + (size_t)row * 1536 + hd * 256) + lane), b = *((const f32x4*)(OB + (size_t)row * 1536 + hd * 256) + lane);
        const f32x4 s = f + b;
        const float rstd = 1.0f / sqrtf(wave_sum((s.x * s.x + s.y * s.y) + (s.z * s.z + s.w * s.w)) * (1.f / 256.f) + 1e-6f);
        const f32x4 g = *((const f32x4*)gn + lane);
        const v2u gt = *((const v2u*)(H + (size_t)row * HP + C_AG + hd * 256) + lane);
        v2u w; w.x = pk2(s.x * rstd * g.x * bflo(gt.x), s.y * rstd * g.y * bfhi(gt.x)); w.y = pk2(s.z * rstd * g.z * bflo(gt.y), s.w * rstd * g.w * bfhi(gt.y));
        *((v2u*)(O + (size_t)row * D + O_A + hd * 256) + lane) = w;
    }
}


typedef short bf16x8 __attribute__((ext_vector_type(8)));
#define MFMA16(a_, b_, c_) __builtin_amdgcn_mfma_f32_16x16x32_bf16(a_, b_, c_, 0, 0, 0)
__device__ __forceinline__ bf16x8 ldsfrag(const LAS unsigned char* base, int pitch, int row0, int k0, int fr, int fq) {
    return *(const LAS bf16x8*)(base + (row0 + fr) * pitch + (k0 + 8 * fq) * 2);
}

__device__ __forceinline__ void phase_sgu(Frame& F, const Args& a, int layer) {
    PHASE_IDS();
    const int fr = lane & 15, fq = lane >> 4;
    constexpr int PIT = 272;
    LAS unsigned char* VT = F.lds + RING_OFF;
    LAS unsigned char* WA = VT + 128 * PIT;
    LAS float* STt = (LAS float*)(WA + 128 * PIT);
    const bf16* H = (const bf16*)(a.ws + WS_H); bf16* O = (bf16*)(a.ws + WS_XN);
    const float* lg = a.in[7] + layer * 1024; const float* lb = a.in[8] + layer * 1024;
    const float* W = a.in[9] + (size_t)layer * 8 * 128 * 128; const float* sb = a.in[10] + layer * 8 * 128;
    for (int chunk = blockIdx.x; chunk < 256; chunk += F.G) {
        const size_t r0 = (size_t)chunk * 128;
        __syncthreads();
#pragma unroll 1
        for (int ib = 0; ib < 2; ++ib) {
            v4u ra[8], rb[8];
#pragma unroll
            for (int i = 0; i < 8; ++i) { const v4u* p = (const v4u*)(H + (r0 + 16 * wave + 8 * ib + i) * HP + C_BV) + lane; ra[i] = p[0]; rb[i] = p[64]; }
            float s[8], q[8];
#pragma unroll
            for (int i = 0; i < 8; ++i) { float x[16]; unpack8(ra[i], x); unpack8(rb[i], x + 8); s[i] = 0.f;
#pragma unroll
                for (int j = 0; j < 16; ++j) s[i] += x[j]; }
#pragma unroll
            for (int i = 0; i < 8; ++i) s[i] = wave_sum(s[i]) * (1.f / 1024.f);
#pragma unroll
            for (int i = 0; i < 8; ++i) { float x[16]; unpack8(ra[i], x); unpack8(rb[i], x + 8); q[i] = 0.f;
#pragma unroll
                for (int j = 0; j < 16; ++j) { const float d = x[j] - s[i]; q[i] += d * d; } }
#pragma unroll
            for (int i = 0; i < 8; ++i) q[i] = wave_sum(q[i]);
#pragma unroll
            for (int i = 0; i < 8; ++i) { const float rstd = 1.0f / sqrtf(q[i] * (1.f / 1024.f) + 1e-5f);
                if (lane == 0) { STt[2 * (16 * wave + 8 * ib + i)] = s[i]; STt[2 * (16 * wave + 8 * ib + i) + 1] = rstd; } }
        }
        __syncthreads();
        v4u vraw[4]; f32x4 wraw[8];
#define SGU_LOAD(g_) do { const v4u* vs_ = (const v4u*)(H + (r0 + (tid & 127)) * HP + C_BV + (g_) * 128 + (tid >> 7) * 32); _Pragma("unroll") for (int i_ = 0; i_ < 4; ++i_) vraw[i_] = vs_[i_]; \
        const f32x4* ws_ = (const f32x4*)(W + ((size_t)(g_) * 128 + (tid >> 2)) * 128 + (tid & 3) * 32); _Pragma("unroll") for (int i_ = 0; i_ < 8; ++i_) wraw[i_] = ws_[i_]; } while (0)
        SGU_LOAD(0);
        for (int g = 0; g < 8; ++g) {
            { const int q = tid & 127, cb = (tid >> 7) * 32; const float st_x = STt[2 * q], st_y = STt[2 * q + 1];
#pragma unroll
              for (int i = 0; i < 4; ++i) { float x[8]; unpack8(vraw[i], x);
#pragma unroll
                  for (int j = 0; j < 8; ++j) { const int c = cb + 8 * i + j; const float y = (x[j] - st_x) * st_y * lg[g * 128 + c] + lb[g * 128 + c];
                      *(LAS bf16*)(VT + c * PIT + q * 2) = (bf16)f2bf(y); } } }
            { const int p = tid >> 2, qb = (tid & 3) * 32;
#pragma unroll
              for (int i = 0; i < 4; ++i) { const f32x4 u0 = wraw[2 * i], u1 = wraw[2 * i + 1]; v4u w; w.x = pk2(u0.x, u0.y); w.y = pk2(u0.z, u0.w); w.z = pk2(u1.x, u1.y); w.w = pk2(u1.z, u1.w);
                  *(LAS v4u*)(WA + p * PIT + (qb + 8 * i) * 2) = w; } }
            if (g < 7) SGU_LOAD(g + 1);
            const int p = 16 * wave + fr; const size_t row = r0 + p; const float sbv = sb[g * 128 + p];
            v2u gu[8], sg[8];
#pragma unroll
            for (int n = 0; n < 8; ++n) { const int c = g * 128 + 16 * n + 4 * fq; gu[n] = *(const v2u*)(H + row * HP + C_BU + c); sg[n] = *(const v2u*)(H + row * HP + C_BG + c); }
            __syncthreads();
            f32x4 acc[8];
#pragma unroll
            for (int n = 0; n < 8; ++n) acc[n] = (f32x4){0.f, 0.f, 0.f, 0.f};
#pragma unroll
            for (int ks = 0; ks < 4; ++ks) { const bf16x8 af = ldsfrag(WA, PIT, 16 * wave, 32 * ks, fr, fq);
#pragma unroll
                for (int n = 0; n < 8; ++n) acc[n] = MFMA16(ldsfrag(VT, PIT, 16 * n, 32 * ks, fr, fq), af, acc[n]); }
#pragma unroll
            for (int n = 0; n < 8; ++n) { const int c = g * 128 + 16 * n + 4 * fq;
                v2u w; w.x = pk2((acc[n][0] + sbv) * bflo(gu[n].x) * bflo(sg[n].x), (acc[n][1] + sbv) * bfhi(gu[n].x) * bfhi(sg[n].x));
                w.y = pk2((acc[n][2] + sbv) * bflo(gu[n].y) * bflo(sg[n].y), (acc[n][3] + sbv) * bfhi(gu[n].y) * bfhi(sg[n].y));
                *(v2u*)(O + row * D + O_B + c) = w; }
            __syncthreads();
        }
#undef SGU_LOAD
    }
}

__device__ __forceinline__ void phase_attn(Frame& F, const Args& a, int layer) {
    PHASE_IDS();
    const int fr = lane & 15, fq = lane >> 4;
    constexpr int PIT = 272;
    LAS unsigned char* Kt = F.lds + RING_OFF;
    LAS unsigned char* Vt = Kt + 128 * PIT;
    LAS unsigned char* Pm = Vt + 128 * PIT;
    const bf16* H = (const bf16*)(a.ws + WS_H); bf16* O = (bf16*)(a.ws + WS_XN);
    const float* sink = a.in[13] + layer * 12;
    const float* qg = a.in[11] + layer * 128; const float* kg = a.in[12] + layer * 128;
    const float* rt = (const float*)(a.ws + WS_ROPE);
    constexpr int NU = 256 * 12;
    int u = F.vcu; if (u >= NU) return;
#define ATT_DECODE(u_, qb_, hq_, r0_, s0_, nblk_, qi_) const int qb_ = (u_) / 12, hq_ = (u_) - qb_ * 12, r0_ = qb_ * 128, s0_ = r0_ < TP ? (r0_ & ~2047) : TP, nblk_ = r0_ < TP ? 16 : 128, qi_ = (r0_ - s0_) >> 7
#define ATT_LOAD_KV(s0_, kbi_, kvh_) do { const size_t kr0_ = (size_t)((s0_) + (kbi_) * 128); \
        const v4u* ks_ = (const v4u*)(H + (kr0_ + (tid >> 2)) * HP + C_CK + (kvh_) * 128 + (tid & 3) * 32); const v4u* vs_ = (const v4u*)(H + (kr0_ + (tid & 127)) * HP + C_CV + (kvh_) * 128 + (tid >> 7) * 32); \
        _Pragma("unroll") for (int i_ = 0; i_ < 4; ++i_) { kraw[i_] = ks_[i_]; vraw[i_] = vs_[i_]; } } while (0)
#define ATT_LOAD_Q(r0_, hq_) do { const bf16* qp_ = H + (size_t)((r0_) + 16 * wave + fr) * HP + C_CQ + (hq_) * 128 + 8 * fq; \
        _Pragma("unroll") for (int i_ = 0; i_ < 4; ++i_) qraw[i_] = *(const v4u*)(qp_ + 32 * i_); } while (0)
    v4u kraw[4], vraw[4], qraw[4];
    int t;
    { ATT_DECODE(u, qb, hq, r0, s0, nblk, qi); (void)nblk; t = qi == 0 ? 0 : -1; ATT_LOAD_KV(s0, qi + t, hq / 3); ATT_LOAD_Q(r0, hq); }
    for (;;) {
        ATT_DECODE(u, qb, hq, r0, s0, nblk, qi); const int kvh = hq / 3;
        const size_t qrow = (size_t)(r0 + 16 * wave + fr);
        bf16x8 qf[4];
#if ATT_FUSED_NORM
        { float x[4][8]; float ss = 0.f;
#pragma unroll
          for (int ks = 0; ks < 4; ++ks) { unpack8(qraw[ks], x[ks]);
#pragma unroll
              for (int j = 0; j < 8; ++j) ss += x[ks][j] * x[ks][j]; }
          ss += shx<16>(ss); ss = sum32(ss);
          const float rstd = 1.0f / sqrtf(ss * (1.f / 128.f) + 1e-6f);
#pragma unroll
          for (int ks = 0; ks < 4; ++ks) { const f32x4 g0 = *(const f32x4*)(qg + 32 * ks + 8 * fq), g1 = *(const f32x4*)(qg + 32 * ks + 8 * fq + 4);
              x[ks][0] *= rstd * g0.x; x[ks][1] *= rstd * g0.y; x[ks][2] *= rstd * g0.z; x[ks][3] *= rstd * g0.w; x[ks][4] *= rstd * g1.x; x[ks][5] *= rstd * g1.y; x[ks][6] *= rstd * g1.z; x[ks][7] *= rstd * g1.w; }
          { const int pos = (int)qrow - s0; const f32x4* c4 = (const f32x4*)(rt + (pos * 16 + 8 * (fq & 1)) * 2);
#pragma unroll
            for (int j2 = 0; j2 < 4; ++j2) { const f32x4 cs = c4[j2]; const float pa = xch32(x[0][2 * j2], fq >= 2), pb = xch32(x[0][2 * j2 + 1], fq >= 2);
                x[0][2 * j2] = fq < 2 ? x[0][2 * j2] * cs.x - pa * cs.y : x[0][2 * j2] * cs.x + pa * cs.y;
                x[0][2 * j2 + 1] = fq < 2 ? x[0][2 * j2 + 1] * cs.z - pb * cs.w : x[0][2 * j2 + 1] * cs.z + pb * cs.w; } }
#pragma unroll
          for (int ks = 0; ks < 4; ++ks) { v4u w; const float sc = 0.12751743082459868f;
              w.x = pk2(x[ks][0] * sc, x[ks][1] * sc); w.y = pk2(x[ks][2] * sc, x[ks][3] * sc); w.z = pk2(x[ks][4] * sc, x[ks][5] * sc); w.w = pk2(x[ks][6] * sc, x[ks][7] * sc);
              qf[ks] = __builtin_bit_cast(bf16x8, w); } }
#else
#pragma unroll
        for (int ks = 0; ks < 4; ++ks) qf[ks] = __builtin_bit_cast(bf16x8, qraw[ks]);
#endif
        v2u gtr[8];
#pragma unroll
        for (int n = 0; n < 8; ++n) gtr[n] = *(const v2u*)(H + qrow * HP + C_CG + hq * 128 + 16 * n + 4 * fq);
        float m = sink[hq] * 1.44269504089f, l = fq == 0 ? 1.f : 0.f;
        f32x4 Oa[8];
#pragma unroll
        for (int n = 0; n < 8; ++n) Oa[n] = (f32x4){0.f, 0.f, 0.f, 0.f};
        int un = u, tn = t; bool more = true;
        for (;;) {
            const size_t kr0 = (size_t)(s0 + (qi + t) * 128);
            __syncthreads();
#if ATT_FUSED_NORM
            { const int key = tid >> 2, dq = tid & 3, db = dq * 32; float ss = 0.f;
#pragma unroll
              for (int i = 0; i < 4; ++i) { float x[8]; unpack8(kraw[i], x);
#pragma unroll
                  for (int j = 0; j < 8; ++j) ss += x[j] * x[j]; }
              ss += shx<1>(ss); ss += shx<2>(ss);
              const float rstd = 1.0f / sqrtf(ss * (1.f / 128.f) + 1e-6f);
              if (dq == 0) {
                  const int pos = (int)(kr0 - s0) + key; const f32x4* c4 = (const f32x4*)(rt + pos * 32);
#pragma unroll
                  for (int h = 0; h < 2; ++h) { float xa[8], xb[8]; unpack8(kraw[h], xa); unpack8(kraw[h + 2], xb);
#pragma unroll
                      for (int j = 0; j < 8; ++j) { xa[j] *= rstd * kg[8 * h + j]; xb[j] *= rstd * kg[16 + 8 * h + j]; }
#pragma unroll
                      for (int j2 = 0; j2 < 4; ++j2) { const f32x4 cs = c4[4 * h + j2];
                          const float a0 = xa[2 * j2], b0 = xb[2 * j2], a1 = xa[2 * j2 + 1], b1 = xb[2 * j2 + 1];
                          xa[2 * j2] = a0 * cs.x - b0 * cs.y; xb[2 * j2] = b0 * cs.x + a0 * cs.y; xa[2 * j2 + 1] = a1 * cs.z - b1 * cs.w; xb[2 * j2 + 1] = b1 * cs.z + a1 * cs.w; }
                      v4u w; w.x = pk2(xa[0], xa[1]); w.y = pk2(xa[2], xa[3]); w.z = pk2(xa[4], xa[5]); w.w = pk2(xa[6], xa[7]); *(LAS v4u*)(Kt + key * PIT + (8 * h) * 2) = w;
                      w.x = pk2(xb[0], xb[1]); w.y = pk2(xb[2], xb[3]); w.z = pk2(xb[4], xb[5]); w.w = pk2(xb[6], xb[7]); *(LAS v4u*)(Kt + key * PIT + (16 + 8 * h) * 2) = w; }
              } else {
#pragma unroll
                  for (int i = 0; i < 4; ++i) { float x[8]; unpack8(kraw[i], x);
#pragma unroll
                      for (int j = 0; j < 8; ++j) x[j] *= rstd * kg[db + 8 * i + j];
                      v4u w; w.x = pk2(x[0], x[1]); w.y = pk2(x[2], x[3]); w.z = pk2(x[4], x[5]); w.w = pk2(x[6], x[7]); *(LAS v4u*)(Kt + key * PIT + (db + 8 * i) * 2) = w; } } }
#else
            { const int key = tid >> 2, db = (tid & 3) * 32;
#pragma unroll
              for (int i = 0; i < 4; ++i) *(LAS v4u*)(Kt + key * PIT + (db + 8 * i) * 2) = kraw[i]; }
#endif
            { const int key = tid & 127, db = (tid >> 7) * 32;
#pragma unroll
              for (int i = 0; i < 4; ++i) { const v4u w = vraw[i]; const unsigned ww[4] = {w.x, w.y, w.z, w.w};
#pragma unroll
                  for (int j = 0; j < 4; ++j) { *(LAS bf16*)(Vt + (db + 8 * i + 2 * j) * PIT + key * 2) = (bf16)(ww[j] & 0xffffu); *(LAS bf16*)(Vt + (db + 8 * i + 2 * j + 1) * PIT + key * 2) = (bf16)(ww[j] >> 16); } } }
            if (t + 1 <= 1 && qi + t + 1 < nblk) { tn = t + 1; ATT_LOAD_KV(s0, qi + tn, kvh); }
            else { un = u + F.G; if (un < NU) { ATT_DECODE(un, qb2, hq2, r02, s02, nblk2, qi2); (void)nblk2; tn = qi2 == 0 ? 0 : -1; ATT_LOAD_KV(s02, qi2 + tn, hq2 / 3); ATT_LOAD_Q(r02, hq2); } else more = false; }
            __syncthreads();
            f32x4 S[8];
#pragma unroll
            for (int n = 0; n < 8; ++n) S[n] = (f32x4){0.f, 0.f, 0.f, 0.f};
#pragma unroll
            for (int ks = 0; ks < 4; ++ks)
#pragma unroll
                for (int n = 0; n < 8; ++n) S[n] = MFMA16(ldsfrag(Kt, PIT, 16 * n, 32 * ks, fr, fq), qf[ks], S[n]);
            const int qi_ = 16 * wave + fr; float mx = -INFINITY;
            if (t != 0) {
#pragma unroll
                for (int n = 0; n < 8; ++n)
#pragma unroll
                    for (int j = 0; j < 4; ++j) { const int kj = 16 * n + 4 * fq + j; const bool ok = t < 0 ? kj >= qi_ : kj <= qi_; S[n][j] = ok ? S[n][j] : -INFINITY; } }
#pragma unroll
            for (int n = 0; n < 8; ++n) mx = fmaxf(mx, fmaxf(fmaxf(S[n][0], S[n][1]), fmaxf(S[n][2], S[n][3])));
            mx = fmaxf(mx, shx<16>(mx)); mx = max32(mx);
            const float mn = fmaxf(m, mx), alpha = __builtin_amdgcn_exp2f(m - mn); m = mn;
            float ps = 0.f;
#pragma unroll
            for (int n = 0; n < 8; ++n) { float p0 = __builtin_amdgcn_exp2f(S[n][0] - mn), p1 = __builtin_amdgcn_exp2f(S[n][1] - mn), p2 = __builtin_amdgcn_exp2f(S[n][2] - mn), p3 = __builtin_amdgcn_exp2f(S[n][3] - mn);
                ps += (p0 + p1) + (p2 + p3); v2u w; w.x = pk2(p0, p1); w.y = pk2(p2, p3);
                *(LAS v2u*)(Pm + (16 * wave + fr) * PIT + (16 * n + 4 * fq) * 2) = w; Oa[n] = Oa[n] * alpha; }
            l = l * alpha + ps;
            LDS_WAIT(); asm volatile("" ::: "memory");
#pragma unroll
            for (int ks = 0; ks < 4; ++ks) { const bf16x8 pf = ldsfrag(Pm, PIT, 16 * wave, 32 * ks, fr, fq);
#pragma unroll
                for (int n = 0; n < 8; ++n) Oa[n] = MFMA16(ldsfrag(Vt, PIT, 16 * n, 32 * ks, fr, fq), pf, Oa[n]); }
            if (un != u || !more) break;
            t = tn;
        }
        l += shx<16>(l); l = sum32(l);
        const float inv = 1.0f / l;
#pragma unroll
        for (int n = 0; n < 8; ++n) { const int d = hq * 128 + 16 * n + 4 * fq; const v2u gt = gtr[n];
            v2u w; w.x = pk2(Oa[n][0] * inv * bflo(gt.x), Oa[n][1] * inv * bfhi(gt.x)); w.y = pk2(Oa[n][2] * inv * bflo(gt.y), Oa[n][3] * inv * bfhi(gt.y));
#if F8_OC
#define F8C(x) __builtin_amdgcn_fmed3f(8.f * (x), -448.f, 448.f)
            int w8 = 0; w8 = __builtin_amdgcn_cvt_pk_fp8_f32(F8C(Oa[n][0] * inv * bflo(gt.x)), F8C(Oa[n][1] * inv * bfhi(gt.x)), w8, false); w8 = __builtin_amdgcn_cvt_pk_fp8_f32(F8C(Oa[n][2] * inv * bflo(gt.y)), F8C(Oa[n][3] * inv * bfhi(gt.y)), w8, true);
#undef F8C
            *(unsigned*)((unsigned char*)O + qrow * 8192 + 5120 + d) = (unsigned)w8; (void)w; }
#else
            *(v2u*)(O + qrow * D + O_C + d) = w; }
#endif
        if (!more) break;
        u = un; t = tn;
    }
#undef ATT_DECODE
#undef ATT_LOAD_KV
#undef ATT_LOAD_Q
}

__device__ __forceinline__ void phase_gla_c1(Frame& F, const Args& a, int layer) {
    PHASE_IDS();
    const int fr = lane & 15, fq = lane >> 4;
    constexpr int PV = 144;
    LAS unsigned char* VT = F.lds + RING_OFF;
    LAS unsigned char* K1T = VT + 256 * PV;
    const bf16* H = (const bf16*)(a.ws + WS_H); const float* Bc = (const float*)(a.ws + WS_MG);
    bf16* STb = (bf16*)(a.ws + WS_ST); float* DECC = (float*)(a.ws + WS_DECC);
    v4u vraw[4], kraw[2]; f32x4 braw[2][4];
#define C1_LOAD(u_) do { const int c_ = (u_) / 6, hd_ = (u_) - c_ * 6; const size_t r0_ = (size_t)c_ * 64; const int s_ = tid & 63; \
        const v4u* vs_ = (const v4u*)(H + (r0_ + s_) * HP + C_AV + hd_ * 256 + (tid >> 6) * 32); _Pragma("unroll") for (int i_ = 0; i_ < 4; ++i_) vraw[i_] = vs_[i_]; \
        const v4u* ks_ = (const v4u*)(H + (r0_ + s_) * HP + C_AK + hd_ * 128 + (tid >> 6) * 16); kraw[0] = ks_[0]; kraw[1] = ks_[1]; \
        _Pragma("unroll") for (int d_ = 0; d_ < 2; ++d_) { const f32x4* bs_ = (const f32x4*)(Bc + (r0_ + s_) * 1536 + d_ * 768 + hd_ * 128 + (tid >> 6) * 16); _Pragma("unroll") for (int i_ = 0; i_ < 4; ++i_) braw[d_][i_] = bs_[i_]; } } while (0)
    if (F.vcu < 512 * 6) C1_LOAD(F.vcu);
    for (int u = F.vcu; u < 512 * 6; u += F.G) {
        const int c = u / 6, hd = u - c * 6; const size_t r0 = (size_t)c * 64;
        __syncthreads();
        { const int s = tid & 63, dvb = (tid >> 6) * 32;
#pragma unroll
          for (int i = 0; i < 4; ++i) { const v4u w = vraw[i]; const unsigned ww[4] = {w.x, w.y, w.z, w.w};
#pragma unroll
              for (int j = 0; j < 4; ++j) { *(LAS bf16*)(VT + (dvb + 8 * i + 2 * j) * PV + s * 2) = (bf16)(ww[j] & 0xffffu); *(LAS bf16*)(VT + (dvb + 8 * i + 2 * j + 1) * PV + s * 2) = (bf16)(ww[j] >> 16); } } }
        { const int s = tid & 63, dkb = (tid >> 6) * 16; float kx[16]; unpack8(kraw[0], kx); unpack8(kraw[1], kx + 8);
#pragma unroll
          for (int dir = 0; dir < 2; ++dir)
#pragma unroll
            for (int i = 0; i < 4; ++i) { const f32x4 bb = braw[dir][i];
#pragma unroll
                for (int j = 0; j < 4; ++j) *(LAS bf16*)(K1T + (dir * 128 + dkb + 4 * i + j) * PV + s * 2) = (bf16)f2bf(kx[4 * i + j] * __expf(-bb[j])); } }
        if (u + F.G < 512 * 6) C1_LOAD(u + F.G);
        __syncthreads();
#pragma unroll
        for (int dir = 0; dir < 2; ++dir) {
            f32x4 acc[2][8];
#pragma unroll
            for (int m = 0; m < 2; ++m)
#pragma unroll
                for (int n = 0; n < 8; ++n) acc[m][n] = (f32x4){0.f, 0.f, 0.f, 0.f};
#pragma unroll
            for (int ks = 0; ks < 2; ++ks) { const bf16x8 a0 = ldsfrag(VT, PV, 32 * wave, 32 * ks, fr, fq), a1 = ldsfrag(VT, PV, 32 * wave + 16, 32 * ks, fr, fq);
#pragma unroll
                for (int n = 0; n < 8; ++n) { const bf16x8 bfr = ldsfrag(K1T + dir * 128 * PV, PV, 16 * n, 32 * ks, fr, fq); acc[0][n] = MFMA16(bfr, a0, acc[0][n]); acc[1][n] = MFMA16(bfr, a1, acc[1][n]); } }
            const size_t lastrow = r0 + (dir == 0 ? 63 : 0); const int slot = (c * 6 + hd) * 2 + dir; bf16* dst = STb + (size_t)slot * 32768;
#pragma unroll
            for (int n = 0; n < 8; ++n) { const int dk = 16 * n + 4 * fq; const f32x4 bl = *(const f32x4*)(Bc + lastrow * 1536 + dir * 768 + hd * 128 + dk);
                const float e0 = __expf(bl.x), e1 = __expf(bl.y), e2 = __expf(bl.z), e3 = __expf(bl.w);
#pragma unroll
                for (int m = 0; m < 2; ++m) { const int dv = 32 * wave + 16 * m + fr; v2u w; w.x = pk2(acc[m][n][0] * e0, acc[m][n][1] * e1); w.y = pk2(acc[m][n][2] * e2, acc[m][n][3] * e3);
                    *(v2u*)(dst + dv * 128 + dk) = w; } }
            if (tid < 128) DECC[slot * 128 + tid] = __expf(Bc[lastrow * 1536 + dir * 768 + hd * 128 + tid]);
        }
    }
#undef C1_LOAD
}
__device__ __forceinline__ void gla_scan_item(int it, bf16* STb, const float* DECC, int lane) {
    int seq, hdir, slab;
    if (it < 768) { seq = 8; hdir = it >> 6; slab = it & 63; } else { const int j = it - 768; const int sh = j >> 6; seq = sh / 12; hdir = sh - seq * 12; slab = j & 63; }
    const int c0 = seq < 8 ? seq * 32 : 256, nc = seq < 8 ? 32 : 256, hd = hdir >> 1, dir = hdir & 1;
    const int e0 = slab * 512 + lane * 8, dk0 = e0 & 127;
    float S[8];
#pragma unroll
    for (int j = 0; j < 8; ++j) S[j] = 0.f;
    v4u kvn[8];
#pragma unroll
    for (int i = 0; i < 8; ++i) { const int c = dir == 0 ? c0 + i : c0 + nc - 1 - i; kvn[i] = *(const v4u*)(STb + (size_t)((c * 6 + hd) * 2 + dir) * 32768 + e0); }
    for (int st = 0; st < nc; st += 8) {
        v4u kv[8]; f32x4 d0[8], d1[8];
#pragma unroll
        for (int i = 0; i < 8; ++i) { const int c = dir == 0 ? c0 + st + i : c0 + nc - 1 - (st + i); const int slot = (c * 6 + hd) * 2 + dir;
            kv[i] = kvn[i]; d0[i] = *(const f32x4*)(DECC + slot * 128 + dk0); d1[i] = *(const f32x4*)(DECC + slot * 128 + dk0 + 4); }
        if (st + 8 < nc) {
#pragma unroll
            for (int i = 0; i < 8; ++i) { const int c = dir == 0 ? c0 + st + 8 + i : c0 + nc - 1 - (st + 8 + i); kvn[i] = *(const v4u*)(STb + (size_t)((c * 6 + hd) * 2 + dir) * 32768 + e0); } }
#pragma unroll
        for (int i = 0; i < 8; ++i) { const int c = dir == 0 ? c0 + st + i : c0 + nc - 1 - (st + i); const int slot = (c * 6 + hd) * 2 + dir;
            v4u w; w.x = pk2(S[0], S[1]); w.y = pk2(S[2], S[3]); w.z = pk2(S[4], S[5]); w.w = pk2(S[6], S[7]);
            *(v4u*)(STb + (size_t)slot * 32768 + e0) = w;
            float x[8]; unpack8(kv[i], x);
            S[0] = d0[i].x * S[0] + x[0]; S[1] = d0[i].y * S[1] + x[1]; S[2] = d0[i].z * S[2] + x[2]; S[3] = d0[i].w * S[3] + x[3];
            S[4] = d1[i].x * S[4] + x[4]; S[5] = d1[i].y * S[5] + x[5]; S[6] = d1[i].z * S[6] + x[6]; S[7] = d1[i].w * S[7] + x[7]; }
    }
}
__device__ __forceinline__ void phase_gla_scan(Frame& F, const Args& a) {
    PHASE_IDS();
    bf16* STb = (bf16*)(a.ws + WS_ST); const float* DECC = (const float*)(a.ws + WS_DECC);
    const int gw = F.vcu * NWAVES + wave, NGW = F.G * NWAVES;
    if (F.G == 256) {
        const int cu = blockIdx.x;
        if (wave < 3) gla_scan_item(cu * 3 + wave, STb, DECC, lane);
        else for (int it = 768 + cu * 5 + (wave - 3); it < 768 + 6144; it += 1280) gla_scan_item(it, STb, DECC, lane);
    }
    else for (int it = gw; it < 768 + 6144; it += NGW) gla_scan_item(it, STb, DECC, lane);
}
__device__ __forceinline__ void phase_gla_c3(Frame& F, const Args& a, int layer) {
    PHASE_IDS();
    const int fr = lane & 15, fq = lane >> 4;
    constexpr int PQ = 272, PV = 144;
    LAS unsigned char* Q1 = F.lds + RING_OFF;
    LAS unsigned char* K1 = Q1 + 2 * 64 * PQ;
    LAS unsigned char* VT = K1 + 2 * 64 * PQ;
    LAS unsigned char* Pm = VT + 256 * PV;
    LAS float* red = (LAS float*)(Pm + 2 * 64 * PV);
    const bf16* H = (const bf16*)(a.ws + WS_H); const float* Bc = (const float*)(a.ws + WS_MG);
    const bf16* STb = (const bf16*)(a.ws + WS_ST); bf16* O = (bf16*)(a.ws + WS_XN);
    const float* gn = a.in[6] + layer * 256;
    v4u qraw[2], kraw[2], vraw[4]; f32x4 braw[2][4];
#define C3_LOAD(u_) do { const int c_ = (u_) / 6, hd_ = (u_) - c_ * 6; const size_t r0_ = (size_t)c_ * 64; const int s_ = tid >> 3, dkb_ = (tid & 7) * 16; \
        const v4u* qs_ = (const v4u*)(H + (r0_ + s_) * HP + C_AQ + hd_ * 128 + dkb_); const v4u* ks_ = (const v4u*)(H + (r0_ + s_) * HP + C_AK + hd_ * 128 + dkb_); \
        qraw[0] = qs_[0]; qraw[1] = qs_[1]; kraw[0] = ks_[0]; kraw[1] = ks_[1]; \
        _Pragma("unroll") for (int d_ = 0; d_ < 2; ++d_) { const f32x4* bs_ = (const f32x4*)(Bc + (r0_ + s_) * 1536 + d_ * 768 + hd_ * 128 + dkb_); _Pragma("unroll") for (int i_ = 0; i_ < 4; ++i_) braw[d_][i_] = bs_[i_]; } \
        const v4u* vs_ = (const v4u*)(H + (r0_ + (tid & 63)) * HP + C_AV + hd_ * 256 + (tid >> 6) * 32); _Pragma("unroll") for (int i_ = 0; i_ < 4; ++i_) vraw[i_] = vs_[i_]; } while (0)
    if (F.vcu < 512 * 6) C3_LOAD(F.vcu);
    for (int u = F.vcu; u < 512 * 6; u += F.G) {
        const int c = u / 6, hd = u - c * 6; const size_t r0 = (size_t)c * 64;
        bf16x8 sfr[2][4][2];
#pragma unroll
        for (int dir = 0; dir < 2; ++dir) { const bf16* Sg = STb + (size_t)((c * 6 + hd) * 2 + dir) * 32768;
#pragma unroll
            for (int ks = 0; ks < 4; ++ks)
#pragma unroll
                for (int n = 0; n < 2; ++n) sfr[dir][ks][n] = *(const bf16x8*)(Sg + (32 * wave + 16 * n + fr) * 128 + 32 * ks + 8 * fq); }
        __syncthreads();
        { const int s = tid >> 3, dkb = (tid & 7) * 16; float q0[16], k0[16]; unpack8(qraw[0], q0); unpack8(qraw[1], q0 + 8); unpack8(kraw[0], k0); unpack8(kraw[1], k0 + 8);
#pragma unroll
          for (int dir = 0; dir < 2; ++dir) { float qx[16], kx[16];
#pragma unroll
            for (int i = 0; i < 4; ++i) { const f32x4 bb = braw[dir][i];
#pragma unroll
                for (int j = 0; j < 4; ++j) { const float e = __expf(bb[j]); qx[4 * i + j] = q0[4 * i + j] * e * 0.08838834764831845f; kx[4 * i + j] = k0[4 * i + j] * __builtin_amdgcn_rcpf(e); } }
            v4u w;
            w.x = pk2(qx[0], qx[1]); w.y = pk2(qx[2], qx[3]); w.z = pk2(qx[4], qx[5]); w.w = pk2(qx[6], qx[7]); *(LAS v4u*)(Q1 + (dir * 64 + s) * PQ + dkb * 2) = w;
            w.x = pk2(qx[8], qx[9]); w.y = pk2(qx[10], qx[11]); w.z = pk2(qx[12], qx[13]); w.w = pk2(qx[14], qx[15]); *(LAS v4u*)(Q1 + (dir * 64 + s) * PQ + dkb * 2 + 16) = w;
            w.x = pk2(kx[0], kx[1]); w.y = pk2(kx[2], kx[3]); w.z = pk2(kx[4], kx[5]); w.w = pk2(kx[6], kx[7]); *(LAS v4u*)(K1 + (dir * 64 + s) * PQ + dkb * 2) = w;
            w.x = pk2(kx[8], kx[9]); w.y = pk2(kx[10], kx[11]); w.z = pk2(kx[12], kx[13]); w.w = pk2(kx[14], kx[15]); *(LAS v4u*)(K1 + (dir * 64 + s) * PQ + dkb * 2 + 16) = w; } }
        { const int s = tid & 63, dvb = (tid >> 6) * 32;
#pragma unroll
          for (int i = 0; i < 4; ++i) { const v4u w = vraw[i]; const unsigned ww[4] = {w.x, w.y, w.z, w.w};
#pragma unroll
              for (int j = 0; j < 4; ++j) { *(LAS bf16*)(VT + (dvb + 8 * i + 2 * j) * PV + s * 2) = (bf16)(ww[j] & 0xffffu); *(LAS bf16*)(VT + (dvb + 8 * i + 2 * j + 1) * PV + s * 2) = (bf16)(ww[j] >> 16); } } }
        if (u + F.G < 512 * 6) C3_LOAD(u + F.G);
        v2u gtr[4][2];
#pragma unroll
        for (int m = 0; m < 4; ++m)
#pragma unroll
            for (int n = 0; n < 2; ++n) gtr[m][n] = *(const v2u*)(H + (r0 + 16 * m + fr) * HP + C_AG + hd * 256 + 32 * wave + 16 * n + 4 * fq);
        __syncthreads();
        { const int mt = wave >> 1, nt0 = (wave & 1) * 2;
#pragma unroll
          for (int dir = 0; dir < 2; ++dir) { f32x4 sc[2] = {(f32x4){0.f, 0.f, 0.f, 0.f}, (f32x4){0.f, 0.f, 0.f, 0.f}};
#pragma unroll
              for (int ks = 0; ks < 4; ++ks) { const bf16x8 af = ldsfrag(Q1 + dir * 64 * PQ, PQ, 16 * mt, 32 * ks, fr, fq);
#pragma unroll
                  for (int nn = 0; nn < 2; ++nn) sc[nn] = MFMA16(ldsfrag(K1 + dir * 64 * PQ, PQ, 16 * (nt0 + nn), 32 * ks, fr, fq), af, sc[nn]); }
              const int t = 16 * mt + fr;
#pragma unroll
              for (int nn = 0; nn < 2; ++nn) { const int sb_ = 16 * (nt0 + nn) + 4 * fq; float p[4];
#pragma unroll
                  for (int j = 0; j < 4; ++j) { const int s_ = sb_ + j; const bool ok = dir == 0 ? s_ <= t : s_ >= t; p[j] = ok ? sc[nn][j] : 0.f; }
                  v2u w; w.x = pk2(p[0], p[1]); w.y = pk2(p[2], p[3]); *(LAS v2u*)(Pm + (dir * 64 + t) * PV + sb_ * 2) = w; } } }
        __syncthreads();
        f32x4 acc[4][2];
#pragma unroll
        for (int m = 0; m < 4; ++m) { acc[m][0] = (f32x4){0.f, 0.f, 0.f, 0.f}; acc[m][1] = (f32x4){0.f, 0.f, 0.f, 0.f}; }
#pragma unroll
        for (int dir = 0; dir < 2; ++dir) {
#pragma unroll
            for (int ks = 0; ks < 4; ++ks) {
#pragma unroll
                for (int m = 0; m < 4; ++m) { const bf16x8 af = ldsfrag(Q1 + dir * 64 * PQ, PQ, 16 * m, 32 * ks, fr, fq); acc[m][0] = MFMA16(sfr[dir][ks][0], af, acc[m][0]); acc[m][1] = MFMA16(sfr[dir][ks][1], af, acc[m][1]); } }
#pragma unroll
            for (int ks = 0; ks < 2; ++ks) { const bf16x8 b0 = ldsfrag(VT, PV, 32 * wave, 32 * ks, fr, fq), b1 = ldsfrag(VT, PV, 32 * wave + 16, 32 * ks, fr, fq);
#pragma unroll
                for (int m = 0; m < 4; ++m) { const bf16x8 af = ldsfrag(Pm + dir * 64 * PV, PV, 16 * m, 32 * ks, fr, fq); acc[m][0] = MFMA16(b0, af, acc[m][0]); acc[m][1] = MFMA16(b1, af, acc[m][1]); } } }
#pragma unroll
        for (int m = 0; m < 4; ++m) { float ss = 0.f;
#pragma unroll
            for (int n = 0; n < 2; ++n)
#pragma unroll
                for (int j = 0; j < 4; ++j) ss += acc[m][n][j] * acc[m][n][j];
            ss += shx<16>(ss); ss = sum32(ss);
            if (fq == 0) red[(16 * m + fr) * 8 + wave] = ss; }
        __syncthreads();
#pragma unroll
        for (int m = 0; m < 4; ++m) { const int t = 16 * m + fr; const f32x4 ra = *(const LAS f32x4*)(red + t * 8), rb = *(const LAS f32x4*)(red + t * 8 + 4);
            const float tot = ((ra.x + ra.y) + (ra.z + ra.w)) + ((rb.x + rb.y) + (rb.z + rb.w)); const float rstd = 1.0f / sqrtf(tot * (1.f / 256.f) + 1e-6f);
            const size_t row = r0 + t;
#pragma unroll
            for (int n = 0; n < 2; ++n) { const int dv = 32 * wave + 16 * n + 4 * fq; const f32x4 g = *(const f32x4*)(gn + dv); const v2u gt = gtr[m][n];
                v2u w; w.x = pk2(acc[m][n][0] * rstd * g.x * bflo(gt.x), acc[m][n][1] * rstd * g.y * bfhi(gt.x)); w.y = pk2(acc[m][n][2] * rstd * g.z * bflo(gt.y), acc[m][n][3] * rstd * g.w * bfhi(gt.y));
                *(v2u*)(O + row * D + O_A + hd * 256 + dv) = w; } }
    }
#undef C3_LOAD
}

__global__ void __launch_bounds__(NWAVES * 64, 2) fwd_kernel(Args args) {
    extern __shared__ __attribute__((aligned(16))) unsigned char lds[];
    Frame F;
    F.lds = (LAS unsigned char*)lds;
    F.wv = __builtin_amdgcn_readfirstlane((int)threadIdx.x >> 6);
    volatile LAS unsigned* MISC = (volatile LAS unsigned*)(F.lds + MISC_OFF);
    F.G = gridDim.x; { const int bx = blockIdx.x; F.vcu = (F.G % 8 == 0) ? (bx % 8) * (F.G / 8) + bx / 8 : bx; }
    unsigned char* ws = args.ws;
    gu32* ctl = (gu32*)(ws + WS_CTL);
    for (int u = threadIdx.x; u < (LDS_BYTES - LDSCTL_OFF) / 4; u += NWAVES * 64) ((LAS unsigned*)(F.lds + LDSCTL_OFF))[u] = 0u;
    __syncthreads();
    XcdBarrier bar; bar.bar = (unsigned*)(ctl + CW_BAR); bar.x = 0; bar.st = nullptr; bar.wv = F.wv;
    if (N_LAUNCHES == 1) bar = xcd_barrier_post((unsigned*)(ctl + CW_BAR), MISC + 8, F.wv);
    const int lo = args.ph_lo, hi = args.ph_hi;
#define IN(k) (lo <= (k) && (k) < hi)
#define REPS(bit) ((DUP_MASK & (bit)) ? (hi > 16 ? 2 : 1) : 1)
#define SEAM(k) do { if (IN(k) && IN((k) + 1)) xcd_barrier(bar); } while (0)

    if (IN(0)) { for (int rep = 0; rep < REPS(1); ++rep) phase_convert(F, args); }
    SEAM(0);
    for (int layer = 0; layer < DEPTH; ++layer) {
        const int pb = 1 + 8 * layer;
        if (IN(pb + 0)) { for (int rep = 0; rep < REPS(2); ++rep) phase_rmsnorm(F, args, layer); }
        SEAM(pb + 0);
        if (IN(pb + 1)) {
            pg8::Gemm g{(const bf16*)(ws + WS_XN), (const bf16*)(ws + WS_WIN + layer * (190 * MiB)), (const bf16*)(ws + WS_MG)};
            Sched1 S{(int)blockIdx.x, F.G};
            Epi1 E{(bf16*)(ws + WS_H), (float*)(ws + WS_LR), args.in[14] + layer * 3 * D, ws + WS_G};
            for (int rep = 0; rep < REPS(4); ++rep) {
                pg8::gemm_phase<Epi1, Sched1, true, true>(F.lds + RING_OFF, g, S, E, F.wv);
#if FP8_ATT
                { int c8 = (int)blockIdx.x, g8 = F.G; asm volatile("" : "+s"(c8), "+s"(g8));
                  Sched1F8 S8{c8, g8}; Epi1F8 E8{(bf16*)(ws + WS_H), args.in[14] + layer * 3 * D, ws + WS_G}; pg8::gemm_phase<Epi1F8, Sched1F8, true, true, true>(F.lds + RING_OFF, g, S8, E8, F.wv); }
#endif
            }
        }
        SEAM(pb + 1);
        if (IN(pb + 2)) { phase_prep(F, args, layer); }
        SEAM(pb + 2);
        if (IN(pb + 3)) {
#if MFMA_SGU
            for (int rep = 0; rep < REPS(16); ++rep) phase_sgu(F, args, layer);
#endif
#if MFMA_ATT
            for (int rep = 0; rep < REPS(32); ++rep) phase_attn(F, args, layer);
#endif
#if MFMA_GLA
            for (int rep = 0; rep < REPS(64); ++rep) phase_gla_c1(F, args, layer);
#else
            phase_mix_naive(F, args, layer);
#endif
        }
        SEAM(pb + 3);
        if (IN(pb + 4)) {
#if MFMA_GLA
            phase_gla_scan(F, args);
#endif
        }
        SEAM(pb + 4);
        if (IN(pb + 5)) {
#if MFMA_GLA
            for (int rep = 0; rep < REPS(128); ++rep) phase_gla_c3(F, args, layer);
#else
            phase_gla_fin(F, args, layer);
#endif
        }
        SEAM(pb + 5);
        if (IN(pb + 6)) {
            pg8::Gemm g{(const bf16*)(ws + WS_XN), (const bf16*)(ws + WS_WBR + layer * (32 * MiB)), nullptr};
            Sched2 S{(int)blockIdx.x, F.G};
            Epi2 E{ws + WS_G, (bf16*)(ws + WS_MG)};
            if (STAG2 && (blockIdx.x & 1)) { const unsigned long long t0 = __builtin_amdgcn_s_memrealtime(); while (__builtin_amdgcn_s_memrealtime() - t0 < (unsigned long long)STAG2) __builtin_amdgcn_s_sleep(8); }
            for (int rep = 0; rep < REPS(256); ++rep) pg8::gemm_phase<Epi2, Sched2, true, true>(F.lds + RING_OFF, g, S, E, F.wv);
        }
        SEAM(pb + 6);
        if (IN(pb + 7)) {
            pg8::Gemm g{(const bf16*)(ws + WS_MG), (const bf16*)(ws + WS_WOUT + layer * (32 * MiB)), nullptr};
            Sched3 S{(int)blockIdx.x, F.G};
            Epi3 E{args.in[0], args.in[1], args.out, layer};
            if (STAG3 && (blockIdx.x & 1)) { const unsigned long long t0 = __builtin_amdgcn_s_memrealtime(); while (__builtin_amdgcn_s_memrealtime() - t0 < (unsigned long long)STAG3) __builtin_amdgcn_s_sleep(8); }
            for (int rep = 0; rep < (layer == 0 ? REPS(512) : 1); ++rep) pg8::gemm_phase<Epi3, Sched3, true, true>(F.lds + RING_OFF, g, S, E, F.wv);
        }
        SEAM(pb + 7);
    }
#undef IN
#undef SEAM
}

extern "C" void kernel_launch(void* const* d_in, const int* in_sizes, int n_in, void* d_out, int out_size, void* d_ws, size_t ws_size, hipStream_t stream) {
    static int grid = 0;
    if (grid == 0) {
        if (n_in != 17 || ws_size < WS_END) { fprintf(stderr, "kernel_launch: bad inputs / workspace (%d, %zu < %zu)\n", n_in, ws_size, (size_t)WS_END); grid = -1; return; }
        int dev = 0, cus = 0;
        if (hipGetDevice(&dev) != hipSuccess || hipDeviceGetAttribute(&cus, hipDeviceAttributeMultiprocessorCount, dev) != hipSuccess) { grid = -1; return; }
        if (hipFuncSetAttribute((const void*)fwd_kernel, hipFuncAttributeMaxDynamicSharedMemorySize, LDS_BYTES) != hipSuccess) { grid = -1; return; }
        int per_cu = 0;
        (void)hipOccupancyMaxActiveBlocksPerMultiprocessor(&per_cu, (const void*)fwd_kernel, NWAVES * 64, LDS_BYTES);
        (void)hipGetLastError();
        grid = cus;
    }
    if (grid < 0) return;
    (void)hipMemsetAsync((char*)d_ws + WS_CTL, 0, CTL_ZERO_BYTES, stream);
    Args a{};
    for (int i = 0; i < 17; ++i) a.in[i] = (const float*)d_in[i];
    a.out = (float*)d_out; a.ws = (unsigned char*)d_ws;
    if (N_LAUNCHES == 1) { a.ph_lo = 0; a.ph_hi = N_PHASES; hipLaunchKernelGGL(fwd_kernel, dim3(grid), dim3(NWAVES * 64), LDS_BYTES, stream, a); }
    else for (int p = 0; p < N_PHASES; ++p) { a.ph_lo = p; a.ph_hi = p + 1; hipLaunchKernelGGL(fwd_kernel, dim3(grid), dim3(NWAVES * 64), LDS_BYTES, stream, a); }
}
```

```cpp
#include <hip/hip_runtime.h>
#include <cstdio>
#include <cstdint>

#ifndef MFMA_SGU
#define MFMA_SGU 1
#endif
#ifndef MFMA_ATT
#define MFMA_ATT 1
#endif
#ifndef ATT_FUSED_NORM
#define ATT_FUSED_NORM 0
#endif
#ifndef MFMA_GLA
#define MFMA_GLA 1
#endif
#ifndef KROT
#define KROT 0
#endif
#ifndef STAG2
#define STAG2 0
#endif
#ifndef STAG3
#define STAG3 0
#endif
#ifndef FP8_ATT
#define FP8_ATT 1
#endif
#ifndef F8_TILES
#define F8_TILES 64
#endif
#ifndef F8_OC
#define F8_OC 1
#endif
#ifndef DUP_MASK
#define DUP_MASK 0
#endif
#ifndef MK_N_LAUNCHES
#define MK_N_LAUNCHES 1
#endif

namespace pg8 {
#define PG8_LAS __attribute__((address_space(3)))
typedef unsigned short bf16_t;
typedef short bf16x8 __attribute__((ext_vector_type(8)));
typedef float f32x4 __attribute__((ext_vector_type(4)));
typedef unsigned u32x4 __attribute__((ext_vector_type(4)));
constexpr int BM = 256, BK = 64, HALF = 128, HTB = HALF * BK * 2, STAGE_BYTES = 8 * HTB, NXCD = 8, WGM = 8;

__host__ __device__ __forceinline__ int lds_byte(int r, int c) { const int st = (r >> 4) * 2 + (c >> 5), rr = r & 15, cc = c & 31, ob = rr * 64 + cc * 2; return st * 1024 + (ob ^ (((ob >> 9) & 1) << 5)); }
__host__ __device__ __forceinline__ void stage_rc(int b, int& R, int& C) { const int st = b / 1024, sb = b % 1024, swz = sb ^ (((sb >> 9) & 1) << 5); R = (st >> 1) * 16 + swz / 64; C = (st & 1) * 32 + (swz % 64) / 2; }
__host__ __device__ __forceinline__ int perm32(int rho) { const int n = rho >> 4, i = rho & 15; return 8 * (i >> 2) + 4 * n + (i & 3); }

__device__ __forceinline__ int lane_id_v() { int l; asm volatile("v_mbcnt_lo_u32_b32 %0, -1, 0\n\tv_mbcnt_hi_u32_b32 %0, -1, %0" : "=v"(l)); return l; }
struct Unit { int pm, pn, k0, nt, tag, rot; };
struct Gemm { const bf16_t* A; const bf16_t* Bt; const bf16_t* A8; static constexpr int lda = 4096, ldb = 4096; };

__host__ __device__ __forceinline__ void static_tile(int L, int nM, int nN, int& pm, int& pn) {
    const int nwg = nM * nN; int wgid = L;
    { const int q = nwg / NXCD, r = nwg % NXCD, xcd = wgid % NXCD, off = wgid / NXCD; wgid = (xcd < r ? xcd * (q + 1) : r * (q + 1) + (xcd - r) * q) + off; }
    const int nig = WGM * nN, gid = wgid / nig, fm = gid * WGM, gsz = (nM - fm) < WGM ? (nM - fm) : WGM;
    pm = fm + ((wgid % nig) % gsz); pn = (wgid % nig) / gsz;
}

typedef __bf16 bf16x2v __attribute__((ext_vector_type(2)));
typedef float f32x2v __attribute__((ext_vector_type(2)));
__device__ __forceinline__ unsigned cvt_pk_bf16(float lo, float hi) { const f32x2v v = {lo, hi}; return __builtin_bit_cast(unsigned, __builtin_convertvector(v, bf16x2v)); }

typedef int v8i_t __attribute__((ext_vector_type(8)));
typedef int v4i_t __attribute__((ext_vector_type(4)));
__device__ __forceinline__ f32x4 mfma_f8(bf16x8 b0, bf16x8 b1, bf16x8 a0, bf16x8 a1, f32x4 c) {
    const v8i_t bb = __builtin_shufflevector(__builtin_bit_cast(v4i_t, b0), __builtin_bit_cast(v4i_t, b1), 0, 1, 2, 3, 4, 5, 6, 7);
    const v8i_t aa = __builtin_shufflevector(__builtin_bit_cast(v4i_t, a0), __builtin_bit_cast(v4i_t, a1), 0, 1, 2, 3, 4, 5, 6, 7);
    return __builtin_amdgcn_mfma_scale_f32_16x16x128_f8f6f4(bb, aa, c, 0, 0, 0, 0x7F7F7F7F, 0, 0x7F7F7F7F);
}
template <class Epi, class Sched, bool ALIGN_EPI, bool SP2, bool F8 = false>
__device__ __forceinline__ void gemm_phase(PG8_LAS unsigned char* lds, const Gemm g, const Sched& S, const Epi& E, const int wv) {
    int tid_ = (wv << 6) + lane_id_v(); asm volatile("" : "+v"(tid_));
    const int tid = tid_, wid = __builtin_amdgcn_readfirstlane(tid >> 6), lane = tid & 63, wr = wid >> 2, wc = wid & 3, fr = lane & 15, fq = lane >> 4;
    unsigned voffA[2], voffB[2];
#pragma unroll
    for (int i = 0; i < 2; ++i) { int R, C; stage_rc(tid * 16 + i * 8192, R, C); const int Rb = Epi::PERM ? ((R & ~31) + perm32(R & 31)) : R;
        voffA[i] = (unsigned)(R * g.lda + C) * 2u; voffB[i] = (unsigned)(Rb * g.ldb + C) * 2u; }
    const size_t kstep = (size_t)(BK * 2);
    const size_t hstepA = (size_t)HALF * g.lda * 2, hstepB = (size_t)HALF * g.ldb * 2;
    const unsigned ldsw = (unsigned)wid * 1024u;
    const int aoff = lds_byte(wr * 64 + fr, fq * 8), boff = lds_byte(wc * 32 + fr, fq * 8);
    const int bdelta = (4 * wc - 8 * wr) * 1024; (void)bdelta;
#define PG8_SA(b, h) (((b) * 2 + (h)) * HTB)
#define PG8_SB(b, h) ((4 + (b) * 2 + (h)) * HTB)
#define PG8_STAGE(bufoff, gbase, voff) do { const char* _gb = (const char*)(gbase); asm volatile("" : "+s"(_gb)); _Pragma("unroll") for (int _i = 0; _i < 2; ++_i) { unsigned _vo = (voff)[_i]; asm volatile("" : "+v"(_vo)); \
        __builtin_amdgcn_global_load_lds((const unsigned*)(_gb + _vo), (PG8_LAS unsigned*)(lds + (bufoff) + ldsw + _i * 8192), 16, 0, 0); } } while (0)
#define PG8_LDA(dst, b, h) do { _Pragma("unroll") for (int m = 0; m < 4; ++m) _Pragma("unroll") for (int k = 0; k < 2; ++k) dst[m][k] = *(const PG8_LAS bf16x8*)(lds + PG8_SA(b, h) + aoff + m * 2048 + k * 1024); } while (0)
#define PG8_LDB(dst, b, h) do { int _bo = boff; if constexpr (Epi::F8_FROM >= 0) { _bo = aoff + bdelta; asm volatile("" : "+v"(_bo)); } _Pragma("unroll") for (int n = 0; n < 2; ++n) _Pragma("unroll") for (int k = 0; k < 2; ++k) dst[n][k] = *(const PG8_LAS bf16x8*)(lds + PG8_SB(b, h) + _bo + n * 2048 + k * 1024); } while (0)
#define PG8_MMA(ai, bj, At, Bt) do { __builtin_amdgcn_s_setprio(1); \
        if (lrskip && ((bj) != 0 || wc != 0)) { } else \
        if constexpr (F8) { _Pragma("unroll") for (int m = 0; m < 4; ++m) _Pragma("unroll") for (int n = 0; n < 2; ++n) acc[ai][bj][m][n] = mfma_f8(Bt[n][0], Bt[n][1], At[m][0], At[m][1], acc[ai][bj][m][n]); } \
        else if (Epi::F8_FROM >= 0 && f8seg) { _Pragma("unroll") for (int m = 0; m < 4; ++m) _Pragma("unroll") for (int n = 0; n < 2; ++n) acc[ai][bj][m][n] = mfma_f8(Bt[n][0], Bt[n][1], At[m][0], At[m][1], acc[ai][bj][m][n]); } \
        else { _Pragma("unroll") for (int m = 0; m < 4; ++m) _Pragma("unroll") for (int n = 0; n < 2; ++n) _Pragma("unroll") for (int k = 0; k < 2; ++k) \
        acc[ai][bj][m][n] = __builtin_amdgcn_mfma_f32_16x16x32_bf16(Bt[n][k], At[m][k], acc[ai][bj][m][n], 0, 0, 0); } __builtin_amdgcn_s_setprio(0); } while (0)
#define PG8_WAIT_V(n) asm volatile("s_waitcnt vmcnt(" #n ")" ::: "memory")
#define PG8_WAIT_L(n) asm volatile("s_waitcnt lgkmcnt(" #n ")" ::: "memory")
#define PG8_BAR __builtin_amdgcn_s_barrier()
#define PG8_SCHED __builtin_amdgcn_sched_barrier(0)
    Unit cur, nxt; int ui = 0;
    if (!S.next(0, cur)) return;
    f32x4 acc[2][2][4][2];
#pragma unroll
    for (int a = 0; a < 2; ++a)
#pragma unroll
        for (int b = 0; b < 2; ++b)
#pragma unroll
            for (int m = 0; m < 4; ++m)
#pragma unroll
                for (int n = 0; n < 2; ++n) acc[a][b][m][n] = (f32x4){0.f, 0.f, 0.f, 0.f};
    bf16x8 At[4][2], B0[2][2], B1[2][2];
    const char* cA = (const char*)(F8 ? g.A8 : g.A) + ((size_t)cur.pm * BM * g.lda + cur.k0) * 2; const char* cB = (const char*)g.Bt + ((size_t)(cur.pn * BM + (F8 ? cur.tag * HALF : 0)) * g.ldb + cur.k0) * 2;
    { const size_t o0 = (size_t)(cur.rot & (cur.nt - 1)) * kstep, o1 = (size_t)((cur.rot + 1) & (cur.nt - 1)) * kstep;
    if constexpr (SP2) {
        PG8_STAGE(PG8_SB(0, 0), cB + o0, voffB); PG8_STAGE(PG8_SB(0, 1), cB + hstepB + o0, voffB); PG8_STAGE(PG8_SA(0, 0), cA + o0, voffA); PG8_STAGE(PG8_SA(0, 1), cA + hstepA + o0, voffA);
        if (wr == 1) PG8_BAR;
        PG8_WAIT_V(2); PG8_BAR;
        PG8_STAGE(PG8_SB(1, 0), cB + o1, voffB); PG8_STAGE(PG8_SA(1, 0), cA + o1, voffA); PG8_STAGE(PG8_SB(1, 1), cB + hstepB + o1, voffB);
        PG8_WAIT_V(6); PG8_BAR;
    } else {
        PG8_STAGE(PG8_SB(0, 0), cB + o0, voffB); PG8_STAGE(PG8_SA(0, 0), cA + o0, voffA); PG8_STAGE(PG8_SB(0, 1), cB + hstepB + o0, voffB); PG8_STAGE(PG8_SA(0, 1), cA + hstepA + o0, voffA);
        if (wr == 1) PG8_BAR;
        PG8_WAIT_V(4); PG8_BAR;
        PG8_STAGE(PG8_SB(1, 0), cB + o1, voffB); PG8_STAGE(PG8_SA(1, 0), cA + o1, voffA); PG8_STAGE(PG8_SB(1, 1), cB + hstepB + o1, voffB);
        PG8_WAIT_V(6); PG8_BAR;
    } }
    for (;;) {
        const bool has_next = S.next(ui + 1, nxt);
        const char* nA = has_next ? (const char*)(F8 ? g.A8 : g.A) + ((size_t)nxt.pm * BM * g.lda + nxt.k0) * 2 : cA; const char* nB = has_next ? (const char*)g.Bt + ((size_t)(nxt.pn * BM + (F8 ? nxt.tag * HALF : 0)) * g.ldb + nxt.k0) * 2 : cB;
        const int nt = cur.nt, rot = cur.rot, msk = nt - 1;
        const size_t n0 = has_next ? (size_t)(nxt.rot & (nxt.nt - 1)) * kstep : (size_t)(rot & msk) * kstep, n1 = has_next ? (size_t)((nxt.rot + 1) & (nxt.nt - 1)) * kstep : (size_t)((rot + 1) & msk) * kstep;
#define PG8_BODY(F8SEG, LRS) { \
            constexpr bool lrskip = (LRS); (void)lrskip; \
            if constexpr (Epi::HAS_MID) { if (t == Epi::MID0 || t == Epi::MID1) E.mid(acc, cur, t, wr, wc, fr, fq); } \
            constexpr bool f8seg = (F8SEG); (void)f8seg; \
            const bool last = (t == nt - 2); \
            const size_t k1 = rot ? (size_t)((t + 1 + rot) & msk) * kstep : (size_t)(t + 1) * kstep, k2 = rot ? (size_t)((t + 2 + rot) & msk) * kstep : (size_t)(t + 2) * kstep, k3 = rot ? (size_t)((t + 3 + rot) & msk) * kstep : (size_t)(t + 3) * kstep; \
            const char* a1 = cA + k1; \
            const char* a2 = last ? nA + n0 : cA + k2; const char* b2 = last ? nB + n0 : cB + k2; \
            const char* a3 = last ? nA + n1 : cA + k3; const char* b3 = last ? nB + n1 : cB + k3; \
            if constexpr (SP2) { \
            PG8_LDB(B0, 0, 0); PG8_LDB(B1, 0, 1); PG8_SCHED; PG8_LDA(At, 0, 0); PG8_STAGE(PG8_SA(1, 1), a1 + hstepA, voffA); \
            PG8_WAIT_V(8); PG8_WAIT_L(0); PG8_BAR; PG8_MMA(0, 0, At, B0); PG8_MMA(0, 1, At, B1); PG8_BAR; PG8_SCHED; \
            PG8_LDA(At, 0, 1); PG8_STAGE(PG8_SB(0, 0), b2, voffB); PG8_STAGE(PG8_SB(0, 1), b2 + hstepB, voffB); PG8_STAGE(PG8_SA(0, 0), a2, voffA); \
            PG8_WAIT_V(8); PG8_WAIT_L(0); PG8_BAR; PG8_MMA(1, 0, At, B0); PG8_MMA(1, 1, At, B1); PG8_BAR; PG8_SCHED; \
            PG8_LDB(B0, 1, 0); PG8_LDB(B1, 1, 1); PG8_SCHED; PG8_LDA(At, 1, 0); PG8_STAGE(PG8_SA(0, 1), a2 + hstepA, voffA); \
            PG8_WAIT_V(8); PG8_WAIT_L(0); PG8_BAR; PG8_MMA(0, 0, At, B0); PG8_MMA(0, 1, At, B1); PG8_BAR; PG8_SCHED; \
            PG8_LDA(At, 1, 1); PG8_STAGE(PG8_SB(1, 0), b3, voffB); PG8_STAGE(PG8_SB(1, 1), b3 + hstepB, voffB); PG8_STAGE(PG8_SA(1, 0), a3, voffA); \
            PG8_WAIT_V(8); PG8_WAIT_L(0); PG8_BAR; PG8_MMA(1, 0, At, B0); PG8_MMA(1, 1, At, B1); PG8_BAR; PG8_SCHED; \
            } else { \
            PG8_LDB(B0, 0, 0); PG8_SCHED; PG8_LDA(At, 0, 0); PG8_STAGE(PG8_SA(1, 1), a1 + hstepA, voffA); \
            PG8_WAIT_L(8); PG8_BAR; PG8_WAIT_L(0); PG8_MMA(0, 0, At, B0); PG8_BAR; PG8_SCHED; \
            PG8_LDB(B1, 0, 1); PG8_STAGE(PG8_SB(0, 0), b2, voffB); \
            PG8_BAR; PG8_WAIT_L(0); PG8_MMA(0, 1, At, B1); PG8_BAR; \
            PG8_LDA(At, 0, 1); PG8_STAGE(PG8_SA(0, 0), a2, voffA); \
            PG8_BAR; PG8_WAIT_L(0); PG8_MMA(1, 0, At, B0); PG8_BAR; PG8_SCHED; \
            PG8_STAGE(PG8_SB(0, 1), b2 + hstepB, voffB); \
            PG8_WAIT_V(6); PG8_BAR; PG8_MMA(1, 1, At, B1); PG8_BAR; \
            PG8_LDB(B0, 1, 0); PG8_SCHED; PG8_LDA(At, 1, 0); PG8_STAGE(PG8_SA(0, 1), a2 + hstepA, voffA); \
            PG8_WAIT_L(8); PG8_BAR; PG8_WAIT_L(0); PG8_MMA(0, 0, At, B0); PG8_BAR; PG8_SCHED; \
            PG8_LDB(B1, 1, 1); PG8_STAGE(PG8_SB(1, 0), b3, voffB); \
            PG8_BAR; PG8_WAIT_L(0); PG8_MMA(0, 1, At, B1); PG8_BAR; \
            PG8_LDA(At, 1, 1); PG8_STAGE(PG8_SA(1, 0), a3, voffA); \
            PG8_BAR; PG8_WAIT_L(0); PG8_MMA(1, 0, At, B0); PG8_BAR; PG8_SCHED; \
            PG8_STAGE(PG8_SB(1, 1), b3 + hstepB, voffB); \
            PG8_WAIT_V(6); PG8_BAR; PG8_MMA(1, 1, At, B1); PG8_BAR; \
            } \
        }
        if constexpr (Epi::F8_FROM >= 0) {
            for (int t = 0; t < Epi::F8_FROM; t += 2) PG8_BODY(false, false)
            for (int t = Epi::F8_FROM; t < nt; t += 2) PG8_BODY(true, false)
        } else if constexpr (Epi::LR_PN >= 0) {
            if (cur.pn == Epi::LR_PN) { for (int t = 0; t < nt; t += 2) PG8_BODY(false, true) }
            else { for (int t = 0; t < nt; t += 2) PG8_BODY(false, false) }
        } else {
            for (int t = 0; t < nt; t += 2) PG8_BODY(false, false)
        }
#undef PG8_BODY
        if constexpr (ALIGN_EPI) { if (wr == 0) PG8_BAR; }
        E(acc, cur, wr, wc, fr, fq);
        if (!has_next) break;
#pragma unroll
        for (int a = 0; a < 2; ++a)
#pragma unroll
            for (int b = 0; b < 2; ++b)
#pragma unroll
                for (int m = 0; m < 4; ++m)
#pragma unroll
                    for (int n = 0; n < 2; ++n) acc[a][b][m][n] = (f32x4){0.f, 0.f, 0.f, 0.f};
        cur = nxt; cA = nA; cB = nB; ++ui;
        if constexpr (ALIGN_EPI) { if (wr == 1) PG8_BAR; }
    }
    PG8_WAIT_V(0);
    if constexpr (!ALIGN_EPI) { if (wr == 0) PG8_BAR; }
    PG8_BAR;
#undef PG8_SA
#undef PG8_SB
#undef PG8_STAGE
#undef PG8_LDA
#undef PG8_LDB
#undef PG8_MMA
#undef PG8_WAIT_V
#undef PG8_WAIT_L
#undef PG8_BAR
#undef PG8_SCHED
}
}
using pg8::lane_id_v;

constexpr int NWAVES = 8;
constexpr int T = 32768, TP = 16384;
constexpr int D = 4096, NIN = 24096, DEPTH = 2;
constexpr int HP = 11776;
constexpr int NBROWS = 24320;
constexpr int C_AQ = 0, C_AK = 768, C_AV = 1536, C_AG = 3072, C_BU = 4608, C_BV = 5632, C_BG = 6656, C_CQ = 7680, C_CK = 9216, C_CV = 9728, C_CG = 10240, C_GM = 11776, C_LR = 24064;
constexpr int O_A = 0, O_B = 1536, O_C = 2560;
constexpr int F8_LO = 30, F8_N = F8_TILES, F8_HI = F8_LO + F8_N;
constexpr int N_PHASES = 17;
constexpr int N_LAUNCHES = MK_N_LAUNCHES;

constexpr size_t MiB = 1u << 20;
constexpr size_t WS_CTL = 0, CTL_ZERO_BYTES = 1 * MiB;
constexpr size_t WS_ROPE = 1 * MiB;
constexpr size_t WS_WIN = 3 * MiB, WIN_BYTES = (size_t)NBROWS * D * 2;
constexpr size_t WS_WBR = WS_WIN + 2 * 190 * MiB, WSQ_BYTES = (size_t)D * D * 2;
constexpr size_t WS_WOUT = WS_WBR + 64 * MiB;
constexpr size_t WS_XN = WS_WOUT + 64 * MiB;
constexpr size_t WS_H = WS_XN + 256 * MiB;
constexpr size_t WS_G = WS_H + 736 * MiB;
constexpr size_t WS_ST = WS_G + 768 * MiB;
constexpr size_t WS_MG = WS_ST + 384 * MiB;
constexpr size_t WS_LR = WS_MG + 256 * MiB;
constexpr size_t WS_DECC = WS_LR + 8 * MiB;
constexpr size_t WS_END = WS_DECC + 4 * MiB;
static_assert(WIN_BYTES <= 190 * MiB && (size_t)T * HP * 2 <= 736 * MiB && (size_t)T * 12288 * 2 <= 768 * MiB, "ws map");
__device__ __forceinline__ size_t gate_off(int b, int pm, int ct, int ai, int m, int bj, int wr, int wc, int fr, int fq) {
    return ((((size_t)(b * 128 + pm) * 16 + ct) * 16 + (size_t)((ai * 4 + m) * 2 + bj)) * 512 + (size_t)(((wr * 4 + wc) * 4 + fq) * 16 + fr)) * 16; }
constexpr int CW_TMO = 0, CW_CODE = 1;
constexpr int CW_BAR = 4096;

constexpr int RING_OFF = 0, RING_BYTES = 131072;
constexpr int LDSCTL_OFF = RING_BYTES, MISC_OFF = LDSCTL_OFF + 320;
constexpr int LDS_BYTES = 147456;

#define GAS __attribute__((address_space(1)))
#define LAS __attribute__((address_space(3)))
typedef unsigned short bf16;
typedef unsigned v4u __attribute__((ext_vector_type(4)));
typedef unsigned v2u __attribute__((ext_vector_type(2)));
typedef float f32x4 __attribute__((ext_vector_type(4)));
typedef GAS unsigned gu32;
#define RLX_AGENT __ATOMIC_RELAXED, __HIP_MEMORY_SCOPE_AGENT
#define LDS_WAIT() asm volatile("s_waitcnt lgkmcnt(0)" ::: "memory")
#define VM_WAIT() asm volatile("s_waitcnt vmcnt(0)" ::: "memory")
__device__ __forceinline__ unsigned f2bf(float f) { unsigned u = __builtin_bit_cast(unsigned, f); return (u + 0x7fffu + ((u >> 16) & 1u)) >> 16; }
__device__ __forceinline__ unsigned pk2(float lo, float hi) { return pg8::cvt_pk_bf16(lo, hi); }
__device__ __forceinline__ float bflo(unsigned w) { return __uint_as_float(w << 16); }
__device__ __forceinline__ float bfhi(unsigned w) { return __uint_as_float(w & 0xffff0000u); }
__device__ __forceinline__ float bf1(bf16 v) { return __uint_as_float((unsigned)v << 16); }
__device__ __forceinline__ void unpack8(const v4u w, float* x) { x[0] = bflo(w.x); x[1] = bfhi(w.x); x[2] = bflo(w.y); x[3] = bfhi(w.y); x[4] = bflo(w.z); x[5] = bfhi(w.z); x[6] = bflo(w.w); x[7] = bfhi(w.w); }
typedef _Float16 h16x4 __attribute__((ext_vector_type(4)));
__device__ __forceinline__ f32x4 h4(v2u w) { return __builtin_convertvector(__builtin_bit_cast(h16x4, w), f32x4); }
__device__ __forceinline__ f32x4 h4q(v4u w, int hi) { v2u t; t.x = hi ? w.z : w.x; t.y = hi ? w.w : w.y; return h4(t); }
__device__ __forceinline__ float sigm(float x) { return __builtin_amdgcn_rcpf(1.0f + __builtin_amdgcn_exp2f(-1.44269504089f * x)); }

#define XB_TMO      128
#define XB_XCNT(j)  (256  + 64 * (j))
#define XB_XSUB(j)  (1280 + 64 * (j))
#define XB_XGEN(j)  (2304 + 64 * (j))
#define XB_TOP      3328
#define XB_TOPGEN   3392
#define XCD_BAR_WORDS 3456
#define XB_SPIN_CAP (1u << 24)
__device__ __forceinline__ unsigned xb_ld(unsigned* p)              { return __hip_atomic_load(p, __ATOMIC_RELAXED, __HIP_MEMORY_SCOPE_AGENT); }
__device__ __forceinline__ unsigned xb_add(unsigned* p, unsigned v) { return __hip_atomic_fetch_add(p, v, __ATOMIC_RELAXED, __HIP_MEMORY_SCOPE_AGENT); }
__device__ __forceinline__ unsigned xb_xcc_id() { return (unsigned)__builtin_amdgcn_s_getreg((3 << 11) | 20) & 0xFu; }
#define XB_SPIN(cond, bar) do { unsigned _sp = 0; while (cond) { __builtin_amdgcn_s_sleep(1); \
    if ((++_sp & 255u) == 0u) { if (xb_ld(&(bar)[XB_TMO])) break; if (_sp > XB_SPIN_CAP) { atomicAdd(&(bar)[XB_TMO], 1u); break; } } } } while (0)
struct XcdBarrier { unsigned* bar; unsigned x; volatile LAS unsigned* st; int wv; };
__device__ __forceinline__ XcdBarrier xcd_barrier_post(unsigned* bar, volatile LAS unsigned* st, int wv) {
    XcdBarrier b; b.bar = bar; b.x = xb_xcc_id(); b.st = st; b.wv = wv;
    if (threadIdx.x == 0) (void)xb_add(&bar[XB_XCNT(b.x)], 1u);
    return b;
}
__device__ __forceinline__ void xcd_barrier_complete(unsigned* bar, unsigned x, unsigned& nloc, unsigned& nx) {
    const unsigned G = gridDim.x * gridDim.y * gridDim.z;
    unsigned sum, cnt, mine, sp = 0u;
    for (;;) {
        sum = 0u; cnt = 0u; mine = 0u;
#pragma unroll
        for (unsigned j = 0; j < 16; ++j) { const unsigned c = xb_ld(&bar[XB_XCNT(j)]); sum += c; cnt += (c > 0u) ? 1u : 0u; mine = (j == x) ? c : mine; }
        if (sum == G) break;
        __builtin_amdgcn_s_sleep(1);
        if ((++sp & 255u) == 0u) { if (xb_ld(&bar[XB_TMO])) break; if (sp > XB_SPIN_CAP) { atomicAdd(&bar[XB_TMO], 1u); break; } }
    }
    nloc = mine > 0u ? mine : 1u; nx = cnt > 0u ? cnt : 1u;
}
__device__ __forceinline__ void xcd_barrier(const XcdBarrier& b) {
    asm volatile("s_waitcnt vmcnt(0)" ::: "memory");
    __syncthreads();
    if (((b.wv << 6) + lane_id_v()) == 0) {
        unsigned* bar = b.bar; asm volatile("" : "+s"(bar));
        __builtin_amdgcn_s_waitcnt(0);
        unsigned nloc = b.st[0], nx = b.st[1];
        if (nloc == 0u) { xcd_barrier_complete(bar, b.x, nloc, nx); b.st[0] = nloc; b.st[1] = nx; }
        const unsigned old = xb_add(&bar[XB_XSUB(b.x)], 1u);
        const unsigned gen = old / nloc;
        if (old + 1u == (gen + 1u) * nloc) {
            __builtin_amdgcn_fence(__ATOMIC_RELEASE, "agent");
            asm volatile("s_waitcnt vmcnt(0)" ::: "memory");
            const unsigned og = xb_add(&bar[XB_TOP], 1u);
            const unsigned tg = og / nx;
            if (og + 1u == (tg + 1u) * nx) xb_add(&bar[XB_TOPGEN], 1u);
            else XB_SPIN(xb_ld(&bar[XB_TOPGEN]) == tg, bar);
            __builtin_amdgcn_fence(__ATOMIC_ACQUIRE, "agent");
            xb_add(&bar[XB_XGEN(b.x)], 1u);
            asm volatile("s_waitcnt vmcnt(0)" ::: "memory");
        } else {
            XB_SPIN(xb_ld(&bar[XB_XGEN(b.x)]) == gen, bar);
            __builtin_amdgcn_fence(__ATOMIC_ACQUIRE, "agent");
            asm volatile("s_waitcnt vmcnt(0)" ::: "memory");
        }
    }
    __syncthreads();
}

struct Args { const float* in[17]; float* out; unsigned char* ws; int ph_lo, ph_hi; };
struct Frame {
    LAS unsigned char* lds;
    int vcu, G, wv;
};
#define PHASE_IDS() int tid_ = (F.wv << 6) + lane_id_v(); asm volatile("" : "+v"(tid_)); const int tid = tid_, lane = tid & 63, wave = __builtin_amdgcn_readfirstlane(tid >> 6); (void)tid; (void)lane; (void)wave
template <int M> __device__ __forceinline__ float shx(float v) { return __builtin_bit_cast(float, __builtin_amdgcn_ds_swizzle(__builtin_bit_cast(int, v), (M << 10) | 0x1f)); }
__device__ __forceinline__ int lane32x() { return (lane_id_v() ^ 32) << 2; }
__device__ __forceinline__ float xch32(float v, bool) { return __builtin_bit_cast(float, __builtin_amdgcn_ds_bpermute(lane32x(), __builtin_bit_cast(int, v))); }
__device__ __forceinline__ float sum32(float v) { return v + xch32(v, false); }
__device__ __forceinline__ float max32(float v) { return fmaxf(v, xch32(v, false)); }
__device__ __forceinline__ float wave_sum(float v) { v += shx<1>(v); v += shx<2>(v); v += shx<4>(v); v += shx<8>(v); v += shx<16>(v); return sum32(v); }
__device__ __forceinline__ float wave_max(float v) { v = fmaxf(v, shx<1>(v)); v = fmaxf(v, shx<2>(v)); v = fmaxf(v, shx<4>(v)); v = fmaxf(v, shx<8>(v)); v = fmaxf(v, shx<16>(v)); return max32(v); }

struct CvtItem { const float* W; const float* kgain; bf16* WT; int Nsrc, nsrc0, ndst0, k0, f8, kd; };
__device__ __forceinline__ CvtItem cvt_decode(const Args& a, int it) {
    constexpr int I_IN = 64 * (NBROWS / 32), I_SQ = 64 * (D / 32), I_L = I_IN + 2 * I_SQ;
    CvtItem c; const int l = it / I_L; int r = it - l * I_L;
    if (r < I_IN) { const int nb = r % (NBROWS / 32), kb = r / (NBROWS / 32), nm = nb * 32;
        c.W = a.in[3] + (size_t)l * D * NIN; c.Nsrc = NIN; c.nsrc0 = nm < 3072 ? nm : (nm < C_LR ? nm + 32 : (nm < C_LR + 32 ? 3072 + (nm - C_LR) : -1));
        c.kgain = a.in[2] + l * D; c.WT = (bf16*)(a.ws + WS_WIN + l * (190 * MiB)); c.ndst0 = nm; c.k0 = kb * 64; c.kd = c.k0; c.f8 = (FP8_ATT && nm >= F8_LO * 256 && nm < F8_HI * 256) ? 1 : 0; return c; }
    r -= I_IN; const bool br = r < I_SQ; if (!br) r -= I_SQ;
    const int nb = r % (D / 32), kb = r / (D / 32);
    c.W = a.in[br ? 15 : 16] + (size_t)l * D * D; c.Nsrc = D; c.nsrc0 = nb * 32; c.kgain = nullptr; c.WT = (bf16*)(a.ws + (br ? WS_WBR : WS_WOUT) + l * (32 * MiB)); c.ndst0 = nb * 32; c.k0 = kb * 64; c.kd = c.k0; c.f8 = 0;
    if (F8_OC && br && c.k0 >= 2560) { c.f8 = 1; c.kd = 5120 + (c.k0 - 2560); }
    return c;
}
__device__ __forceinline__ void cvt_load(const CvtItem& c, int lane, f32x4 (&v)[8]) {
    const int kr = lane >> 3, nq = (lane & 7) * 4;
#pragma unroll
    for (int i = 0; i < 8; ++i) { v[i] = (f32x4){0.f, 0.f, 0.f, 0.f};
        if (c.nsrc0 >= 0) { v[i] = *(const f32x4*)(c.W + (size_t)(c.k0 + kr + 8 * i) * c.Nsrc + c.nsrc0 + nq); if (c.kgain) v[i] = v[i] * c.kgain[c.k0 + kr + 8 * i]; } }
}
__device__ __forceinline__ void cvt_store(const CvtItem& c, int lane, const f32x4 (&v)[8], LAS float* scr) {
    const int kr = lane >> 3, nq = (lane & 7) * 4;
#pragma unroll
    for (int i = 0; i < 8; ++i) { LAS float* d = scr + (kr + 8 * i) * 33 + nq; d[0] = v[i].x; d[1] = v[i].y; d[2] = v[i].z; d[3] = v[i].w; }
    LDS_WAIT(); asm volatile("" ::: "memory");
    const int cc = lane & 7;
#pragma unroll
    for (int j = 0; j < 4; ++j) { const int n = (lane >> 3) + 8 * j; const LAS float* s = scr + (8 * cc) * 33 + n;
        if (c.f8) {
            int w0 = 0, w1 = 0;
#define F8C(x) __builtin_amdgcn_fmed3f(64.f * (x), -448.f, 448.f)
            w0 = __builtin_amdgcn_cvt_pk_fp8_f32(F8C(s[0 * 33]), F8C(s[1 * 33]), w0, false); w0 = __builtin_amdgcn_cvt_pk_fp8_f32(F8C(s[2 * 33]), F8C(s[3 * 33]), w0, true);
            w1 = __builtin_amdgcn_cvt_pk_fp8_f32(F8C(s[4 * 33]), F8C(s[5 * 33]), w1, false); w1 = __builtin_amdgcn_cvt_pk_fp8_f32(F8C(s[6 * 33]), F8C(s[7 * 33]), w1, true);
#undef F8C
            v2u o2; o2.x = (unsigned)w0; o2.y = (unsigned)w1;
            *(GAS v2u*)((GAS unsigned char*)c.WT + (size_t)(c.ndst0 + n) * 8192 + c.kd + 8 * cc) = o2;
        } else {
        v4u o; o.x = pk2(s[0 * 33], s[1 * 33]); o.y = pk2(s[2 * 33], s[3 * 33]); o.z = pk2(s[4 * 33], s[5 * 33]); o.w = pk2(s[6 * 33], s[7 * 33]);
        *(GAS v4u*)(c.WT + (size_t)(c.ndst0 + n) * D + c.kd + 8 * cc) = o; } }
    LDS_WAIT(); asm volatile("" ::: "memory");
}
__device__ __forceinline__ void phase_convert(Frame& F, const Args& a) {
    PHASE_IDS();
    LAS float* scr = (LAS float*)(F.lds + RING_OFF + wave * 16384);
    const int gw = F.vcu * NWAVES + wave, NGW = F.G * NWAVES;
    constexpr int I_IN = 64 * (NBROWS / 32), I_SQ = 64 * (D / 32), I_L = I_IN + 2 * I_SQ, NIT = DEPTH * I_L;
    if (gw < NIT) {
        CvtItem cur = cvt_decode(a, gw); f32x4 v[8]; cvt_load(cur, lane, v);
        for (int it = gw; it < NIT; it += NGW) {
            const int itn = it + NGW; CvtItem nxt = cur; f32x4 vn[8];
            if (itn < NIT) { nxt = cvt_decode(a, itn); cvt_load(nxt, lane, vn); }
            cvt_store(cur, lane, v, scr);
            cur = nxt;
#pragma unroll
            for (int i = 0; i < 8; ++i) v[i] = vn[i];
        }
    }
    float2* rt = (float2*)(a.ws + WS_ROPE);
    for (int e = (F.vcu * NWAVES + wave) * 64 + lane; e < 16384 * 16; e += F.G * NWAVES * 64) {
        const int pos = e >> 4, i = e & 15;
        const float inv = (float)pow(500000.0, -(double)(2 * i) / 32.0);
        const float ang = (float)pos * inv;
        double sn, cs; sincos((double)ang, &sn, &cs);
        rt[e] = make_float2((float)cs, (float)sn);
    }
}

__device__ __forceinline__ void phase_rmsnorm(Frame& F, const Args& a, int layer) {
    PHASE_IDS();
    const int gw = F.vcu * NWAVES + wave, NGW = F.G * NWAVES;
    bf16* XN = (bf16*)(a.ws + WS_XN);
    for (int m = gw; m < T; m += NGW) {
        const float* xrow = layer == 0 ? (m < TP ? a.in[0] + (size_t)m * D : a.in[1] + (size_t)(m - TP) * D) : a.out + (size_t)m * D;
        const GAS f32x4* xr = (const GAS f32x4*)xrow + lane;
        f32x4 v[16]; float s = 0.f;
#pragma unroll
        for (int j = 0; j < 16; ++j) { v[j] = xr[64 * j]; s += (v[j].x * v[j].x + v[j].y * v[j].y) + (v[j].z * v[j].z + v[j].w * v[j].w); }
        const float rstd = 1.0f / sqrtf(wave_sum(s) * (1.f / D) + 1e-6f);
        GAS v2u* o8 = (GAS v2u*)(XN + (size_t)m * D) + lane;
#pragma unroll
        for (int j = 0; j < 16; ++j) { v2u w; w.x = pk2(v[j].x * rstd, v[j].y * rstd); w.y = pk2(v[j].z * rstd, v[j].w * rstd); o8[64 * j] = w; }
#if FP8_ATT
        GAS unsigned* f8p = (GAS unsigned*)(a.ws + WS_MG + (size_t)m * 8192) + lane;
#pragma unroll
        for (int j = 0; j < 16; ++j) { int w = 0; w = __builtin_amdgcn_cvt_pk_fp8_f32(v[j].x * rstd, v[j].y * rstd, w, false); w = __builtin_amdgcn_cvt_pk_fp8_f32(v[j].z * rstd, v[j].w * rstd, w, true); f8p[64 * j] = (unsigned)w; }
#endif
    }
}

struct Sched1 {
    int c, G;
    __device__ __forceinline__ bool next(int i, pg8::Unit& u) const {
        constexpr int NT = FP8_ATT ? 94 - F8_N : 94;
        const bool hf = (c & 1) && G == 256;
        u.rot = 0;
        if (hf) { if (i == 0) { u.pm = c >> 1; u.pn = 94; u.k0 = 2048; u.nt = 32; u.tag = 1; return true; } i -= 1; }
        long L = (long)i * G + c;
        if (L < 128 * NT) { pg8::static_tile((int)L, 128, NT, u.pm, u.pn); if (FP8_ATT && u.pn >= F8_LO) u.pn += F8_N; u.k0 = 0; u.nt = 64; u.tag = 0; u.rot = KROT * (c & 7); return true; }
        if (hf) return false;
        L -= 128 * NT;
        if (G == 256) { if (L < 256 && !(L & 1)) { u.pm = (int)(L >> 1); u.pn = 94; u.k0 = 0; u.nt = 32; u.tag = 0; return true; } return false; }
        if (L < 256) { u.pm = (int)(L >> 1); u.pn = 94; u.k0 = (int)(L & 1) * 2048; u.nt = 32; u.tag = (int)(L & 1); return true; }
        return false;
    }
};
struct Sched1F8 {
    int c, G;
    __device__ __forceinline__ bool next(int i, pg8::Unit& u) const {
        const long L = (long)i * G + c; if (L >= 128 * F8_N) return false;
        pg8::static_tile((int)L, 128, F8_N, u.pm, u.pn); u.pn += F8_LO; u.k0 = 0; u.nt = 32; u.tag = 0; u.rot = 0; return true;
    }
};
struct Sched2 {
    int c, G;
    __device__ __forceinline__ bool next(int i, pg8::Unit& u) const {
        const long L = (long)i * G + c; if (L >= 128 * 16) return false;
        pg8::static_tile((int)L, 128, 16, u.pm, u.pn); u.k0 = 0; u.nt = F8_OC ? 52 : 64; u.tag = 0; u.rot = 0; return true;
    }
};
struct Sched3 {
    int c, G;
    __device__ __forceinline__ bool next(int i, pg8::Unit& u) const {
        const long L = (long)i * G + c; if (L >= 128 * 16) return false;
        pg8::static_tile((int)L, 128, 16, u.pm, u.pn); u.k0 = 0; u.nt = 64; u.tag = 0; u.rot = KROT * (c & 7); return true;
    }
};
struct Epi1 {
    static constexpr bool PERM = true, HAS_MID = false; static constexpr int MID0 = -1, MID1 = -1, F8_FROM = -1, LR_PN = 94;
    bf16* H; float* LR; const float* gbias; unsigned char* G;
    __device__ __forceinline__ void operator()(const f32x4 (&acc)[2][2][4][2], const pg8::Unit& u, int wr, int wc, int fr, int fq) const {
        using namespace pg8;
        const int row0 = u.pm * BM + wr * 64 + fr;
        if (u.pn == 94) {
            if (wc == 0) { float* base = LR + (size_t)u.tag * T * 32 + 8 * fq;
#pragma unroll
                for (int ai = 0; ai < 2; ++ai)
#pragma unroll
                    for (int m = 0; m < 4; ++m) { float* rp = base + (size_t)(row0 + ai * HALF + m * 16) * 32;
                        *(f32x4*)rp = acc[ai][0][m][0]; *(f32x4*)(rp + 4) = acc[ai][0][m][1]; } }
            return;
        }
        const int pn = u.pn;
        const int act = pn < 12 ? 0 : (pn < 18 ? 1 : (pn < 26 ? 2 : (pn < 30 ? 1 : (pn < 40 ? 0 : (pn < 46 ? 1 : 3)))));
        const int col0 = pn * BM + wc * 32 + 8 * fq;
        if (act == 0) {
#pragma unroll
            for (int ai = 0; ai < 2; ++ai)
#pragma unroll
                for (int m = 0; m < 4; ++m) { bf16* rowp = H + (size_t)(row0 + ai * HALF + m * 16) * HP + col0;
#pragma unroll
                    for (int bj = 0; bj < 2; ++bj) { const f32x4 v0 = acc[ai][bj][m][0], v1 = acc[ai][bj][m][1];
                        u32x4 w; w.x = cvt_pk_bf16(v0[0], v0[1]); w.y = cvt_pk_bf16(v0[2], v0[3]); w.z = cvt_pk_bf16(v1[0], v1[1]); w.w = cvt_pk_bf16(v1[2], v1[3]);
                        __builtin_nontemporal_store(w, (u32x4*)(rowp + bj * HALF)); } }
            return;
        }
        if (act == 3) {
            f32x4 bv[2][2];
#pragma unroll
            for (int bj = 0; bj < 2; ++bj)
#pragma unroll
                for (int n = 0; n < 2; ++n) bv[bj][n] = *(const f32x4*)(gbias + (pn - 46) * BM + wc * 32 + 8 * fq + bj * HALF + 4 * n);
            const int gb = (pn - 46) >> 4, gct = (pn - 46) & 15;
#pragma unroll
            for (int ai = 0; ai < 2; ++ai)
#pragma unroll
                for (int m = 0; m < 4; ++m) {
#pragma unroll
                    for (int bj = 0; bj < 2; ++bj) { float x[8];
#pragma unroll
                        for (int j = 0; j < 4; ++j) { x[j] = sigm(acc[ai][bj][m][0][j] + bv[bj][0][j]); x[4 + j] = sigm(acc[ai][bj][m][1][j] + bv[bj][1][j]); }
                        u32x4 w; w.x = cvt_pk_bf16(x[0], x[1]); w.y = cvt_pk_bf16(x[2], x[3]); w.z = cvt_pk_bf16(x[4], x[5]); w.w = cvt_pk_bf16(x[6], x[7]);
                        __builtin_nontemporal_store(w, (u32x4*)(G + gate_off(gb, u.pm, gct, ai, m, bj, wr, wc, fr, fq))); } }
        } else if (act == 1) {
#pragma unroll
            for (int ai = 0; ai < 2; ++ai)
#pragma unroll
                for (int m = 0; m < 4; ++m) { bf16* rowp = H + (size_t)(row0 + ai * HALF + m * 16) * HP + col0;
#pragma unroll
                    for (int bj = 0; bj < 2; ++bj) { float x[8];
#pragma unroll
                        for (int j = 0; j < 4; ++j) { const float a0 = acc[ai][bj][m][0][j], a1 = acc[ai][bj][m][1][j]; x[j] = a0 * sigm(a0); x[4 + j] = a1 * sigm(a1); }
                        u32x4 w; w.x = cvt_pk_bf16(x[0], x[1]); w.y = cvt_pk_bf16(x[2], x[3]); w.z = cvt_pk_bf16(x[4], x[5]); w.w = cvt_pk_bf16(x[6], x[7]);
                        __builtin_nontemporal_store(w, (u32x4*)(rowp + bj * HALF)); } }
        } else {
#pragma unroll
            for (int ai = 0; ai < 2; ++ai)
#pragma unroll
                for (int m = 0; m < 4; ++m) { bf16* rowp = H + (size_t)(row0 + ai * HALF + m * 16) * HP + col0;
#pragma unroll
                    for (int bj = 0; bj < 2; ++bj) { float x[8];
#pragma unroll
                        for (int j = 0; j < 4; ++j) { const float a0 = acc[ai][bj][m][0][j], a1 = acc[ai][bj][m][1][j];
                            x[j] = a0 * sigm(1.5957691216f * (a0 + 0.044715f * a0 * a0 * a0)); x[4 + j] = a1 * sigm(1.5957691216f * (a1 + 0.044715f * a1 * a1 * a1)); }
                        u32x4 w; w.x = cvt_pk_bf16(x[0], x[1]); w.y = cvt_pk_bf16(x[2], x[3]); w.z = cvt_pk_bf16(x[4], x[5]); w.w = cvt_pk_bf16(x[6], x[7]);
                        __builtin_nontemporal_store(w, (u32x4*)(rowp + bj * HALF)); } }
        }
    }
};
struct Epi1F8 {
    static constexpr bool PERM = true, HAS_MID = false; static constexpr int MID0 = -1, MID1 = -1, F8_FROM = -1, LR_PN = -1;
    bf16* H; const float* gbias; unsigned char* G;
    __device__ __forceinline__ void operator()(const f32x4 (&acc)[2][2][4][2], const pg8::Unit& u, int wr, int wc, int fr, int fq) const {
        using namespace pg8;
        { const int l = lane_id_v(); fr = l & 15; fq = l >> 4; }
        if (u.pn >= 46) {
            const int pn = u.pn; f32x4 bv[2][2];
#pragma unroll
            for (int bj = 0; bj < 2; ++bj)
#pragma unroll
                for (int n = 0; n < 2; ++n) bv[bj][n] = -1.44269504089f * *(const f32x4*)(gbias + (pn - 46) * BM + wc * 32 + 8 * fq + bj * HALF + 4 * n);
            const int gb = (pn - 46) >> 4, gct = (pn - 46) & 15;
            constexpr float KS = -1.44269504089f * 0.015625f;
#pragma unroll
            for (int ai = 0; ai < 2; ++ai)
#pragma unroll
                for (int m = 0; m < 4; ++m) {
#pragma unroll
                    for (int bj = 0; bj < 2; ++bj) { float x[8];
#pragma unroll
                        for (int j = 0; j < 4; ++j) { x[j] = __builtin_amdgcn_rcpf(1.0f + __builtin_amdgcn_exp2f(acc[ai][bj][m][0][j] * KS + bv[bj][0][j])); x[4 + j] = __builtin_amdgcn_rcpf(1.0f + __builtin_amdgcn_exp2f(acc[ai][bj][m][1][j] * KS + bv[bj][1][j])); }
                        u32x4 w; w.x = cvt_pk_bf16(x[0], x[1]); w.y = cvt_pk_bf16(x[2], x[3]); w.z = cvt_pk_bf16(x[4], x[5]); w.w = cvt_pk_bf16(x[6], x[7]);
                        __builtin_nontemporal_store(w, (u32x4*)(G + gate_off(gb, u.pm, gct, ai, m, bj, wr, wc, fr, fq))); } }
            return;
        }
        const int row0 = u.pm * BM + wr * 64 + fr, col0 = u.pn * BM + u.tag * HALF + wc * 32 + 8 * fq; const bool gate = u.pn >= 40;
#pragma unroll
        for (int ai = 0; ai < 2; ++ai)
#pragma unroll
            for (int m = 0; m < 4; ++m)
#pragma unroll
              for (int bj = 0; bj < 2; ++bj) { float x[8];
#pragma unroll
                for (int j = 0; j < 4; ++j) { x[j] = acc[ai][bj][m][0][j] * 0.015625f; x[4 + j] = acc[ai][bj][m][1][j] * 0.015625f; }
                if (gate) {
#pragma unroll
                    for (int j = 0; j < 8; ++j) x[j] = x[j] * sigm(x[j]); }
                u32x4 w; w.x = cvt_pk_bf16(x[0], x[1]); w.y = cvt_pk_bf16(x[2], x[3]); w.z = cvt_pk_bf16(x[4], x[5]); w.w = cvt_pk_bf16(x[6], x[7]);
                __builtin_nontemporal_store(w, (u32x4*)(H + (size_t)(row0 + ai * HALF + m * 16) * HP + col0 + bj * HALF)); }
    }
};
struct Epi2 {
    static constexpr bool PERM = true, HAS_MID = true; static constexpr int MID0 = 24, MID1 = 40, F8_FROM = F8_OC ? 40 : -1, LR_PN = -1;
    const unsigned char* G; bf16* MG;
    __device__ __forceinline__ void mid(f32x4 (&acc)[2][2][4][2], const pg8::Unit& u, int t, int wr, int wc, int fr, int fq) const {
        using namespace pg8;
        { const int l = lane_id_v(); fr = l & 15; fq = l >> 4; }
        const int row0 = u.pm * BM + wr * 64 + fr, col0 = u.pn * BM + wc * 32 + 8 * fq, b = t == MID0 ? 0 : 1;
        const float sc = (F8_OC && b == 1) ? 512.f : 1.f;
#pragma unroll
        for (int ai = 0; ai < 2; ++ai) {
            u32x4 ga[4][2], gb[4][2];
#pragma unroll
            for (int m = 0; m < 4; ++m) {
#pragma unroll
                for (int bj = 0; bj < 2; ++bj) { ga[m][bj] = *(const u32x4*)(G + gate_off(b, u.pm, u.pn, ai, m, bj, wr, wc, fr, fq)); gb[m][bj] = *(const u32x4*)(G + gate_off(b + 1, u.pm, u.pn, ai, m, bj, wr, wc, fr, fq)); } }
#pragma unroll
            for (int m = 0; m < 4; ++m)
#pragma unroll
                for (int bj = 0; bj < 2; ++bj) { float xa[8], xb[8]; unpack8(ga[m][bj], xa); unpack8(gb[m][bj], xb);
#pragma unroll
                    for (int j = 0; j < 4; ++j) { acc[ai][bj][m][0][j] *= xa[j] * __builtin_amdgcn_rcpf(xb[j]) * sc; acc[ai][bj][m][1][j] *= xa[4 + j] * __builtin_amdgcn_rcpf(xb[4 + j]) * sc; } }
        }
    }
    __device__ __forceinline__ void operator()(const f32x4 (&acc)[2][2][4][2], const pg8::Unit& u, int wr, int wc, int fr, int fq) const {
        using namespace pg8;
        { const int l = lane_id_v(); fr = l & 15; fq = l >> 4; }
        const int row0 = u.pm * BM + wr * 64 + fr, col0 = u.pn * BM + wc * 32 + 8 * fq;
#pragma unroll
        for (int ai = 0; ai < 2; ++ai)
#pragma unroll
            for (int m = 0; m < 4; ++m) { const size_t row = (size_t)(row0 + ai * HALF + m * 16);
                bf16* mp = MG + row * D + col0;
#pragma unroll
                for (int bj = 0; bj < 2; ++bj) { const u32x4 gw = *(const u32x4*)(G + gate_off(2, u.pm, u.pn, ai, m, bj, wr, wc, fr, fq));
                    float g[8]; unpack8(gw, g);
                    if (F8_OC) {
#pragma unroll
                        for (int j = 0; j < 8; ++j) g[j] *= (1.f / 512.f); }
                    u32x4 w; w.x = cvt_pk_bf16(acc[ai][bj][m][0][0] * g[0], acc[ai][bj][m][0][1] * g[1]); w.y = cvt_pk_bf16(acc[ai][bj][m][0][2] * g[2], acc[ai][bj][m][0][3] * g[3]);
                    w.z = cvt_pk_bf16(acc[ai][bj][m][1][0] * g[4], acc[ai][bj][m][1][1] * g[5]); w.w = cvt_pk_bf16(acc[ai][bj][m][1][2] * g[6], acc[ai][bj][m][1][3] * g[7]);
                    *(u32x4*)(mp + bj * HALF) = w; } }
    }
};
struct Epi3 {
    static constexpr bool PERM = false, HAS_MID = false; static constexpr int MID0 = -1, MID1 = -1, F8_FROM = -1, LR_PN = -1;
    const float* xp; const float* xs; float* out; int layer;
    __device__ __forceinline__ void operator()(const f32x4 (&acc)[2][2][4][2], const pg8::Unit& u, int wr, int wc, int fr, int fq) const {
        using namespace pg8;
        const int row0 = u.pm * BM + wr * 64 + fr, col0 = u.pn * BM + wc * 32 + 4 * fq;
#pragma unroll
        for (int ai = 0; ai < 2; ++ai)
#pragma unroll
            for (int m = 0; m < 4; ++m) { const int row = row0 + ai * HALF + m * 16;
                const float* xr = (layer == 0 ? (row < TP ? xp + (size_t)row * D : xs + (size_t)(row - TP) * D) : out + (size_t)row * D) + col0;
                float* op = out + (size_t)row * D + col0;
#pragma unroll
                for (int bj = 0; bj < 2; ++bj)
#pragma unroll
                    for (int n = 0; n < 2; ++n) { const f32x4 xv = *(const f32x4*)(xr + bj * HALF + n * 16); __builtin_nontemporal_store(xv + acc[ai][bj][m][n], (f32x4*)(op + bj * HALF + n * 16)); } }
    }
};

__device__ __forceinline__ void phase_prep(Frame& F, const Args& a, int layer) {
    PHASE_IDS();
    const int gw = F.vcu * NWAVES + wave, NGW = F.G * NWAVES;
    bf16* H = (bf16*)(a.ws + WS_H);
    const float2* rt = (const float2*)(a.ws + WS_ROPE);
    const float* qg = a.in[11] + layer * 128; const float* kg = a.in[12] + layer * 128;
#if !(MFMA_ATT && ATT_FUSED_NORM)
    {
        const int li = lane & 15;
        float qgv[8], kgv[8];
#pragma unroll
        for (int i = 0; i < 8; ++i) { qgv[i] = qg[8 * li + i]; kgv[i] = kg[8 * li + i]; }
        v4u w[4], wn[4];
        if (gw < T) { const v4u* p = (const v4u*)(H + (size_t)gw * HP + C_CQ) + lane;
#pragma unroll
            for (int j = 0; j < 4; ++j) w[j] = p[64 * j]; }
        for (int row = gw; row < T; row += NGW) {
            const int rn = row + NGW;
            if (rn < T) { const v4u* p = (const v4u*)(H + (size_t)rn * HP + C_CQ) + lane;
#pragma unroll
                for (int j = 0; j < 4; ++j) wn[j] = p[64 * j]; }
            const int pos = row < TP ? (row & 2047) : row - TP;
            float cs[8], sn[8];
            if (li < 4) { const f32x4* r4 = (const f32x4*)(rt + pos * 16 + 8 * (li & 1));
#pragma unroll
                for (int i = 0; i < 4; ++i) { const f32x4 t4 = r4[i]; cs[2 * i] = t4.x; sn[2 * i] = t4.y; cs[2 * i + 1] = t4.z; sn[2 * i + 1] = t4.w; } }
            v4u* po = (v4u*)(H + (size_t)row * HP + C_CQ) + lane;
#pragma unroll
            for (int j = 0; j < 4; ++j) { float x[8]; unpack8(w[j], x);
                float ss = 0.f;
#pragma unroll
                for (int i = 0; i < 8; ++i) ss += x[i] * x[i];
                ss += shx<1>(ss); ss += shx<2>(ss); ss += shx<4>(ss); ss += shx<8>(ss);
                const float rstd = 1.0f / sqrtf(ss * (1.f / 128.f) + 1e-6f);
                const bool isq = j < 3;
#pragma unroll
                for (int i = 0; i < 8; ++i) x[i] = x[i] * rstd * (isq ? qgv[i] : kgv[i]);
                float pv[8];
#pragma unroll
                for (int i = 0; i < 8; ++i) pv[i] = shx<2>(x[i]);
                if (li < 4) {
#pragma unroll
                    for (int i = 0; i < 8; ++i) x[i] = li < 2 ? x[i] * cs[i] - pv[i] * sn[i] : x[i] * cs[i] + pv[i] * sn[i]; }
                if (isq) {
#pragma unroll
                    for (int i = 0; i < 8; ++i) x[i] *= (MFMA_ATT ? 0.12751743082459868f : 0.08838834764831845f); }
                v4u o; o.x = pk2(x[0], x[1]); o.y = pk2(x[2], x[3]); o.z = pk2(x[4], x[5]); o.w = pk2(x[6], x[7]);
                po[64 * j] = o; }
#pragma unroll
            for (int j = 0; j < 4; ++j) w[j] = wn[j];
        }
    }
#endif
#if !MFMA_SGU
    const float* lg = a.in[7] + layer * 1024; const float* lb = a.in[8] + layer * 1024;
    for (int row = gw; row < T; row += NGW) {
        v4u* p = (v4u*)(H + (size_t)row * HP + C_BV) + lane;
        v4u w0 = p[0], w1 = p[64]; float x[16];
        x[0] = bflo(w0.x); x[1] = bfhi(w0.x); x[2] = bflo(w0.y); x[3] = bfhi(w0.y); x[4] = bflo(w0.z); x[5] = bfhi(w0.z); x[6] = bflo(w0.w); x[7] = bfhi(w0.w);
        x[8] = bflo(w1.x); x[9] = bfhi(w1.x); x[10] = bflo(w1.y); x[11] = bfhi(w1.y); x[12] = bflo(w1.z); x[13] = bfhi(w1.z); x[14] = bflo(w1.w); x[15] = bfhi(w1.w);
        float s = 0.f;
#pragma unroll
        for (int j = 0; j < 16; ++j) s += x[j];
        const float mean = wave_sum(s) * (1.f / 1024.f); float q = 0.f;
#pragma unroll
        for (int j = 0; j < 16; ++j) { x[j] -= mean; q += x[j] * x[j]; }
        const float rstd = 1.0f / sqrtf(wave_sum(q) * (1.f / 1024.f) + 1e-5f);
#pragma unroll
        for (int j = 0; j < 16; ++j) { const int c = (j < 8 ? 8 * lane + j : 512 + 8 * lane + (j - 8)); x[j] = x[j] * rstd * lg[c] + lb[c]; }
        w0.x = pk2(x[0], x[1]); w0.y = pk2(x[2], x[3]); w0.z = pk2(x[4], x[5]); w0.w = pk2(x[6], x[7]);
        w1.x = pk2(x[8], x[9]); w1.y = pk2(x[10], x[11]); w1.z = pk2(x[12], x[13]); w1.w = pk2(x[14], x[15]);
        p[0] = w0; p[64] = w1;
    }
#endif
#if MFMA_GLA
    {
        const float* up = a.in[4] + (size_t)layer * 2 * 16 * 768; const float* gb = a.in[5] + layer * 2 * 768;
        const float* LR0 = (const float*)(a.ws + WS_LR); const float* LR1 = LR0 + (size_t)T * 32;
        float* Bc = (float*)(a.ws + WS_MG);
        LAS float* lrs = (LAS float*)(F.lds + RING_OFF);
        for (int rep8 = 0; rep8 < ((DUP_MASK & 8) ? (F.G > 100 ? 2 : 1) : 1); ++rep8)
        for (int chunk = blockIdx.x; chunk < 512; chunk += F.G) {
            __syncthreads();
            { const size_t o = (size_t)chunk * 2048 + tid * 4; const f32x4 x0 = *(const f32x4*)(LR0 + o), x1 = *(const f32x4*)(LR1 + o); *(LAS f32x4*)(lrs + tid * 4) = x0 + x1; }
            __syncthreads();
#pragma unroll 1
            for (int rr = 0; rr < 3; ++rr) { const int r = tid + 512 * rr, dir = r >= 768 ? 1 : 0, k = r - dir * 768;
                float upv[16];
#pragma unroll
                for (int j = 0; j < 16; ++j) upv[j] = up[(dir * 16 + j) * 768 + k];
                const float bias = gb[dir * 768 + k]; float b = 0.f;
#pragma unroll 4
                for (int i = 0; i < 64; ++i) { const int ri = dir == 0 ? i : 63 - i; const LAS f32x4* l4 = (const LAS f32x4*)(lrs + ri * 32 + dir * 16);
                    float z = bias;
#pragma unroll
                    for (int j = 0; j < 4; ++j) { const f32x4 x = l4[j]; z += x.x * upv[4 * j] + x.y * upv[4 * j + 1] + x.z * upv[4 * j + 2] + x.w * upv[4 * j + 3]; }
                    const float ls = fminf(z, 0.f) - __logf(1.0f + __expf(-fabsf(z)));
                    b += ls * (1.f / 16.f); ((_Float16*)Bc)[((size_t)chunk * 64 + ri) * 1536 + r] = (_Float16)b; }
            }
        }
    }
#endif
#if !MFMA_GLA
    const float* up = a.in[4] + (size_t)layer * 2 * 16 * 768; const float* gb = a.in[5] + layer * 2 * 768;
    const float* LR0 = (const float*)(a.ws + WS_LR); const float* LR1 = LR0 + (size_t)T * 32;
    float* DEC = (float*)(a.ws + WS_MG);
    for (size_t e = (size_t)(F.vcu * NWAVES + wave) * 64 + lane; e < (size_t)T * 1536; e += (size_t)F.G * NWAVES * 64) {
        const int row = (int)(e / 1536), r = (int)(e - (size_t)row * 1536), dir = r / 768, k = r - dir * 768;
        float z = gb[dir * 768 + k];
#pragma unroll
        for (int j = 0; j < 16; ++j) z += (LR0[(size_t)row * 32 + dir * 16 + j] + LR1[(size_t)row * 32 + dir * 16 + j]) * up[(dir * 16 + j) * 768 + k];
        const float ls = fminf(z, 0.f) - log1pf(expf(-fabsf(z)));
        DEC[e] = expf(ls * (1.f / 16.f));
    }
#endif
}

__device__ __forceinline__ void phase_mix_naive(Frame& F, const Args& a, int layer) {
    PHASE_IDS();
    bf16* H = (bf16*)(a.ws + WS_H); bf16* O = (bf16*)(a.ws + WS_XN);
#if !MFMA_SGU
    {
        const float* W = a.in[9] + (size_t)layer * 8 * 128 * 128; const float* sb = a.in[10] + layer * 8 * 128;
        const int c = tid & 127, pq = tid >> 7;
        for (int it = blockIdx.x; it < 256 * 8; it += F.G) {
            const int chunk = it >> 3, g = it & 7; const size_t r0 = (size_t)chunk * 128;
            for (int pp = 0; pp < 32; ++pp) { const int p = pp * 4 + pq; const float* wr = W + ((size_t)g * 128 + p) * 128;
                float acc = 0.f;
                for (int q = 0; q < 128; ++q) acc += wr[q] * bf1(H[(r0 + q) * HP + C_BV + g * 128 + c]);
                const size_t row = r0 + p;
                const float u = bf1(H[row * HP + C_BU + g * 128 + c]), sg = bf1(H[row * HP + C_BG + g * 128 + c]);
                O[row * D + O_B + g * 128 + c] = (bf16)f2bf((acc + sb[g * 128 + p]) * u * sg); }
        }
    }
#endif
#if !MFMA_ATT
    {
        LAS float* wq = (LAS float*)(F.lds + RING_OFF + wave * 2048);
        LAS float* sc = wq + 128;
        const float* sink = a.in[13] + layer * 12;
        const int gw = F.vcu * NWAVES + wave, NGW = F.G * NWAVES;
        for (int it = gw; it < T * 12; it += NGW) {
            const int row = it / 12, hq = it - row * 12, kvh = hq / 3;
            const int s0 = row < TP ? (row & ~2047) : TP, L = row < TP ? 2048 : 16384, qpos = row - s0;
            { const unsigned w = *((const unsigned*)(H + (size_t)row * HP + C_CQ + hq * 128) + lane); wq[2 * lane] = bflo(w); wq[2 * lane + 1] = bfhi(w); }
            LDS_WAIT(); asm volatile("" ::: "memory");
            float mx = -INFINITY;
            for (int pass = 0; pass < 5; ++pass) { const int jj = pass * 64 + lane, kpos = qpos - 128 + jj; float s = -INFINITY;
                if (jj <= 256 && kpos >= 0 && kpos < L) { const v4u* kr = (const v4u*)(H + (size_t)(s0 + kpos) * HP + C_CK + kvh * 128); float d = 0.f;
#pragma unroll 4
                    for (int i = 0; i < 16; ++i) { const v4u w = kr[i]; const LAS float* q8 = wq + 8 * i;
                        d += q8[0] * bflo(w.x) + q8[1] * bfhi(w.x) + q8[2] * bflo(w.y) + q8[3] * bfhi(w.y) + q8[4] * bflo(w.z) + q8[5] * bfhi(w.z) + q8[6] * bflo(w.w) + q8[7] * bfhi(w.w); }
                    s = d; }
                sc[jj] = s; mx = fmaxf(mx, s); }
            const float sk = sink[hq];
            const float m = fmaxf(wave_max(mx), sk);
            LDS_WAIT(); asm volatile("" ::: "memory");
            float ps = 0.f;
            for (int pass = 0; pass < 5; ++pass) { const int jj = pass * 64 + lane; const float s = sc[jj]; const float p = (s == -INFINITY) ? 0.f : __expf(s - m); sc[jj] = p; ps += p; }
            const float denom = wave_sum(ps) + __expf(sk - m);
            LDS_WAIT(); asm volatile("" ::: "memory");
            float o0 = 0.f, o1 = 0.f;
            const int jlo = qpos >= 128 ? 0 : 128 - qpos, jhi = (qpos + 128 < L) ? 256 : (L - 1 - qpos + 128);
            for (int jj = jlo; jj <= jhi; ++jj) { const float p = sc[jj]; const unsigned w = *((const unsigned*)(H + (size_t)(s0 + qpos - 128 + jj) * HP + C_CV + kvh * 128) + lane);
                o0 += p * bflo(w); o1 += p * bfhi(w); }
            const float inv = 1.0f / denom;
            const unsigned gwd = *((const unsigned*)(H + (size_t)row * HP + C_CG + hq * 128) + lane);
            *((unsigned*)(O + (size_t)row * D + O_C + hq * 128) + lane) = pk2(o0 * inv * bflo(gwd), o1 * inv * bfhi(gwd));
            LDS_WAIT(); asm volatile("" ::: "memory");
        }
    }
#endif
    __syncthreads();
    if (blockIdx.x < 108) {
        const int b = blockIdx.x, seq = b / 12, hd = (b % 12) >> 1, dir = b & 1;
        const int s0 = seq < 8 ? seq * 2048 : TP, L = seq < 8 ? 2048 : 16384;
        LAS float* la = (LAS float*)(F.lds + RING_OFF + 32768); LAS float* lq = la + 128; LAS float* lk = lq + 128; LAS float* lo = lk + 128;
        const float* DEC = (const float*)(a.ws + WS_MG);
        float* OUT = (float*)(a.ws + WS_ST) + (size_t)dir * T * 1536;
        const int dv = tid & 255, half = tid >> 8;
        float S[64];
#pragma unroll
        for (int j = 0; j < 64; ++j) S[j] = 0.f;
        float na = 0.f, nq = 0.f, nk = 0.f, nv;
        { const size_t p = (size_t)(dir == 0 ? s0 : s0 + L - 1);
          if (tid < 128) { na = DEC[p * 1536 + dir * 768 + hd * 128 + tid]; nq = bf1(H[p * HP + C_AQ + hd * 128 + tid]) * 0.08838834764831845f; nk = bf1(H[p * HP + C_AK + hd * 128 + tid]); }
          nv = bf1(H[p * HP + C_AV + hd * 256 + dv]); }
        for (int t = 0; t < L; ++t) {
            const size_t p = (size_t)(dir == 0 ? s0 + t : s0 + L - 1 - t);
            if (tid < 128) { la[tid] = na; lq[tid] = nq; lk[tid] = nk; }
            const float v = nv;
            __syncthreads();
            if (t + 1 < L) { const size_t pn = (size_t)(dir == 0 ? p + 1 : p - 1);
                if (tid < 128) { na = DEC[pn * 1536 + dir * 768 + hd * 128 + tid]; nq = bf1(H[pn * HP + C_AQ + hd * 128 + tid]) * 0.08838834764831845f; nk = bf1(H[pn * HP + C_AK + hd * 128 + tid]); }
                nv = bf1(H[pn * HP + C_AV + hd * 256 + dv]); }
            float acc = 0.f;
#pragma unroll
            for (int j = 0; j < 64; ++j) { const int dk = half * 64 + j; S[j] = la[dk] * S[j] + lk[dk] * v; acc += lq[dk] * S[j]; }
            if (half == 1) lo[dv] = acc;
            __syncthreads();
            if (half == 0) OUT[p * 1536 + hd * 256 + dv] = acc + lo[dv];
        }
    }
}

__device__ __forceinline__ void phase_gla_fin(Frame& F, const Args& a, int layer) {
    PHASE_IDS();
    const int gw = F.vcu * NWAVES + wave, NGW = F.G * NWAVES;
    const bf16* H = (const bf16*)(a.ws + WS_H); bf16* O = (bf16*)(a.ws + WS_XN);
    const float* OF = (const float*)(a.ws + WS_ST); const float* OB = OF + (size_t)T * 1536;
    const float* gn = a.in[6] + layer * 256;
    for (int it = gw; it < T * 6; it += NGW) {
        const int row = it / 6, hd = it - row * 6;
        const f32x4 f = *((const f32x4*)(OF + (size_t)row * 1536 + hd * 256) + lane), b = *((const f32x4*)(OB + (size_t)row * 1536 + hd * 256) + lane);
        const f32x4 s = f + b;
        const float rstd = 1.0f / sqrtf(wave_sum((s.x * s.x + s.y * s.y) + (s.z * s.z + s.w * s.w)) * (1.f / 256.f) + 1e-6f);
        const f32x4 g = *((const f32x4*)gn + lane);
        const v2u gt = *((const v2u*)(H + (size_t)row * HP + C_AG + hd * 256) + lane);
        v2u w; w.x = pk2(s.x * rstd * g.x * bflo(gt.x), s.y * rstd * g.y * bfhi(gt.x)); w.y = pk2(s.z * rstd * g.z * bflo(gt.y), s.w * rstd * g.w * bfhi(gt.y));
        *((v2u*)(O + (size_t)row * D + O_A + hd * 256) + lane) = w;
    }
}


typedef short bf16x8 __attribute__((ext_vector_type(8)));
#define MFMA16(a_, b_, c_) __builtin_amdgcn_mfma_f32_16x16x32_bf16(a_, b_, c_, 0, 0, 0)
__device__ __forceinline__ bf16x8 ldsfrag(const LAS unsigned char* base, int pitch, int row0, int k0, int fr, int fq) {
    return *(const LAS bf16x8*)(base + (row0 + fr) * pitch + (k0 + 8 * fq) * 2);
}

__device__ __forceinline__ void phase_sgu(Frame& F, const Args& a, int layer) {
    PHASE_IDS();
    const int fr = lane & 15, fq = lane >> 4;
    constexpr int PIT = 272;
    LAS unsigned char* VT = F.lds + RING_OFF;
    LAS unsigned char* WA = VT + 128 * PIT;
    LAS float* STt = (LAS float*)(WA + 128 * PIT);
    const bf16* H = (const bf16*)(a.ws + WS_H); bf16* O = (bf16*)(a.ws + WS_XN);
    const float* lg = a.in[7] + layer * 1024; const float* lb = a.in[8] + layer * 1024;
    const float* W = a.in[9] + (size_t)layer * 8 * 128 * 128; const float* sb = a.in[10] + layer * 8 * 128;
    for (int chunk = blockIdx.x; chunk < 256; chunk += F.G) {
        const size_t r0 = (size_t)chunk * 128;
        __syncthreads();
        for (int i = 0; i < 16; ++i) { const size_t row = r0 + 16 * wave + i;
            const v4u* p = (const v4u*)(H + row * HP + C_BV) + lane; float x[16]; unpack8(p[0], x); unpack8(p[64], x + 8);
            float s = 0.f;
#pragma unroll
            for (int j = 0; j < 16; ++j) s += x[j];
            const float mean = wave_sum(s) * (1.f / 1024.f); float q = 0.f;
#pragma unroll
            for (int j = 0; j < 16; ++j) { const float d = x[j] - mean; q += d * d; }
            const float rstd = 1.0f / sqrtf(wave_sum(q) * (1.f / 1024.f) + 1e-5f);
            if (lane == 0) { STt[2 * (16 * wave + i)] = mean; STt[2 * (16 * wave + i) + 1] = rstd; } }
        __syncthreads();
        v4u vraw[4]; f32x4 wraw[8];
#define SGU_LOAD(g_) do { const v4u* vs_ = (const v4u*)(H + (r0 + (tid & 127)) * HP + C_BV + (g_) * 128 + (tid >> 7) * 32); _Pragma("unroll") for (int i_ = 0; i_ < 4; ++i_) vraw[i_] = vs_[i_]; \
        const f32x4* ws_ = (const f32x4*)(W + ((size_t)(g_) * 128 + (tid >> 2)) * 128 + (tid & 3) * 32); _Pragma("unroll") for (int i_ = 0; i_ < 8; ++i_) wraw[i_] = ws_[i_]; } while (0)
        SGU_LOAD(0);
        for (int g = 0; g < 8; ++g) {
            { const int q = tid & 127, cb = (tid >> 7) * 32; const float st_x = STt[2 * q], st_y = STt[2 * q + 1];
#pragma unroll
              for (int i = 0; i < 4; ++i) { float x[8]; unpack8(vraw[i], x);
#pragma unroll
                  for (int j = 0; j < 8; ++j) { const int c = cb + 8 * i + j; const float y = (x[j] - st_x) * st_y * lg[g * 128 + c] + lb[g * 128 + c];
                      *(LAS bf16*)(VT + c * PIT + q * 2) = (bf16)f2bf(y); } } }
            { const int p = tid >> 2, qb = (tid & 3) * 32;
#pragma unroll
              for (int i = 0; i < 4; ++i) { const f32x4 u0 = wraw[2 * i], u1 = wraw[2 * i + 1]; v4u w; w.x = pk2(u0.x, u0.y); w.y = pk2(u0.z, u0.w); w.z = pk2(u1.x, u1.y); w.w = pk2(u1.z, u1.w);
                  *(LAS v4u*)(WA + p * PIT + (qb + 8 * i) * 2) = w; } }
            if (g < 7) SGU_LOAD(g + 1);
            const int p = 16 * wave + fr; const size_t row = r0 + p; const float sbv = sb[g * 128 + p];
            v2u gu[8], sg[8];
#pragma unroll
            for (int n = 0; n < 8; ++n) { const int c = g * 128 + 16 * n + 4 * fq; gu[n] = *(const v2u*)(H + row * HP + C_BU + c); sg[n] = *(const v2u*)(H + row * HP + C_BG + c); }
            __syncthreads();
            f32x4 acc[8];
#pragma unroll
            for (int n = 0; n < 8; ++n) acc[n] = (f32x4){0.f, 0.f, 0.f, 0.f};
#pragma unroll
            for (int ks = 0; ks < 4; ++ks) { const bf16x8 af = ldsfrag(WA, PIT, 16 * wave, 32 * ks, fr, fq);
#pragma unroll
                for (int n = 0; n < 8; ++n) acc[n] = MFMA16(ldsfrag(VT, PIT, 16 * n, 32 * ks, fr, fq), af, acc[n]); }
#pragma unroll
            for (int n = 0; n < 8; ++n) { const int c = g * 128 + 16 * n + 4 * fq;
                v2u w; w.x = pk2((acc[n][0] + sbv) * bflo(gu[n].x) * bflo(sg[n].x), (acc[n][1] + sbv) * bfhi(gu[n].x) * bfhi(sg[n].x));
                w.y = pk2((acc[n][2] + sbv) * bflo(gu[n].y) * bflo(sg[n].y), (acc[n][3] + sbv) * bfhi(gu[n].y) * bfhi(sg[n].y));
                *(v2u*)(O + row * D + O_B + c) = w; }
            __syncthreads();
        }
#undef SGU_LOAD
    }
}

__device__ __forceinline__ void phase_attn(Frame& F, const Args& a, int layer) {
    PHASE_IDS();
    const int fr = lane & 15, fq = lane >> 4;
    constexpr int PIT = 272;
    LAS unsigned char* Kt = F.lds + RING_OFF;
    LAS unsigned char* Vt = Kt + 128 * PIT;
    LAS unsigned char* Pm = Vt + 128 * PIT;
    const bf16* H = (const bf16*)(a.ws + WS_H); bf16* O = (bf16*)(a.ws + WS_XN);
    const float* sink = a.in[13] + layer * 12;
    const float* qg = a.in[11] + layer * 128; const float* kg = a.in[12] + layer * 128;
    const float* rt = (const float*)(a.ws + WS_ROPE);
    constexpr int NU = 256 * 12;
    int u = F.vcu; if (u >= NU) return;
#define ATT_DECODE(u_, qb_, hq_, r0_, s0_, nblk_, qi_) const int qb_ = (u_) / 12, hq_ = (u_) - qb_ * 12, r0_ = qb_ * 128, s0_ = r0_ < TP ? (r0_ & ~2047) : TP, nblk_ = r0_ < TP ? 16 : 128, qi_ = (r0_ - s0_) >> 7
#define ATT_LOAD_KV(s0_, kbi_, kvh_) do { const size_t kr0_ = (size_t)((s0_) + (kbi_) * 128); \
        const v4u* ks_ = (const v4u*)(H + (kr0_ + (tid >> 2)) * HP + C_CK + (kvh_) * 128 + (tid & 3) * 32); const v4u* vs_ = (const v4u*)(H + (kr0_ + (tid & 127)) * HP + C_CV + (kvh_) * 128 + (tid >> 7) * 32); \
        _Pragma("unroll") for (int i_ = 0; i_ < 4; ++i_) { kraw[i_] = ks_[i_]; vraw[i_] = vs_[i_]; } } while (0)
#define ATT_LOAD_Q(r0_, hq_) do { const bf16* qp_ = H + (size_t)((r0_) + 16 * wave + fr) * HP + C_CQ + (hq_) * 128 + 8 * fq; \
        _Pragma("unroll") for (int i_ = 0; i_ < 4; ++i_) qraw[i_] = *(const v4u*)(qp_ + 32 * i_); } while (0)
    v4u kraw[4], vraw[4], qraw[4];
    int t;
    { ATT_DECODE(u, qb, hq, r0, s0, nblk, qi); (void)nblk; t = qi == 0 ? 0 : -1; ATT_LOAD_KV(s0, qi + t, hq / 3); ATT_LOAD_Q(r0, hq); }
    for (;;) {
        ATT_DECODE(u, qb, hq, r0, s0, nblk, qi); const int kvh = hq / 3;
        const size_t qrow = (size_t)(r0 + 16 * wave + fr);
        bf16x8 qf[4];
#if ATT_FUSED_NORM
        { float x[4][8]; float ss = 0.f;
#pragma unroll
          for (int ks = 0; ks < 4; ++ks) { unpack8(qraw[ks], x[ks]);
#pragma unroll
              for (int j = 0; j < 8; ++j) ss += x[ks][j] * x[ks][j]; }
          ss += shx<16>(ss); ss = sum32(ss);
          const float rstd = 1.0f / sqrtf(ss * (1.f / 128.f) + 1e-6f);
#pragma unroll
          for (int ks = 0; ks < 4; ++ks) { const f32x4 g0 = *(const f32x4*)(qg + 32 * ks + 8 * fq), g1 = *(const f32x4*)(qg + 32 * ks + 8 * fq + 4);
              x[ks][0] *= rstd * g0.x; x[ks][1] *= rstd * g0.y; x[ks][2] *= rstd * g0.z; x[ks][3] *= rstd * g0.w; x[ks][4] *= rstd * g1.x; x[ks][5] *= rstd * g1.y; x[ks][6] *= rstd * g1.z; x[ks][7] *= rstd * g1.w; }
          { const int pos = (int)qrow - s0; const f32x4* c4 = (const f32x4*)(rt + (pos * 16 + 8 * (fq & 1)) * 2);
#pragma unroll
            for (int j2 = 0; j2 < 4; ++j2) { const f32x4 cs = c4[j2]; const float pa = xch32(x[0][2 * j2], fq >= 2), pb = xch32(x[0][2 * j2 + 1], fq >= 2);
                x[0][2 * j2] = fq < 2 ? x[0][2 * j2] * cs.x - pa * cs.y : x[0][2 * j2] * cs.x + pa * cs.y;
                x[0][2 * j2 + 1] = fq < 2 ? x[0][2 * j2 + 1] * cs.z - pb * cs.w : x[0][2 * j2 + 1] * cs.z + pb * cs.w; } }
#pragma unroll
          for (int ks = 0; ks < 4; ++ks) { v4u w; const float sc = 0.12751743082459868f;
              w.x = pk2(x[ks][0] * sc, x[ks][1] * sc); w.y = pk2(x[ks][2] * sc, x[ks][3] * sc); w.z = pk2(x[ks][4] * sc, x[ks][5] * sc); w.w = pk2(x[ks][6] * sc, x[ks][7] * sc);
              qf[ks] = __builtin_bit_cast(bf16x8, w); } }
#else
#pragma unroll
        for (int ks = 0; ks < 4; ++ks) qf[ks] = __builtin_bit_cast(bf16x8, qraw[ks]);
#endif
        float m = sink[hq] * 1.44269504089f, l = fq == 0 ? 1.f : 0.f;
        f32x4 Oa[8];
#pragma unroll
        for (int n = 0; n < 8; ++n) Oa[n] = (f32x4){0.f, 0.f, 0.f, 0.f};
        int un = u, tn = t; bool more = true;
        for (;;) {
            const size_t kr0 = (size_t)(s0 + (qi + t) * 128);
            __syncthreads();
#if ATT_FUSED_NORM
            { const int key = tid >> 2, dq = tid & 3, db = dq * 32; float ss = 0.f;
#pragma unroll
              for (int i = 0; i < 4; ++i) { float x[8]; unpack8(kraw[i], x);
#pragma unroll
                  for (int j = 0; j < 8; ++j) ss += x[j] * x[j]; }
              ss += shx<1>(ss); ss += shx<2>(ss);
              const float rstd = 1.0f / sqrtf(ss * (1.f / 128.f) + 1e-6f);
              if (dq == 0) {
                  const int pos = (int)(kr0 - s0) + key; const f32x4* c4 = (const f32x4*)(rt + pos * 32);
#pragma unroll
                  for (int h = 0; h < 2; ++h) { float xa[8], xb[8]; unpack8(kraw[h], xa); unpack8(kraw[h + 2], xb);
#pragma unroll
                      for (int j = 0; j < 8; ++j) { xa[j] *= rstd * kg[8 * h + j]; xb[j] *= rstd * kg[16 + 8 * h + j]; }
#pragma unroll
                      for (int j2 = 0; j2 < 4; ++j2) { const f32x4 cs = c4[4 * h + j2];
                          const float a0 = xa[2 * j2], b0 = xb[2 * j2], a1 = xa[2 * j2 + 1], b1 = xb[2 * j2 + 1];
                          xa[2 * j2] = a0 * cs.x - b0 * cs.y; xb[2 * j2] = b0 * cs.x + a0 * cs.y; xa[2 * j2 + 1] = a1 * cs.z - b1 * cs.w; xb[2 * j2 + 1] = b1 * cs.z + a1 * cs.w; }
                      v4u w; w.x = pk2(xa[0], xa[1]); w.y = pk2(xa[2], xa[3]); w.z = pk2(xa[4], xa[5]); w.w = pk2(xa[6], xa[7]); *(LAS v4u*)(Kt + key * PIT + (8 * h) * 2) = w;
                      w.x = pk2(xb[0], xb[1]); w.y = pk2(xb[2], xb[3]); w.z = pk2(xb[4], xb[5]); w.w = pk2(xb[6], xb[7]); *(LAS v4u*)(Kt + key * PIT + (16 + 8 * h) * 2) = w; }
              } else {
#pragma unroll
                  for (int i = 0; i < 4; ++i) { float x[8]; unpack8(kraw[i], x);
#pragma unroll
                      for (int j = 0; j < 8; ++j) x[j] *= rstd * kg[db + 8 * i + j];
                      v4u w; w.x = pk2(x[0], x[1]); w.y = pk2(x[2], x[3]); w.z = pk2(x[4], x[5]); w.w = pk2(x[6], x[7]); *(LAS v4u*)(Kt + key * PIT + (db + 8 * i) * 2) = w; } } }
#else
            { const int key = tid >> 2, db = (tid & 3) * 32;
#pragma unroll
              for (int i = 0; i < 4; ++i) *(LAS v4u*)(Kt + key * PIT + (db + 8 * i) * 2) = kraw[i]; }
#endif
            { const int key = tid & 127, db = (tid >> 7) * 32;
#pragma unroll
              for (int i = 0; i < 4; ++i) { const v4u w = vraw[i]; const unsigned ww[4] = {w.x, w.y, w.z, w.w};
#pragma unroll
                  for (int j = 0; j < 4; ++j) { *(LAS bf16*)(Vt + (db + 8 * i + 2 * j) * PIT + key * 2) = (bf16)(ww[j] & 0xffffu); *(LAS bf16*)(Vt + (db + 8 * i + 2 * j + 1) * PIT + key * 2) = (bf16)(ww[j] >> 16); } } }
            if (t + 1 <= 1 && qi + t + 1 < nblk) { tn = t + 1; ATT_LOAD_KV(s0, qi + tn, kvh); }
            else { un = u + F.G; if (un < NU) { ATT_DECODE(un, qb2, hq2, r02, s02, nblk2, qi2); (void)nblk2; tn = qi2 == 0 ? 0 : -1; ATT_LOAD_KV(s02, qi2 + tn, hq2 / 3); ATT_LOAD_Q(r02, hq2); } else more = false; }
            __syncthreads();
            f32x4 S[8];
#pragma unroll
            for (int n = 0; n < 8; ++n) S[n] = (f32x4){0.f, 0.f, 0.f, 0.f};
#pragma unroll
            for (int ks = 0; ks < 4; ++ks)
#pragma unroll
                for (int n = 0; n < 8; ++n) S[n] = MFMA16(ldsfrag(Kt, PIT, 16 * n, 32 * ks, fr, fq), qf[ks], S[n]);
            const int qi_ = 16 * wave + fr; float mx = -INFINITY;
            if (t != 0) {
#pragma unroll
                for (int n = 0; n < 8; ++n)
#pragma unroll
                    for (int j = 0; j < 4; ++j) { const int kj = 16 * n + 4 * fq + j; const bool ok = t < 0 ? kj >= qi_ : kj <= qi_; S[n][j] = ok ? S[n][j] : -INFINITY; } }
#pragma unroll
            for (int n = 0; n < 8; ++n) mx = fmaxf(mx, fmaxf(fmaxf(S[n][0], S[n][1]), fmaxf(S[n][2], S[n][3])));
            mx = fmaxf(mx, shx<16>(mx)); mx = max32(mx);
            const float mn = fmaxf(m, mx), alpha = __builtin_amdgcn_exp2f(m - mn); m = mn;
            float ps = 0.f;
#pragma unroll
            for (int n = 0; n < 8; ++n) { float p0 = __builtin_amdgcn_exp2f(S[n][0] - mn), p1 = __builtin_amdgcn_exp2f(S[n][1] - mn), p2 = __builtin_amdgcn_exp2f(S[n][2] - mn), p3 = __builtin_amdgcn_exp2f(S[n][3] - mn);
                ps += (p0 + p1) + (p2 + p3); v2u w; w.x = pk2(p0, p1); w.y = pk2(p2, p3);
                *(LAS v2u*)(Pm + (16 * wave + fr) * PIT + (16 * n + 4 * fq) * 2) = w; Oa[n] = Oa[n] * alpha; }
            l = l * alpha + ps;
            LDS_WAIT(); asm volatile("" ::: "memory");
#pragma unroll
            for (int ks = 0; ks < 4; ++ks) { const bf16x8 pf = ldsfrag(Pm, PIT, 16 * wave, 32 * ks, fr, fq);
#pragma unroll
                for (int n = 0; n < 8; ++n) Oa[n] = MFMA16(ldsfrag(Vt, PIT, 16 * n, 32 * ks, fr, fq), pf, Oa[n]); }
            if (un != u || !more) break;
            t = tn;
        }
        l += shx<16>(l); l = sum32(l);
        const float inv = 1.0f / l;
#pragma unroll
        for (int n = 0; n < 8; ++n) { const int d = hq * 128 + 16 * n + 4 * fq; const v2u gt = *(const v2u*)(H + qrow * HP + C_CG + d);
            v2u w; w.x = pk2(Oa[n][0] * inv * bflo(gt.x), Oa[n][1] * inv * bfhi(gt.x)); w.y = pk2(Oa[n][2] * inv * bflo(gt.y), Oa[n][3] * inv * bfhi(gt.y));
#if F8_OC
#define F8C(x) __builtin_amdgcn_fmed3f(8.f * (x), -448.f, 448.f)
            int w8 = 0; w8 = __builtin_amdgcn_cvt_pk_fp8_f32(F8C(Oa[n][0] * inv * bflo(gt.x)), F8C(Oa[n][1] * inv * bfhi(gt.x)), w8, false); w8 = __builtin_amdgcn_cvt_pk_fp8_f32(F8C(Oa[n][2] * inv * bflo(gt.y)), F8C(Oa[n][3] * inv * bfhi(gt.y)), w8, true);
#undef F8C
            *(unsigned*)((unsigned char*)O + qrow * 8192 + 5120 + d) = (unsigned)w8; (void)w; }
#else
            *(v2u*)(O + qrow * D + O_C + d) = w; }
#endif
        if (!more) break;
        u = un; t = tn;
    }
#undef ATT_DECODE
#undef ATT_LOAD_KV
#undef ATT_LOAD_Q
}

__device__ __forceinline__ void phase_gla_c1(Frame& F, const Args& a, int layer) {
    PHASE_IDS();
    const int fr = lane & 15, fq = lane >> 4;
    constexpr int PV = 144;
    LAS unsigned char* VT = F.lds + RING_OFF;
    LAS unsigned char* K1T = VT + 256 * PV;
    const bf16* H = (const bf16*)(a.ws + WS_H); const float* Bc = (const float*)(a.ws + WS_MG);
    bf16* STb = (bf16*)(a.ws + WS_ST); float* DECC = (float*)(a.ws + WS_DECC);
    v4u vraw[4], kraw[2], braw[2][2];
#define C1_LOAD(u_) do { const int c_ = (u_) / 6, hd_ = (u_) - c_ * 6; const size_t r0_ = (size_t)c_ * 64; const int s_ = tid & 63; \
        const v4u* vs_ = (const v4u*)(H + (r0_ + s_) * HP + C_AV + hd_ * 256 + (tid >> 6) * 32); _Pragma("unroll") for (int i_ = 0; i_ < 4; ++i_) vraw[i_] = vs_[i_]; \
        const v4u* ks_ = (const v4u*)(H + (r0_ + s_) * HP + C_AK + hd_ * 128 + (tid >> 6) * 16); kraw[0] = ks_[0]; kraw[1] = ks_[1]; \
        _Pragma("unroll") for (int d_ = 0; d_ < 2; ++d_) { const v4u* bs_ = (const v4u*)((const _Float16*)Bc + (r0_ + s_) * 1536 + d_ * 768 + hd_ * 128 + (tid >> 6) * 16); braw[d_][0] = bs_[0]; braw[d_][1] = bs_[1]; } } while (0)
    if (F.vcu < 512 * 6) C1_LOAD(F.vcu);
    for (int u = F.vcu; u < 512 * 6; u += F.G) {
        const int c = u / 6, hd = u - c * 6; const size_t r0 = (size_t)c * 64;
        __syncthreads();
        { const int s = tid & 63, dvb = (tid >> 6) * 32;
#pragma unroll
          for (int i = 0; i < 4; ++i) { const v4u w = vraw[i]; const unsigned ww[4] = {w.x, w.y, w.z, w.w};
#pragma unroll
              for (int j = 0; j < 4; ++j) { *(LAS bf16*)(VT + (dvb + 8 * i + 2 * j) * PV + s * 2) = (bf16)(ww[j] & 0xffffu); *(LAS bf16*)(VT + (dvb + 8 * i + 2 * j + 1) * PV + s * 2) = (bf16)(ww[j] >> 16); } } }
        { const int s = tid & 63, dkb = (tid >> 6) * 16; float kx[16]; unpack8(kraw[0], kx); unpack8(kraw[1], kx + 8);
#pragma unroll
          for (int dir = 0; dir < 2; ++dir)
#pragma unroll
            for (int i = 0; i < 4; ++i) { const f32x4 bb = h4q(braw[dir][i >> 1], i & 1);
#pragma unroll
                for (int j = 0; j < 4; ++j) *(LAS bf16*)(K1T + (dir * 128 + dkb + 4 * i + j) * PV + s * 2) = (bf16)f2bf(kx[4 * i + j] * __expf(-bb[j])); } }
        if (u + F.G < 512 * 6) C1_LOAD(u + F.G);
        __syncthreads();
#pragma unroll
        for (int dir = 0; dir < 2; ++dir) {
            f32x4 acc[2][8];
#pragma unroll
            for (int m = 0; m < 2; ++m)
#pragma unroll
                for (int n = 0; n < 8; ++n) acc[m][n] = (f32x4){0.f, 0.f, 0.f, 0.f};
#pragma unroll
            for (int ks = 0; ks < 2; ++ks) { const bf16x8 a0 = ldsfrag(VT, PV, 32 * wave, 32 * ks, fr, fq), a1 = ldsfrag(VT, PV, 32 * wave + 16, 32 * ks, fr, fq);
#pragma unroll
                for (int n = 0; n < 8; ++n) { const bf16x8 bfr = ldsfrag(K1T + dir * 128 * PV, PV, 16 * n, 32 * ks, fr, fq); acc[0][n] = MFMA16(bfr, a0, acc[0][n]); acc[1][n] = MFMA16(bfr, a1, acc[1][n]); } }
            const size_t lastrow = r0 + (dir == 0 ? 63 : 0); const int slot = (c * 6 + hd) * 2 + dir; bf16* dst = STb + (size_t)slot * 32768;
#pragma unroll
            for (int n = 0; n < 8; ++n) { const int dk = 16 * n + 4 * fq; const f32x4 bl = h4(*(const v2u*)((const _Float16*)Bc + lastrow * 1536 + dir * 768 + hd * 128 + dk));
                const float e0 = __expf(bl.x), e1 = __expf(bl.y), e2 = __expf(bl.z), e3 = __expf(bl.w);
#pragma unroll
                for (int m = 0; m < 2; ++m) { const int dv = 32 * wave + 16 * m + fr; v2u w; w.x = pk2(acc[m][n][0] * e0, acc[m][n][1] * e1); w.y = pk2(acc[m][n][2] * e2, acc[m][n][3] * e3);
                    *(v2u*)(dst + dv * 128 + dk) = w; } }
            if (tid < 128) DECC[slot * 128 + tid] = __expf((float)((const _Float16*)Bc)[lastrow * 1536 + dir * 768 + hd * 128 + tid]);
        }
    }
#undef C1_LOAD
}
__device__ __forceinline__ void gla_scan_item(int it, bf16* STb, const float* DECC, int lane) {
    int seq, hdir, slab;
    if (it < 768) { seq = 8; hdir = it >> 6; slab = it & 63; } else { const int j = it - 768; const int sh = j >> 6; seq = sh / 12; hdir = sh - seq * 12; slab = j & 63; }
    const int c0 = seq < 8 ? seq * 32 : 256, nc = seq < 8 ? 32 : 256, hd = hdir >> 1, dir = hdir & 1;
    const int e0 = slab * 512 + lane * 8, dk0 = e0 & 127;
    float S[8];
#pragma unroll
    for (int j = 0; j < 8; ++j) S[j] = 0.f;
    v4u kvn[8];
#pragma unroll
    for (int i = 0; i < 8; ++i) { const int c = dir == 0 ? c0 + i : c0 + nc - 1 - i; kvn[i] = *(const v4u*)(STb + (size_t)((c * 6 + hd) * 2 + dir) * 32768 + e0); }
    for (int st = 0; st < nc; st += 8) {
        v4u kv[8]; f32x4 d0[8], d1[8];
#pragma unroll
        for (int i = 0; i < 8; ++i) { const int c = dir == 0 ? c0 + st + i : c0 + nc - 1 - (st + i); const int slot = (c * 6 + hd) * 2 + dir;
            kv[i] = kvn[i]; d0[i] = *(const f32x4*)(DECC + slot * 128 + dk0); d1[i] = *(const f32x4*)(DECC + slot * 128 + dk0 + 4); }
        if (st + 8 < nc) {
#pragma unroll
            for (int i = 0; i < 8; ++i) { const int c = dir == 0 ? c0 + st + 8 + i : c0 + nc - 1 - (st + 8 + i); kvn[i] = *(const v4u*)(STb + (size_t)((c * 6 + hd) * 2 + dir) * 32768 + e0); } }
#pragma unroll
        for (int i = 0; i < 8; ++i) { const int c = dir == 0 ? c0 + st + i : c0 + nc - 1 - (st + i); const int slot = (c * 6 + hd) * 2 + dir;
            v4u w; w.x = pk2(S[0], S[1]); w.y = pk2(S[2], S[3]); w.z = pk2(S[4], S[5]); w.w = pk2(S[6], S[7]);
            *(v4u*)(STb + (size_t)slot * 32768 + e0) = w;
            float x[8]; unpack8(kv[i], x);
            S[0] = d0[i].x * S[0] + x[0]; S[1] = d0[i].y * S[1] + x[1]; S[2] = d0[i].z * S[2] + x[2]; S[3] = d0[i].w * S[3] + x[3];
            S[4] = d1[i].x * S[4] + x[4]; S[5] = d1[i].y * S[5] + x[5]; S[6] = d1[i].z * S[6] + x[6]; S[7] = d1[i].w * S[7] + x[7]; }
    }
}
__device__ __forceinline__ void phase_gla_scan(Frame& F, const Args& a) {
    PHASE_IDS();
    bf16* STb = (bf16*)(a.ws + WS_ST); const float* DECC = (const float*)(a.ws + WS_DECC);
    const int gw = F.vcu * NWAVES + wave, NGW = F.G * NWAVES;
    if (F.G == 256) {
        const int cu = blockIdx.x;
        if (wave < 3) gla_scan_item(cu * 3 + wave, STb, DECC, lane);
        else for (int it = 768 + cu * 5 + (wave - 3); it < 768 + 6144; it += 1280) gla_scan_item(it, STb, DECC, lane);
    }
    else for (int it = gw; it < 768 + 6144; it += NGW) gla_scan_item(it, STb, DECC, lane);
}
__device__ __forceinline__ void phase_gla_c3(Frame& F, const Args& a, int layer) {
    PHASE_IDS();
    const int fr = lane & 15, fq = lane >> 4;
    constexpr int PQ = 272, PV = 144;
    LAS unsigned char* Q1 = F.lds + RING_OFF;
    LAS unsigned char* K1 = Q1 + 2 * 64 * PQ;
    LAS unsigned char* VT = K1 + 2 * 64 * PQ;
    LAS unsigned char* Pm = VT + 256 * PV;
    LAS float* red = (LAS float*)(Pm + 2 * 64 * PV);
    const bf16* H = (const bf16*)(a.ws + WS_H); const float* Bc = (const float*)(a.ws + WS_MG);
    const bf16* STb = (const bf16*)(a.ws + WS_ST); bf16* O = (bf16*)(a.ws + WS_XN);
    const float* gn = a.in[6] + layer * 256;
    v4u qraw[2], kraw[2], vraw[4], braw[2][2];
#define C3_LOAD(u_) do { const int c_ = (u_) / 6, hd_ = (u_) - c_ * 6; const size_t r0_ = (size_t)c_ * 64; const int s_ = tid >> 3, dkb_ = (tid & 7) * 16; \
        const v4u* qs_ = (const v4u*)(H + (r0_ + s_) * HP + C_AQ + hd_ * 128 + dkb_); const v4u* ks_ = (const v4u*)(H + (r0_ + s_) * HP + C_AK + hd_ * 128 + dkb_); \
        qraw[0] = qs_[0]; qraw[1] = qs_[1]; kraw[0] = ks_[0]; kraw[1] = ks_[1]; \
        _Pragma("unroll") for (int d_ = 0; d_ < 2; ++d_) { const v4u* bs_ = (const v4u*)((const _Float16*)Bc + (r0_ + s_) * 1536 + d_ * 768 + hd_ * 128 + dkb_); braw[d_][0] = bs_[0]; braw[d_][1] = bs_[1]; } \
        const v4u* vs_ = (const v4u*)(H + (r0_ + (tid & 63)) * HP + C_AV + hd_ * 256 + (tid >> 6) * 32); _Pragma("unroll") for (int i_ = 0; i_ < 4; ++i_) vraw[i_] = vs_[i_]; } while (0)
    if (F.vcu < 512 * 6) C3_LOAD(F.vcu);
    for (int u = F.vcu; u < 512 * 6; u += F.G) {
        const int c = u / 6, hd = u - c * 6; const size_t r0 = (size_t)c * 64;
        bf16x8 sfr[2][4][2];
#pragma unroll
        for (int dir = 0; dir < 2; ++dir) { const bf16* Sg = STb + (size_t)((c * 6 + hd) * 2 + dir) * 32768;
#pragma unroll
            for (int ks = 0; ks < 4; ++ks)
#pragma unroll
                for (int n = 0; n < 2; ++n) sfr[dir][ks][n] = *(const bf16x8*)(Sg + (32 * wave + 16 * n + fr) * 128 + 32 * ks + 8 * fq); }
        __syncthreads();
        { const int s = tid >> 3, dkb = (tid & 7) * 16; float q0[16], k0[16]; unpack8(qraw[0], q0); unpack8(qraw[1], q0 + 8); unpack8(kraw[0], k0); unpack8(kraw[1], k0 + 8);
#pragma unroll
          for (int dir = 0; dir < 2; ++dir) { float qx[16], kx[16];
#pragma unroll
            for (int i = 0; i < 4; ++i) { const f32x4 bb = h4q(braw[dir][i >> 1], i & 1);
#pragma unroll
                for (int j = 0; j < 4; ++j) { const float e = __expf(bb[j]); qx[4 * i + j] = q0[4 * i + j] * e * 0.08838834764831845f; kx[4 * i + j] = k0[4 * i + j] * __builtin_amdgcn_rcpf(e); } }
            v4u w;
            w.x = pk2(qx[0], qx[1]); w.y = pk2(qx[2], qx[3]); w.z = pk2(qx[4], qx[5]); w.w = pk2(qx[6], qx[7]); *(LAS v4u*)(Q1 + (dir * 64 + s) * PQ + dkb * 2) = w;
            w.x = pk2(qx[8], qx[9]); w.y = pk2(qx[10], qx[11]); w.z = pk2(qx[12], qx[13]); w.w = pk2(qx[14], qx[15]); *(LAS v4u*)(Q1 + (dir * 64 + s) * PQ + dkb * 2 + 16) = w;
            w.x = pk2(kx[0], kx[1]); w.y = pk2(kx[2], kx[3]); w.z = pk2(kx[4], kx[5]); w.w = pk2(kx[6], kx[7]); *(LAS v4u*)(K1 + (dir * 64 + s) * PQ + dkb * 2) = w;
            w.x = pk2(kx[8], kx[9]); w.y = pk2(kx[10], kx[11]); w.z = pk2(kx[12], kx[13]); w.w = pk2(kx[14], kx[15]); *(LAS v4u*)(K1 + (dir * 64 + s) * PQ + dkb * 2 + 16) = w; } }
        { const int s = tid & 63, dvb = (tid >> 6) * 32;
#pragma unroll
          for (int i = 0; i < 4; ++i) { const v4u w = vraw[i]; const unsigned ww[4] = {w.x, w.y, w.z, w.w};
#pragma unroll
              for (int j = 0; j < 4; ++j) { *(LAS bf16*)(VT + (dvb + 8 * i + 2 * j) * PV + s * 2) = (bf16)(ww[j] & 0xffffu); *(LAS bf16*)(VT + (dvb + 8 * i + 2 * j + 1) * PV + s * 2) = (bf16)(ww[j] >> 16); } } }
        if (u + F.G < 512 * 6) C3_LOAD(u + F.G);
        __syncthreads();
        { const int mt = wave >> 1, nt0 = (wave & 1) * 2;
#pragma unroll
          for (int dir = 0; dir < 2; ++dir) { f32x4 sc[2] = {(f32x4){0.f, 0.f, 0.f, 0.f}, (f32x4){0.f, 0.f, 0.f, 0.f}};
#pragma unroll
              for (int ks = 0; ks < 4; ++ks) { const bf16x8 af = ldsfrag(Q1 + dir * 64 * PQ, PQ, 16 * mt, 32 * ks, fr, fq);
#pragma unroll
                  for (int nn = 0; nn < 2; ++nn) sc[nn] = MFMA16(ldsfrag(K1 + dir * 64 * PQ, PQ, 16 * (nt0 + nn), 32 * ks, fr, fq), af, sc[nn]); }
              const int t = 16 * mt + fr;
#pragma unroll
              for (int nn = 0; nn < 2; ++nn) { const int sb_ = 16 * (nt0 + nn) + 4 * fq; float p[4];
#pragma unroll
                  for (int j = 0; j < 4; ++j) { const int s_ = sb_ + j; const bool ok = dir == 0 ? s_ <= t : s_ >= t; p[j] = ok ? sc[nn][j] : 0.f; }
                  v2u w; w.x = pk2(p[0], p[1]); w.y = pk2(p[2], p[3]); *(LAS v2u*)(Pm + (dir * 64 + t) * PV + sb_ * 2) = w; } } }
        __syncthreads();
        f32x4 acc[4][2];
#pragma unroll
        for (int m = 0; m < 4; ++m) { acc[m][0] = (f32x4){0.f, 0.f, 0.f, 0.f}; acc[m][1] = (f32x4){0.f, 0.f, 0.f, 0.f}; }
#pragma unroll
        for (int dir = 0; dir < 2; ++dir) {
#pragma unroll
            for (int ks = 0; ks < 4; ++ks) {
#pragma unroll
                for (int m = 0; m < 4; ++m) { const bf16x8 af = ldsfrag(Q1 + dir * 64 * PQ, PQ, 16 * m, 32 * ks, fr, fq); acc[m][0] = MFMA16(sfr[dir][ks][0], af, acc[m][0]); acc[m][1] = MFMA16(sfr[dir][ks][1], af, acc[m][1]); } }
#pragma unroll
            for (int ks = 0; ks < 2; ++ks) { const bf16x8 b0 = ldsfrag(VT, PV, 32 * wave, 32 * ks, fr, fq), b1 = ldsfrag(VT, PV, 32 * wave + 16, 32 * ks, fr, fq);
#pragma unroll
                for (int m = 0; m < 4; ++m) { const bf16x8 af = ldsfrag(Pm + dir * 64 * PV, PV, 16 * m, 32 * ks, fr, fq); acc[m][0] = MFMA16(b0, af, acc[m][0]); acc[m][1] = MFMA16(b1, af, acc[m][1]); } } }
#pragma unroll
        for (int m = 0; m < 4; ++m) { float ss = 0.f;
#pragma unroll
            for (int n = 0; n < 2; ++n)
#pragma unroll
                for (int j = 0; j < 4; ++j) ss += acc[m][n][j] * acc[m][n][j];
            ss += shx<16>(ss); ss = sum32(ss);
            if (fq == 0) red[(16 * m + fr) * 8 + wave] = ss; }
        __syncthreads();
#pragma unroll
        for (int m = 0; m < 4; ++m) { const int t = 16 * m + fr; const f32x4 ra = *(const LAS f32x4*)(red + t * 8), rb = *(const LAS f32x4*)(red + t * 8 + 4);
            const float tot = ((ra.x + ra.y) + (ra.z + ra.w)) + ((rb.x + rb.y) + (rb.z + rb.w)); const float rstd = 1.0f / sqrtf(tot * (1.f / 256.f) + 1e-6f);
            const size_t row = r0 + t;
#pragma unroll
            for (int n = 0; n < 2; ++n) { const int dv = 32 * wave + 16 * n + 4 * fq; const f32x4 g = *(const f32x4*)(gn + dv); const v2u gt = *(const v2u*)(H + row * HP + C_AG + hd * 256 + dv);
                v2u w; w.x = pk2(acc[m][n][0] * rstd * g.x * bflo(gt.x), acc[m][n][1] * rstd * g.y * bfhi(gt.x)); w.y = pk2(acc[m][n][2] * rstd * g.z * bflo(gt.y), acc[m][n][3] * rstd * g.w * bfhi(gt.y));
                *(v2u*)(O + row * D + O_A + hd * 256 + dv) = w; } }
    }
#undef C3_LOAD
}

__global__ void __launch_bounds__(NWAVES * 64, 2) fwd_kernel(Args args) {
    extern __shared__ __attribute__((aligned(16))) unsigned char lds[];
    Frame F;
    F.lds = (LAS unsigned char*)lds;
    F.wv = __builtin_amdgcn_readfirstlane((int)threadIdx.x >> 6);
    volatile LAS unsigned* MISC = (volatile LAS unsigned*)(F.lds + MISC_OFF);
    F.G = gridDim.x; { const int bx = blockIdx.x; F.vcu = (F.G % 8 == 0) ? (bx % 8) * (F.G / 8) + bx / 8 : bx; }
    unsigned char* ws = args.ws;
    gu32* ctl = (gu32*)(ws + WS_CTL);
    for (int u = threadIdx.x; u < (LDS_BYTES - LDSCTL_OFF) / 4; u += NWAVES * 64) ((LAS unsigned*)(F.lds + LDSCTL_OFF))[u] = 0u;
    __syncthreads();
    XcdBarrier bar; bar.bar = (unsigned*)(ctl + CW_BAR); bar.x = 0; bar.st = nullptr; bar.wv = F.wv;
    if (N_LAUNCHES == 1) bar = xcd_barrier_post((unsigned*)(ctl + CW_BAR), MISC + 8, F.wv);
    const int lo = args.ph_lo, hi = args.ph_hi;
#define IN(k) (lo <= (k) && (k) < hi)
#define REPS(bit) ((DUP_MASK & (bit)) ? (hi > 16 ? 2 : 1) : 1)
#define SEAM(k) do { if (IN(k) && IN((k) + 1)) xcd_barrier(bar); } while (0)

    if (IN(0)) { for (int rep = 0; rep < REPS(1); ++rep) phase_convert(F, args); }
    SEAM(0);
    for (int layer = 0; layer < DEPTH; ++layer) {
        const int pb = 1 + 8 * layer;
        if (IN(pb + 0)) { for (int rep = 0; rep < REPS(2); ++rep) phase_rmsnorm(F, args, layer); }
        SEAM(pb + 0);
        if (IN(pb + 1)) {
            pg8::Gemm g{(const bf16*)(ws + WS_XN), (const bf16*)(ws + WS_WIN + layer * (190 * MiB)), (const bf16*)(ws + WS_MG)};
            Sched1 S{(int)blockIdx.x, F.G};
            Epi1 E{(bf16*)(ws + WS_H), (float*)(ws + WS_LR), args.in[14] + layer * 3 * D, ws + WS_G};
            for (int rep = 0; rep < REPS(4); ++rep) {
                pg8::gemm_phase<Epi1, Sched1, true, true>(F.lds + RING_OFF, g, S, E, F.wv);
#if FP8_ATT
                { int c8 = (int)blockIdx.x, g8 = F.G; asm volatile("" : "+s"(c8), "+s"(g8));
                  Sched1F8 S8{c8, g8}; Epi1F8 E8{(bf16*)(ws + WS_H), args.in[14] + layer * 3 * D, ws + WS_G}; pg8::gemm_phase<Epi1F8, Sched1F8, true, true, true>(F.lds + RING_OFF, g, S8, E8, F.wv); }
#endif
            }
        }
        SEAM(pb + 1);
        if (IN(pb + 2)) { phase_prep(F, args, layer); }
        SEAM(pb + 2);
        if (IN(pb + 3)) {
#if MFMA_SGU
            for (int rep = 0; rep < REPS(16); ++rep) phase_sgu(F, args, layer);
#endif
#if MFMA_ATT
            for (int rep = 0; rep < REPS(32); ++rep) phase_attn(F, args, layer);
#endif
#if MFMA_GLA
            for (int rep = 0; rep < REPS(64); ++rep) phase_gla_c1(F, args, layer);
#else
            phase_mix_naive(F, args, layer);
#endif
        }
        SEAM(pb + 3);
        if (IN(pb + 4)) {
#if MFMA_GLA
            phase_gla_scan(F, args);
#endif
        }
        SEAM(pb + 4);
        if (IN(pb + 5)) {
#if MFMA_GLA
            for (int rep = 0; rep < REPS(128); ++rep) phase_gla_c3(F, args, layer);
#else
            phase_gla_fin(F, args, layer);
#endif
        }
        SEAM(pb + 5);
        if (IN(pb + 6)) {
            pg8::Gemm g{(const bf16*)(ws + WS_XN), (const bf16*)(ws + WS_WBR + layer * (32 * MiB)), nullptr};
            Sched2 S{(int)blockIdx.x, F.G};
            Epi2 E{ws + WS_G, (bf16*)(ws + WS_MG)};
            if (STAG2 && (blockIdx.x & 1)) { const unsigned long long t0 = __builtin_amdgcn_s_memrealtime(); while (__builtin_amdgcn_s_memrealtime() - t0 < (unsigned long long)STAG2) __builtin_amdgcn_s_sleep(8); }
            for (int rep = 0; rep < REPS(256); ++rep) pg8::gemm_phase<Epi2, Sched2, true, true>(F.lds + RING_OFF, g, S, E, F.wv);
        }
        SEAM(pb + 6);
        if (IN(pb + 7)) {
            pg8::Gemm g{(const bf16*)(ws + WS_MG), (const bf16*)(ws + WS_WOUT + layer * (32 * MiB)), nullptr};
            Sched3 S{(int)blockIdx.x, F.G};
            Epi3 E{args.in[0], args.in[1], args.out, layer};
            if (STAG3 && (blockIdx.x & 1)) { const unsigned long long t0 = __builtin_amdgcn_s_memrealtime(); while (__builtin_amdgcn_s_memrealtime() - t0 < (unsigned long long)STAG3) __builtin_amdgcn_s_sleep(8); }
            for (int rep = 0; rep < (layer == 0 ? REPS(512) : 1); ++rep) pg8::gemm_phase<Epi3, Sched3, true, true>(F.lds + RING_OFF, g, S, E, F.wv);
        }
        SEAM(pb + 7);
    }
#undef IN
#undef SEAM
}

extern "C" void kernel_launch(void* const* d_in, const int* in_sizes, int n_in, void* d_out, int out_size, void* d_ws, size_t ws_size, hipStream_t stream) {
    static int grid = 0;
    if (grid == 0) {
        if (n_in != 17 || ws_size < WS_END) { fprintf(stderr, "kernel_launch: bad inputs / workspace (%d, %zu < %zu)\n", n_in, ws_size, (size_t)WS_END); grid = -1; return; }
        int dev = 0, cus = 0;
        if (hipGetDevice(&dev) != hipSuccess || hipDeviceGetAttribute(&cus, hipDeviceAttributeMultiprocessorCount, dev) != hipSuccess) { grid = -1; return; }
        if (hipFuncSetAttribute((const void*)fwd_kernel, hipFuncAttributeMaxDynamicSharedMemorySize, LDS_BYTES) != hipSuccess) { grid = -1; return; }
        int per_cu = 0;
        (void)hipOccupancyMaxActiveBlocksPerMultiprocessor(&per_cu, (const void*)fwd_kernel, NWAVES * 64, LDS_BYTES);
        (void)hipGetLastError();
        grid = cus;
    }
    if (grid < 0) return;
    (void)hipMemsetAsync((char*)d_ws + WS_CTL, 0, CTL_ZERO_BYTES, stream);
    Args a{};
    for (int i = 0; i < 17; ++i) a.in[i] = (const float*)d_in[i];
    a.out = (float*)d_out; a.ws = (unsigned char*)d_ws;
    if (N_LAUNCHES == 1) { a.ph_lo = 0; a.ph_hi = N_PHASES; hipLaunchKernelGGL(fwd_kernel, dim3(grid), dim3(NWAVES * 64), LDS_BYTES, stream, a); }
    else for (int p = 0; p < N_PHASES; ++p) { a.ph_lo = p; a.ph_hi = p + 1; hipLaunchKernelGGL(fwd_kernel, dim3(grid), dim3(NWAVES * 64), LDS_BYTES, stream, a); }
}
```

```cpp
#include <hip/hip_runtime.h>
#include <cstdio>
#include <cstdint>

#ifndef MFMA_SGU
#define MFMA_SGU 1
#endif
#ifndef MFMA_ATT
#define MFMA_ATT 1
#endif
#ifndef ATT_FUSED_NORM
#define ATT_FUSED_NORM 0
#endif
#ifndef MFMA_GLA
#define MFMA_GLA 1
#endif
#ifndef KROT
#define KROT 0
#endif
#ifndef STAG2
#define STAG2 0
#endif
#ifndef STAG3
#define STAG3 0
#endif
#ifndef FP8_ATT
#define FP8_ATT 1
#endif
#ifndef F8_TILES
#define F8_TILES 64
#endif
#ifndef F8_OC
#define F8_OC 1
#endif
#ifndef DUP_MASK
#define DUP_MASK 0
#endif
#ifndef MK_N_LAUNCHES
#define MK_N_LAUNCHES 1
#endif

namespace pg8 {
#define PG8_LAS __attribute__((address_space(3)))
typedef unsigned short bf16_t;
typedef short bf16x8 __attribute__((ext_vector_type(8)));
typedef float f32x4 __attribute__((ext_vector_type(4)));
typedef unsigned u32x4 __attribute__((ext_vector_type(4)));
constexpr int BM = 256, BK = 64, HALF = 128, HTB = HALF * BK * 2, STAGE_BYTES = 8 * HTB, NXCD = 8, WGM = 8;

__host__ __device__ __forceinline__ int lds_byte(int r, int c) { const int st = (r >> 4) * 2 + (c >> 5), rr = r & 15, cc = c & 31, ob = rr * 64 + cc * 2; return st * 1024 + (ob ^ (((ob >> 9) & 1) << 5)); }
__host__ __device__ __forceinline__ void stage_rc(int b, int& R, int& C) { const int st = b / 1024, sb = b % 1024, swz = sb ^ (((sb >> 9) & 1) << 5); R = (st >> 1) * 16 + swz / 64; C = (st & 1) * 32 + (swz % 64) / 2; }
__host__ __device__ __forceinline__ int perm32(int rho) { const int n = rho >> 4, i = rho & 15; return 8 * (i >> 2) + 4 * n + (i & 3); }

__device__ __forceinline__ int lane_id_v() { int l; asm volatile("v_mbcnt_lo_u32_b32 %0, -1, 0\n\tv_mbcnt_hi_u32_b32 %0, -1, %0" : "=v"(l)); return l; }
struct Unit { int pm, pn, k0, nt, tag, rot; };
struct Gemm { const bf16_t* A; const bf16_t* Bt; const bf16_t* A8; static constexpr int lda = 4096, ldb = 4096; };

__host__ __device__ __forceinline__ void static_tile(int L, int nM, int nN, int& pm, int& pn) {
    const int nwg = nM * nN; int wgid = L;
    { const int q = nwg / NXCD, r = nwg % NXCD, xcd = wgid % NXCD, off = wgid / NXCD; wgid = (xcd < r ? xcd * (q + 1) : r * (q + 1) + (xcd - r) * q) + off; }
    const int nig = WGM * nN, gid = wgid / nig, fm = gid * WGM, gsz = (nM - fm) < WGM ? (nM - fm) : WGM;
    pm = fm + ((wgid % nig) % gsz); pn = (wgid % nig) / gsz;
}

typedef __bf16 bf16x2v __attribute__((ext_vector_type(2)));
typedef float f32x2v __attribute__((ext_vector_type(2)));
__device__ __forceinline__ unsigned cvt_pk_bf16(float lo, float hi) { const f32x2v v = {lo, hi}; return __builtin_bit_cast(unsigned, __builtin_convertvector(v, bf16x2v)); }

typedef int v8i_t __attribute__((ext_vector_type(8)));
typedef int v4i_t __attribute__((ext_vector_type(4)));
__device__ __forceinline__ f32x4 mfma_f8(bf16x8 b0, bf16x8 b1, bf16x8 a0, bf16x8 a1, f32x4 c) {
    const v8i_t bb = __builtin_shufflevector(__builtin_bit_cast(v4i_t, b0), __builtin_bit_cast(v4i_t, b1), 0, 1, 2, 3, 4, 5, 6, 7);
    const v8i_t aa = __builtin_shufflevector(__builtin_bit_cast(v4i_t, a0), __builtin_bit_cast(v4i_t, a1), 0, 1, 2, 3, 4, 5, 6, 7);
    return __builtin_amdgcn_mfma_scale_f32_16x16x128_f8f6f4(bb, aa, c, 0, 0, 0, 0x7F7F7F7F, 0, 0x7F7F7F7F);
}
template <class Epi, class Sched, bool ALIGN_EPI, bool SP2, bool F8 = false>
__device__ __forceinline__ void gemm_phase(PG8_LAS unsigned char* lds, const Gemm g, const Sched& S, const Epi& E, const int wv) {
    int tid_ = (wv << 6) + lane_id_v(); asm volatile("" : "+v"(tid_));
    const int tid = tid_, wid = __builtin_amdgcn_readfirstlane(tid >> 6), lane = tid & 63, wr = wid >> 2, wc = wid & 3, fr = lane & 15, fq = lane >> 4;
    unsigned voffA[2], voffB[2];
#pragma unroll
    for (int i = 0; i < 2; ++i) { int R, C; stage_rc(tid * 16 + i * 8192, R, C); const int Rb = Epi::PERM ? ((R & ~31) + perm32(R & 31)) : R;
        voffA[i] = (unsigned)(R * g.lda + C) * 2u; voffB[i] = (unsigned)(Rb * g.ldb + C) * 2u; }
    const size_t kstep = (size_t)(BK * 2);
    const size_t hstepA = (size_t)HALF * g.lda * 2, hstepB = (size_t)HALF * g.ldb * 2;
    const unsigned ldsw = (unsigned)wid * 1024u;
    const int aoff = lds_byte(wr * 64 + fr, fq * 8), boff = lds_byte(wc * 32 + fr, fq * 8);
    const int bdelta = (4 * wc - 8 * wr) * 1024; (void)bdelta;
#define PG8_SA(b, h) (((b) * 2 + (h)) * HTB)
#define PG8_SB(b, h) ((4 + (b) * 2 + (h)) * HTB)
#define PG8_STAGE(bufoff, gbase, voff) do { const char* _gb = (const char*)(gbase); asm volatile("" : "+s"(_gb)); _Pragma("unroll") for (int _i = 0; _i < 2; ++_i) { unsigned _vo = (voff)[_i]; asm volatile("" : "+v"(_vo)); \
        __builtin_amdgcn_global_load_lds((const unsigned*)(_gb + _vo), (PG8_LAS unsigned*)(lds + (bufoff) + ldsw + _i * 8192), 16, 0, 0); } } while (0)
#define PG8_LDA(dst, b, h) do { _Pragma("unroll") for (int m = 0; m < 4; ++m) _Pragma("unroll") for (int k = 0; k < 2; ++k) dst[m][k] = *(const PG8_LAS bf16x8*)(lds + PG8_SA(b, h) + aoff + m * 2048 + k * 1024); } while (0)
#define PG8_LDB(dst, b, h) do { int _bo = boff; if constexpr (Epi::F8_FROM >= 0) { _bo = aoff + bdelta; asm volatile("" : "+v"(_bo)); } _Pragma("unroll") for (int n = 0; n < 2; ++n) _Pragma("unroll") for (int k = 0; k < 2; ++k) dst[n][k] = *(const PG8_LAS bf16x8*)(lds + PG8_SB(b, h) + _bo + n * 2048 + k * 1024); } while (0)
#define PG8_MMA(ai, bj, At, Bt) do { __builtin_amdgcn_s_setprio(1); \
        if (lrskip && ((bj) != 0 || wc != 0)) { } else \
        if constexpr (F8) { _Pragma("unroll") for (int m = 0; m < 4; ++m) _Pragma("unroll") for (int n = 0; n < 2; ++n) acc[ai][bj][m][n] = mfma_f8(Bt[n][0], Bt[n][1], At[m][0], At[m][1], acc[ai][bj][m][n]); } \
        else if (Epi::F8_FROM >= 0 && f8seg) { _Pragma("unroll") for (int m = 0; m < 4; ++m) _Pragma("unroll") for (int n = 0; n < 2; ++n) acc[ai][bj][m][n] = mfma_f8(Bt[n][0], Bt[n][1], At[m][0], At[m][1], acc[ai][bj][m][n]); } \
        else { _Pragma("unroll") for (int m = 0; m < 4; ++m) _Pragma("unroll") for (int n = 0; n < 2; ++n) _Pragma("unroll") for (int k = 0; k < 2; ++k) \
        acc[ai][bj][m][n] = __builtin_amdgcn_mfma_f32_16x16x32_bf16(Bt[n][k], At[m][k], acc[ai][bj][m][n], 0, 0, 0); } __builtin_amdgcn_s_setprio(0); } while (0)
#define PG8_WAIT_V(n) asm volatile("s_waitcnt vmcnt(" #n ")" ::: "memory")
#define PG8_WAIT_L(n) asm volatile("s_waitcnt lgkmcnt(" #n ")" ::: "memory")
#define PG8_BAR __builtin_amdgcn_s_barrier()
#define PG8_SCHED __builtin_amdgcn_sched_barrier(0)
    Unit cur, nxt; int ui = 0;
    if (!S.next(0, cur)) return;
    f32x4 acc[2][2][4][2];
#pragma unroll
    for (int a = 0; a < 2; ++a)
#pragma unroll
        for (int b = 0; b < 2; ++b)
#pragma unroll
            for (int m = 0; m < 4; ++m)
#pragma unroll
                for (int n = 0; n < 2; ++n) acc[a][b][m][n] = (f32x4){0.f, 0.f, 0.f, 0.f};
    bf16x8 At[4][2], B0[2][2], B1[2][2];
    const char* cA = (const char*)(F8 ? g.A8 : g.A) + ((size_t)cur.pm * BM * g.lda + cur.k0) * 2; const char* cB = (const char*)g.Bt + ((size_t)(cur.pn * BM + (F8 ? cur.tag * HALF : 0)) * g.ldb + cur.k0) * 2;
    { const size_t o0 = (size_t)(cur.rot & (cur.nt - 1)) * kstep, o1 = (size_t)((cur.rot + 1) & (cur.nt - 1)) * kstep;
    if constexpr (SP2) {
        PG8_STAGE(PG8_SB(0, 0), cB + o0, voffB); PG8_STAGE(PG8_SB(0, 1), cB + hstepB + o0, voffB); PG8_STAGE(PG8_SA(0, 0), cA + o0, voffA); PG8_STAGE(PG8_SA(0, 1), cA + hstepA + o0, voffA);
        if (wr == 1) PG8_BAR;
        PG8_WAIT_V(2); PG8_BAR;
        PG8_STAGE(PG8_SB(1, 0), cB + o1, voffB); PG8_STAGE(PG8_SA(1, 0), cA + o1, voffA); PG8_STAGE(PG8_SB(1, 1), cB + hstepB + o1, voffB);
        PG8_WAIT_V(6); PG8_BAR;
    } else {
        PG8_STAGE(PG8_SB(0, 0), cB + o0, voffB); PG8_STAGE(PG8_SA(0, 0), cA + o0, voffA); PG8_STAGE(PG8_SB(0, 1), cB + hstepB + o0, voffB); PG8_STAGE(PG8_SA(0, 1), cA + hstepA + o0, voffA);
        if (wr == 1) PG8_BAR;
        PG8_WAIT_V(4); PG8_BAR;
        PG8_STAGE(PG8_SB(1, 0), cB + o1, voffB); PG8_STAGE(PG8_SA(1, 0), cA + o1, voffA); PG8_STAGE(PG8_SB(1, 1), cB + hstepB + o1, voffB);
        PG8_WAIT_V(6); PG8_BAR;
    } }
    for (;;) {
        const bool has_next = S.next(ui + 1, nxt);
        const char* nA = has_next ? (const char*)(F8 ? g.A8 : g.A) + ((size_t)nxt.pm * BM * g.lda + nxt.k0) * 2 : cA; const char* nB = has_next ? (const char*)g.Bt + ((size_t)(nxt.pn * BM + (F8 ? nxt.tag * HALF : 0)) * g.ldb + nxt.k0) * 2 : cB;
        const int nt = cur.nt, rot = cur.rot, msk = nt - 1;
        const size_t n0 = has_next ? (size_t)(nxt.rot & (nxt.nt - 1)) * kstep : (size_t)(rot & msk) * kstep, n1 = has_next ? (size_t)((nxt.rot + 1) & (nxt.nt - 1)) * kstep : (size_t)((rot + 1) & msk) * kstep;
#define PG8_BODY(F8SEG, LRS) { \
            constexpr bool lrskip = (LRS); (void)lrskip; \
            if constexpr (Epi::HAS_MID) { if (t == Epi::MID0 || t == Epi::MID1) E.mid(acc, cur, t, wr, wc, fr, fq); } \
            constexpr bool f8seg = (F8SEG); (void)f8seg; \
            const bool last = (t == nt - 2); \
            const size_t k1 = rot ? (size_t)((t + 1 + rot) & msk) * kstep : (size_t)(t + 1) * kstep, k2 = rot ? (size_t)((t + 2 + rot) & msk) * kstep : (size_t)(t + 2) * kstep, k3 = rot ? (size_t)((t + 3 + rot) & msk) * kstep : (size_t)(t + 3) * kstep; \
            const char* a1 = cA + k1; \
            const char* a2 = last ? nA + n0 : cA + k2; const char* b2 = last ? nB + n0 : cB + k2; \
            const char* a3 = last ? nA + n1 : cA + k3; const char* b3 = last ? nB + n1 : cB + k3; \
            if constexpr (SP2) { \
            PG8_LDB(B0, 0, 0); PG8_LDB(B1, 0, 1); PG8_SCHED; PG8_LDA(At, 0, 0); PG8_STAGE(PG8_SA(1, 1), a1 + hstepA, voffA); \
            PG8_WAIT_V(8); PG8_WAIT_L(0); PG8_BAR; PG8_MMA(0, 0, At, B0); PG8_MMA(0, 1, At, B1); PG8_BAR; PG8_SCHED; \
            PG8_LDA(At, 0, 1); PG8_STAGE(PG8_SB(0, 0), b2, voffB); PG8_STAGE(PG8_SB(0, 1), b2 + hstepB, voffB); PG8_STAGE(PG8_SA(0, 0), a2, voffA); \
            PG8_WAIT_V(8); PG8_WAIT_L(0); PG8_BAR; PG8_MMA(1, 0, At, B0); PG8_MMA(1, 1, At, B1); PG8_BAR; PG8_SCHED; \
            PG8_LDB(B0, 1, 0); PG8_LDB(B1, 1, 1); PG8_SCHED; PG8_LDA(At, 1, 0); PG8_STAGE(PG8_SA(0, 1), a2 + hstepA, voffA); \
            PG8_WAIT_V(8); PG8_WAIT_L(0); PG8_BAR; PG8_MMA(0, 0, At, B0); PG8_MMA(0, 1, At, B1); PG8_BAR; PG8_SCHED; \
            PG8_LDA(At, 1, 1); PG8_STAGE(PG8_SB(1, 0), b3, voffB); PG8_STAGE(PG8_SB(1, 1), b3 + hstepB, voffB); PG8_STAGE(PG8_SA(1, 0), a3, voffA); \
            PG8_WAIT_V(8); PG8_WAIT_L(0); PG8_BAR; PG8_MMA(1, 0, At, B0); PG8_MMA(1, 1, At, B1); PG8_BAR; PG8_SCHED; \
            } else { \
            PG8_LDB(B0, 0, 0); PG8_SCHED; PG8_LDA(At, 0, 0); PG8_STAGE(PG8_SA(1, 1), a1 + hstepA, voffA); \
            PG8_WAIT_L(8); PG8_BAR; PG8_WAIT_L(0); PG8_MMA(0, 0, At, B0); PG8_BAR; PG8_SCHED; \
            PG8_LDB(B1, 0, 1); PG8_STAGE(PG8_SB(0, 0), b2, voffB); \
            PG8_BAR; PG8_WAIT_L(0); PG8_MMA(0, 1, At, B1); PG8_BAR; \
            PG8_LDA(At, 0, 1); PG8_STAGE(PG8_SA(0, 0), a2, voffA); \
            PG8_BAR; PG8_WAIT_L(0); PG8_MMA(1, 0, At, B0); PG8_BAR; PG8_SCHED; \
            PG8_STAGE(PG8_SB(0, 1), b2 + hstepB, voffB); \
            PG8_WAIT_V(6); PG8_BAR; PG8_MMA(1, 1, At, B1); PG8_BAR; \
            PG8_LDB(B0, 1, 0); PG8_SCHED; PG8_LDA(At, 1, 0); PG8_STAGE(PG8_SA(0, 1), a2 + hstepA, voffA); \
            PG8_WAIT_L(8); PG8_BAR; PG8_WAIT_L(0); PG8_MMA(0, 0, At, B0); PG8_BAR; PG8_SCHED; \
            PG8_LDB(B1, 1, 1); PG8_STAGE(PG8_SB(1, 0), b3, voffB); \
            PG8_BAR; PG8_WAIT_L(0); PG8_MMA(0, 1, At, B1); PG8_BAR; \
            PG8_LDA(At, 1, 1); PG8_STAGE(PG8_SA(1, 0), a3, voffA); \
            PG8_BAR; PG8_WAIT_L(0); PG8_MMA(1, 0, At, B0); PG8_BAR; PG8_SCHED; \
            PG8_STAGE(PG8_SB(1, 1), b3 + hstepB, voffB); \
            PG8_WAIT_V(6); PG8_BAR; PG8_MMA(1, 1, At, B1); PG8_BAR; \
            } \
        }
        if constexpr (Epi::F8_FROM >= 0) {
            for (int t = 0; t < Epi::F8_FROM; t += 2) PG8_BODY(false, false)
            for (int t = Epi::F8_FROM; t < nt; t += 2) PG8_BODY(true, false)
        } else if constexpr (Epi::LR_PN >= 0) {
            if (cur.pn == Epi::LR_PN) { for (int t = 0; t < nt; t += 2) PG8_BODY(false, true) }
            else { for (int t = 0; t < nt; t += 2) PG8_BODY(false, false) }
        } else {
            for (int t = 0; t < nt; t += 2) PG8_BODY(false, false)
        }
#undef PG8_BODY
        if constexpr (ALIGN_EPI) { if (wr == 0) PG8_BAR; }
        E(acc, cur, wr, wc, fr, fq);
        if (!has_next) break;
#pragma unroll
        for (int a = 0; a < 2; ++a)
#pragma unroll
            for (int b = 0; b < 2; ++b)
#pragma unroll
                for (int m = 0; m < 4; ++m)
#pragma unroll
                    for (int n = 0; n < 2; ++n) acc[a][b][m][n] = (f32x4){0.f, 0.f, 0.f, 0.f};
        cur = nxt; cA = nA; cB = nB; ++ui;
        if constexpr (ALIGN_EPI) { if (wr == 1) PG8_BAR; }
    }
    PG8_WAIT_V(0);
    if constexpr (!ALIGN_EPI) { if (wr == 0) PG8_BAR; }
    PG8_BAR;
#undef PG8_SA
#undef PG8_SB
#undef PG8_STAGE
#undef PG8_LDA
#undef PG8_LDB
#undef PG8_MMA
#undef PG8_WAIT_V
#undef PG8_WAIT_L
#undef PG8_BAR
#undef PG8_SCHED
}
}
using pg8::lane_id_v;

constexpr int NWAVES = 8;
constexpr int T = 32768, TP = 16384;
constexpr int D = 4096, NIN = 24096, DEPTH = 2;
constexpr int HP = 11776;
constexpr int NBROWS = 24320;
constexpr int C_AQ = 0, C_AK = 768, C_AV = 1536, C_AG = 3072, C_BU = 4608, C_BV = 5632, C_BG = 6656, C_CQ = 7680, C_CK = 9216, C_CV = 9728, C_CG = 10240, C_GM = 11776, C_LR = 24064;
constexpr int O_A = 0, O_B = 1536, O_C = 2560;
constexpr int F8_LO = 30, F8_N = F8_TILES, F8_HI = F8_LO + F8_N;
constexpr int N_PHASES = 17;
constexpr int N_LAUNCHES = MK_N_LAUNCHES;

constexpr size_t MiB = 1u << 20;
constexpr size_t WS_CTL = 0, CTL_ZERO_BYTES = 1 * MiB;
constexpr size_t WS_ROPE = 1 * MiB;
constexpr size_t WS_WIN = 3 * MiB, WIN_BYTES = (size_t)NBROWS * D * 2;
constexpr size_t WS_WBR = WS_WIN + 2 * 190 * MiB, WSQ_BYTES = (size_t)D * D * 2;
constexpr size_t WS_WOUT = WS_WBR + 64 * MiB;
constexpr size_t WS_XN = WS_WOUT + 64 * MiB;
constexpr size_t WS_H = WS_XN + 256 * MiB;
constexpr size_t WS_G = WS_H + 736 * MiB;
constexpr size_t WS_ST = WS_G + 768 * MiB;
constexpr size_t WS_MG = WS_ST + 384 * MiB;
constexpr size_t WS_LR = WS_MG + 256 * MiB;
constexpr size_t WS_DECC = WS_LR + 8 * MiB;
constexpr size_t WS_END = WS_DECC + 4 * MiB;
static_assert(WIN_BYTES <= 190 * MiB && (size_t)T * HP * 2 <= 736 * MiB && (size_t)T * 12288 * 2 <= 768 * MiB, "ws map");
__device__ __forceinline__ size_t gate_off(int b, int pm, int ct, int ai, int m, int bj, int wr, int wc, int fr, int fq) {
    return ((((size_t)(b * 128 + pm) * 16 + ct) * 16 + (size_t)((ai * 4 + m) * 2 + bj)) * 512 + (size_t)(((wr * 4 + wc) * 4 + fq) * 16 + fr)) * 16; }
constexpr int CW_TMO = 0, CW_CODE = 1;
constexpr int CW_BAR = 4096;

constexpr int RING_OFF = 0, RING_BYTES = 131072;
constexpr int LDSCTL_OFF = RING_BYTES, MISC_OFF = LDSCTL_OFF + 320;
constexpr int LDS_BYTES = 147456;

#define GAS __attribute__((address_space(1)))
#define LAS __attribute__((address_space(3)))
typedef unsigned short bf16;
typedef unsigned v4u __attribute__((ext_vector_type(4)));
typedef unsigned v2u __attribute__((ext_vector_type(2)));
typedef float f32x4 __attribute__((ext_vector_type(4)));
typedef GAS unsigned gu32;
#define RLX_AGENT __ATOMIC_RELAXED, __HIP_MEMORY_SCOPE_AGENT
#define LDS_WAIT() asm volatile("s_waitcnt lgkmcnt(0)" ::: "memory")
#define VM_WAIT() asm volatile("s_waitcnt vmcnt(0)" ::: "memory")
__device__ __forceinline__ unsigned f2bf(float f) { unsigned u = __builtin_bit_cast(unsigned, f); return (u + 0x7fffu + ((u >> 16) & 1u)) >> 16; }
__device__ __forceinline__ unsigned pk2(float lo, float hi) { return pg8::cvt_pk_bf16(lo, hi); }
__device__ __forceinline__ float bflo(unsigned w) { return __uint_as_float(w << 16); }
__device__ __forceinline__ float bfhi(unsigned w) { return __uint_as_float(w & 0xffff0000u); }
__device__ __forceinline__ float bf1(bf16 v) { return __uint_as_float((unsigned)v << 16); }
__device__ __forceinline__ void unpack8(const v4u w, float* x) { x[0] = bflo(w.x); x[1] = bfhi(w.x); x[2] = bflo(w.y); x[3] = bfhi(w.y); x[4] = bflo(w.z); x[5] = bfhi(w.z); x[6] = bflo(w.w); x[7] = bfhi(w.w); }
typedef _Float16 h16x4 __attribute__((ext_vector_type(4)));
__device__ __forceinline__ f32x4 h4(v2u w) { return __builtin_convertvector(__builtin_bit_cast(h16x4, w), f32x4); }
__device__ __forceinline__ f32x4 h4q(v4u w, int hi) { v2u t; t.x = hi ? w.z : w.x; t.y = hi ? w.w : w.y; return h4(t); }
__device__ __forceinline__ float sigm(float x) { return __builtin_amdgcn_rcpf(1.0f + __builtin_amdgcn_exp2f(-1.44269504089f * x)); }

#define XB_TMO      128
#define XB_XCNT(j)  (256  + 64 * (j))
#define XB_XSUB(j)  (1280 + 64 * (j))
#define XB_XGEN(j)  (2304 + 64 * (j))
#define XB_TOP      3328
#define XB_TOPGEN   3392
#define XCD_BAR_WORDS 3456
#define XB_SPIN_CAP (1u << 24)
__device__ __forceinline__ unsigned xb_ld(unsigned* p)              { return __hip_atomic_load(p, __ATOMIC_RELAXED, __HIP_MEMORY_SCOPE_AGENT); }
__device__ __forceinline__ unsigned xb_add(unsigned* p, unsigned v) { return __hip_atomic_fetch_add(p, v, __ATOMIC_RELAXED, __HIP_MEMORY_SCOPE_AGENT); }
__device__ __forceinline__ unsigned xb_xcc_id() { return (unsigned)__builtin_amdgcn_s_getreg((3 << 11) | 20) & 0xFu; }
#define XB_SPIN(cond, bar) do { unsigned _sp = 0; while (cond) { __builtin_amdgcn_s_sleep(1); \
    if ((++_sp & 255u) == 0u) { if (xb_ld(&(bar)[XB_TMO])) break; if (_sp > XB_SPIN_CAP) { atomicAdd(&(bar)[XB_TMO], 1u); break; } } } } while (0)
struct XcdBarrier { unsigned* bar; unsigned x; volatile LAS unsigned* st; int wv; };
__device__ __forceinline__ XcdBarrier xcd_barrier_post(unsigned* bar, volatile LAS unsigned* st, int wv) {
    XcdBarrier b; b.bar = bar; b.x = xb_xcc_id(); b.st = st; b.wv = wv;
    if (threadIdx.x == 0) (void)xb_add(&bar[XB_XCNT(b.x)], 1u);
    return b;
}
__device__ __forceinline__ void xcd_barrier_complete(unsigned* bar, unsigned x, unsigned& nloc, unsigned& nx) {
    const unsigned G = gridDim.x * gridDim.y * gridDim.z;
    unsigned sum, cnt, mine, sp = 0u;
    for (;;) {
        sum = 0u; cnt = 0u; mine = 0u;
#pragma unroll
        for (unsigned j = 0; j < 16; ++j) { const unsigned c = xb_ld(&bar[XB_XCNT(j)]); sum += c; cnt += (c > 0u) ? 1u : 0u; mine = (j == x) ? c : mine; }
        if (sum == G) break;
        __builtin_amdgcn_s_sleep(1);
        if ((++sp & 255u) == 0u) { if (xb_ld(&bar[XB_TMO])) break; if (sp > XB_SPIN_CAP) { atomicAdd(&bar[XB_TMO], 1u); break; } }
    }
    nloc = mine > 0u ? mine : 1u; nx = cnt > 0u ? cnt : 1u;
}
__device__ __forceinline__ void xcd_barrier(const XcdBarrier& b) {
    asm volatile("s_waitcnt vmcnt(0)" ::: "memory");
    __syncthreads();
    if (((b.wv << 6) + lane_id_v()) == 0) {
        unsigned* bar = b.bar; asm volatile("" : "+s"(bar));
        __builtin_amdgcn_s_waitcnt(0);
        unsigned nloc = b.st[0], nx = b.st[1];
        if (nloc == 0u) { xcd_barrier_complete(bar, b.x, nloc, nx); b.st[0] = nloc; b.st[1] = nx; }
        const unsigned old = xb_add(&bar[XB_XSUB(b.x)], 1u);
        const unsigned gen = old / nloc;
        if (old + 1u == (gen + 1u) * nloc) {
            __builtin_amdgcn_fence(__ATOMIC_RELEASE, "agent");
            asm volatile("s_waitcnt vmcnt(0)" ::: "memory");
            const unsigned og = xb_add(&bar[XB_TOP], 1u);
            const unsigned tg = og / nx;
            if (og + 1u == (tg + 1u) * nx) xb_add(&bar[XB_TOPGEN], 1u);
            else XB_SPIN(xb_ld(&bar[XB_TOPGEN]) == tg, bar);
            __builtin_amdgcn_fence(__ATOMIC_ACQUIRE, "agent");
            xb_add(&bar[XB_XGEN(b.x)], 1u);
            asm volatile("s_waitcnt vmcnt(0)" ::: "memory");
        } else {
            XB_SPIN(xb_ld(&bar[XB_XGEN(b.x)]) == gen, bar);
            __builtin_amdgcn_fence(__ATOMIC_ACQUIRE, "agent");
            asm volatile("s_waitcnt vmcnt(0)" ::: "memory");
        }
    }
    __syncthreads();
}

struct Args { const float* in[17]; float* out; unsigned char* ws; int ph_lo, ph_hi; };
struct Frame {
    LAS unsigned char* lds;
    int vcu, G, wv;
};
#define PHASE_IDS() int tid_ = (F.wv << 6) + lane_id_v(); asm volatile("" : "+v"(tid_)); const int tid = tid_, lane = tid & 63, wave = __builtin_amdgcn_readfirstlane(tid >> 6); (void)tid; (void)lane; (void)wave
template <int M> __device__ __forceinline__ float shx(float v) { return __builtin_bit_cast(float, __builtin_amdgcn_ds_swizzle(__builtin_bit_cast(int, v), (M << 10) | 0x1f)); }
__device__ __forceinline__ int lane32x() { return (lane_id_v() ^ 32) << 2; }
__device__ __forceinline__ float xch32(float v, bool) { return __builtin_bit_cast(float, __builtin_amdgcn_ds_bpermute(lane32x(), __builtin_bit_cast(int, v))); }
__device__ __forceinline__ float sum32(float v) { return v + xch32(v, false); }
__device__ __forceinline__ float max32(float v) { return fmaxf(v, xch32(v, false)); }
__device__ __forceinline__ float wave_sum(float v) { v += shx<1>(v); v += shx<2>(v); v += shx<4>(v); v += shx<8>(v); v += shx<16>(v); return sum32(v); }
__device__ __forceinline__ float wave_max(float v) { v = fmaxf(v, shx<1>(v)); v = fmaxf(v, shx<2>(v)); v = fmaxf(v, shx<4>(v)); v = fmaxf(v, shx<8>(v)); v = fmaxf(v, shx<16>(v)); return max32(v); }

struct CvtItem { const float* W; const float* kgain; bf16* WT; int Nsrc, nsrc0, ndst0, k0, f8, kd; };
__device__ __forceinline__ CvtItem cvt_decode(const Args& a, int it) {
    constexpr int I_IN = 64 * (NBROWS / 32), I_SQ = 64 * (D / 32), I_L = I_IN + 2 * I_SQ;
    CvtItem c; const int l = it / I_L; int r = it - l * I_L;
    if (r < I_IN) { const int nb = r % (NBROWS / 32), kb = r / (NBROWS / 32), nm = nb * 32;
        c.W = a.in[3] + (size_t)l * D * NIN; c.Nsrc = NIN; c.nsrc0 = nm < 3072 ? nm : (nm < C_LR ? nm + 32 : (nm < C_LR + 32 ? 3072 + (nm - C_LR) : -1));
        c.kgain = a.in[2] + l * D; c.WT = (bf16*)(a.ws + WS_WIN + l * (190 * MiB)); c.ndst0 = nm; c.k0 = kb * 64; c.kd = c.k0; c.f8 = (FP8_ATT && nm >= F8_LO * 256 && nm < F8_HI * 256) ? 1 : 0; return c; }
    r -= I_IN; const bool br = r < I_SQ; if (!br) r -= I_SQ;
    const int nb = r % (D / 32), kb = r / (D / 32);
    c.W = a.in[br ? 15 : 16] + (size_t)l * D * D; c.Nsrc = D; c.nsrc0 = nb * 32; c.kgain = nullptr; c.WT = (bf16*)(a.ws + (br ? WS_WBR : WS_WOUT) + l * (32 * MiB)); c.ndst0 = nb * 32; c.k0 = kb * 64; c.kd = c.k0; c.f8 = 0;
    if (F8_OC && br && c.k0 >= 2560) { c.f8 = 1; c.kd = 5120 + (c.k0 - 2560); }
    return c;
}
__device__ __forceinline__ void cvt_load(const CvtItem& c, int lane, f32x4 (&v)[8]) {
    const int kr = lane >> 3, nq = (lane & 7) * 4;
#pragma unroll
    for (int i = 0; i < 8; ++i) { v[i] = (f32x4){0.f, 0.f, 0.f, 0.f};
        if (c.nsrc0 >= 0) { v[i] = *(const f32x4*)(c.W + (size_t)(c.k0 + kr + 8 * i) * c.Nsrc + c.nsrc0 + nq); if (c.kgain) v[i] = v[i] * c.kgain[c.k0 + kr + 8 * i]; } }
}
__device__ __forceinline__ void cvt_store(const CvtItem& c, int lane, const f32x4 (&v)[8], LAS float* scr) {
    const int kr = lane >> 3, nq = (lane & 7) * 4;
#pragma unroll
    for (int i = 0; i < 8; ++i) { LAS float* d = scr + (kr + 8 * i) * 33 + nq; d[0] = v[i].x; d[1] = v[i].y; d[2] = v[i].z; d[3] = v[i].w; }
    LDS_WAIT(); asm volatile("" ::: "memory");
    const int cc = lane & 7;
#pragma unroll
    for (int j = 0; j < 4; ++j) { const int n = (lane >> 3) + 8 * j; const LAS float* s = scr + (8 * cc) * 33 + n;
        if (c.f8) {
            int w0 = 0, w1 = 0;
#define F8C(x) __builtin_amdgcn_fmed3f(64.f * (x), -448.f, 448.f)
            w0 = __builtin_amdgcn_cvt_pk_fp8_f32(F8C(s[0 * 33]), F8C(s[1 * 33]), w0, false); w0 = __builtin_amdgcn_cvt_pk_fp8_f32(F8C(s[2 * 33]), F8C(s[3 * 33]), w0, true);
            w1 = __builtin_amdgcn_cvt_pk_fp8_f32(F8C(s[4 * 33]), F8C(s[5 * 33]), w1, false); w1 = __builtin_amdgcn_cvt_pk_fp8_f32(F8C(s[6 * 33]), F8C(s[7 * 33]), w1, true);
#undef F8C
            v2u o2; o2.x = (unsigned)w0; o2.y = (unsigned)w1;
            *(GAS v2u*)((GAS unsigned char*)c.WT + (size_t)(c.ndst0 + n) * 8192 + c.kd + 8 * cc) = o2;
        } else {
        v4u o; o.x = pk2(s[0 * 33], s[1 * 33]); o.y = pk2(s[2 * 33], s[3 * 33]); o.z = pk2(s[4 * 33], s[5 * 33]); o.w = pk2(s[6 * 33], s[7 * 33]);
        *(GAS v4u*)(c.WT + (size_t)(c.ndst0 + n) * D + c.kd + 8 * cc) = o; } }
    LDS_WAIT(); asm volatile("" ::: "memory");
}
__device__ __forceinline__ void phase_convert(Frame& F, const Args& a) {
    PHASE_IDS();
    LAS float* scr = (LAS float*)(F.lds + RING_OFF + wave * 16384);
    const int gw = F.vcu * NWAVES + wave, NGW = F.G * NWAVES;
    constexpr int I_IN = 64 * (NBROWS / 32), I_SQ = 64 * (D / 32), I_L = I_IN + 2 * I_SQ, NIT = DEPTH * I_L;
    if (gw < NIT) {
        CvtItem cur = cvt_decode(a, gw); f32x4 v[8]; cvt_load(cur, lane, v);
        for (int it = gw; it < NIT; it += NGW) {
            const int itn = it + NGW; CvtItem nxt = cur; f32x4 vn[8];
            if (itn < NIT) { nxt = cvt_decode(a, itn); cvt_load(nxt, lane, vn); }
            cvt_store(cur, lane, v, scr);
            cur = nxt;
#pragma unroll
            for (int i = 0; i < 8; ++i) v[i] = vn[i];
        }
    }
    float2* rt = (float2*)(a.ws + WS_ROPE);
    for (int e = (F.vcu * NWAVES + wave) * 64 + lane; e < 16384 * 16; e += F.G * NWAVES * 64) {
        const int pos = e >> 4, i = e & 15;
        const float inv = (float)pow(500000.0, -(double)(2 * i) / 32.0);
        const float ang = (float)pos * inv;
        double sn, cs; sincos((double)ang, &sn, &cs);
        rt[e] = make_float2((float)cs, (float)sn);
    }
}

__device__ __forceinline__ void phase_rmsnorm(Frame& F, const Args& a, int layer) {
    PHASE_IDS();
    const int gw = F.vcu * NWAVES + wave, NGW = F.G * NWAVES;
    bf16* XN = (bf16*)(a.ws + WS_XN);
    for (int m = gw; m < T; m += NGW) {
        const float* xrow = layer == 0 ? (m < TP ? a.in[0] + (size_t)m * D : a.in[1] + (size_t)(m - TP) * D) : a.out + (size_t)m * D;
        const GAS f32x4* xr = (const GAS f32x4*)xrow + lane;
        f32x4 v[16]; float s = 0.f;
#pragma unroll
        for (int j = 0; j < 16; ++j) { v[j] = xr[64 * j]; s += (v[j].x * v[j].x + v[j].y * v[j].y) + (v[j].z * v[j].z + v[j].w * v[j].w); }
        const float rstd = 1.0f / sqrtf(wave_sum(s) * (1.f / D) + 1e-6f);
        GAS v2u* o8 = (GAS v2u*)(XN + (size_t)m * D) + lane;
#pragma unroll
        for (int j = 0; j < 16; ++j) { v2u w; w.x = pk2(v[j].x * rstd, v[j].y * rstd); w.y = pk2(v[j].z * rstd, v[j].w * rstd); o8[64 * j] = w; }
#if FP8_ATT
        GAS unsigned* f8p = (GAS unsigned*)(a.ws + WS_MG + (size_t)m * 8192) + lane;
#pragma unroll
        for (int j = 0; j < 16; ++j) { int w = 0; w = __builtin_amdgcn_cvt_pk_fp8_f32(v[j].x * rstd, v[j].y * rstd, w, false); w = __builtin_amdgcn_cvt_pk_fp8_f32(v[j].z * rstd, v[j].w * rstd, w, true); f8p[64 * j] = (unsigned)w; }
#endif
    }
}

struct Sched1 {
    int c, G;
    __device__ __forceinline__ bool next(int i, pg8::Unit& u) const {
        constexpr int NT = FP8_ATT ? 94 - F8_N : 94;
        const bool hf = (c & 1) && G == 256;
        u.rot = 0;
        if (hf) { if (i == 0) { u.pm = c >> 1; u.pn = 94; u.k0 = 2048; u.nt = 32; u.tag = 1; return true; } i -= 1; }
        long L = (long)i * G + c;
        if (L < 128 * NT) { pg8::static_tile((int)L, 128, NT, u.pm, u.pn); if (FP8_ATT && u.pn >= F8_LO) u.pn += F8_N; u.k0 = 0; u.nt = 64; u.tag = 0; u.rot = KROT * (c & 7); return true; }
        if (hf) return false;
        L -= 128 * NT;
        if (G == 256) { if (L < 256 && !(L & 1)) { u.pm = (int)(L >> 1); u.pn = 94; u.k0 = 0; u.nt = 32; u.tag = 0; return true; } return false; }
        if (L < 256) { u.pm = (int)(L >> 1); u.pn = 94; u.k0 = (int)(L & 1) * 2048; u.nt = 32; u.tag = (int)(L & 1); return true; }
        return false;
    }
};
struct Sched1F8 {
    int c, G;
    __device__ __forceinline__ bool next(int i, pg8::Unit& u) const {
        const long L = (long)i * G + c; if (L >= 128 * F8_N) return false;
        pg8::static_tile((int)L, 128, F8_N, u.pm, u.pn); u.pn += F8_LO; u.k0 = 0; u.nt = 32; u.tag = 0; u.rot = 0; return true;
    }
};
struct Sched2 {
    int c, G;
    __device__ __forceinline__ bool next(int i, pg8::Unit& u) const {
        const long L = (long)i * G + c; if (L >= 128 * 16) return false;
        pg8::static_tile((int)L, 128, 16, u.pm, u.pn); u.k0 = 0; u.nt = F8_OC ? 52 : 64; u.tag = 0; u.rot = 0; return true;
    }
};
struct Sched3 {
    int c, G;
    __device__ __forceinline__ bool next(int i, pg8::Unit& u) const {
        const long L = (long)i * G + c; if (L >= 128 * 16) return false;
        pg8::static_tile((int)L, 128, 16, u.pm, u.pn); u.k0 = 0; u.nt = 64; u.tag = 0; u.rot = KROT * (c & 7); return true;
    }
};
struct Epi1 {
    static constexpr bool PERM = true, HAS_MID = false; static constexpr int MID0 = -1, MID1 = -1, F8_FROM = -1, LR_PN = 94;
    bf16* H; float* LR; const float* gbias; unsigned char* G;
    __device__ __forceinline__ void operator()(const f32x4 (&acc)[2][2][4][2], const pg8::Unit& u, int wr, int wc, int fr, int fq) const {
        using namespace pg8;
        const int row0 = u.pm * BM + wr * 64 + fr;
        if (u.pn == 94) {
            if (wc == 0) { float* base = LR + (size_t)u.tag * T * 32 + 8 * fq;
#pragma unroll
                for (int ai = 0; ai < 2; ++ai)
#pragma unroll
                    for (int m = 0; m < 4; ++m) { float* rp = base + (size_t)(row0 + ai * HALF + m * 16) * 32;
                        *(f32x4*)rp = acc[ai][0][m][0]; *(f32x4*)(rp + 4) = acc[ai][0][m][1]; } }
            return;
        }
        const int pn = u.pn;
        const int act = pn < 12 ? 0 : (pn < 18 ? 1 : (pn < 26 ? 2 : (pn < 30 ? 1 : (pn < 40 ? 0 : (pn < 46 ? 1 : 3)))));
        const int col0 = pn * BM + wc * 32 + 8 * fq;
        if (act == 0) {
#pragma unroll
            for (int ai = 0; ai < 2; ++ai)
#pragma unroll
                for (int m = 0; m < 4; ++m) { bf16* rowp = H + (size_t)(row0 + ai * HALF + m * 16) * HP + col0;
#pragma unroll
                    for (int bj = 0; bj < 2; ++bj) { const f32x4 v0 = acc[ai][bj][m][0], v1 = acc[ai][bj][m][1];
                        u32x4 w; w.x = cvt_pk_bf16(v0[0], v0[1]); w.y = cvt_pk_bf16(v0[2], v0[3]); w.z = cvt_pk_bf16(v1[0], v1[1]); w.w = cvt_pk_bf16(v1[2], v1[3]);
                        __builtin_nontemporal_store(w, (u32x4*)(rowp + bj * HALF)); } }
            return;
        }
        if (act == 3) {
            f32x4 bv[2][2];
#pragma unroll
            for (int bj = 0; bj < 2; ++bj)
#pragma unroll
                for (int n = 0; n < 2; ++n) bv[bj][n] = *(const f32x4*)(gbias + (pn - 46) * BM + wc * 32 + 8 * fq + bj * HALF + 4 * n);
            const int gb = (pn - 46) >> 4, gct = (pn - 46) & 15;
#pragma unroll
            for (int ai = 0; ai < 2; ++ai)
#pragma unroll
                for (int m = 0; m < 4; ++m) {
#pragma unroll
                    for (int bj = 0; bj < 2; ++bj) { float x[8];
#pragma unroll
                        for (int j = 0; j < 4; ++j) { x[j] = sigm(acc[ai][bj][m][0][j] + bv[bj][0][j]); x[4 + j] = sigm(acc[ai][bj][m][1][j] + bv[bj][1][j]); }
                        u32x4 w; w.x = cvt_pk_bf16(x[0], x[1]); w.y = cvt_pk_bf16(x[2], x[3]); w.z = cvt_pk_bf16(x[4], x[5]); w.w = cvt_pk_bf16(x[6], x[7]);
                        __builtin_nontemporal_store(w, (u32x4*)(G + gate_off(gb, u.pm, gct, ai, m, bj, wr, wc, fr, fq))); } }
        } else if (act == 1) {
#pragma unroll
            for (int ai = 0; ai < 2; ++ai)
#pragma unroll
                for (int m = 0; m < 4; ++m) { bf16* rowp = H + (size_t)(row0 + ai * HALF + m * 16) * HP + col0;
#pragma unroll
                    for (int bj = 0; bj < 2; ++bj) { float x[8];
#pragma unroll
                        for (int j = 0; j < 4; ++j) { const float a0 = acc[ai][bj][m][0][j], a1 = acc[ai][bj][m][1][j]; x[j] = a0 * sigm(a0); x[4 + j] = a1 * sigm(a1); }
                        u32x4 w; w.x = cvt_pk_bf16(x[0], x[1]); w.y = cvt_pk_bf16(x[2], x[3]); w.z = cvt_pk_bf16(x[4], x[5]); w.w = cvt_pk_bf16(x[6], x[7]);
                        __builtin_nontemporal_store(w, (u32x4*)(rowp + bj * HALF)); } }
        } else {
#pragma unroll
            for (int ai = 0; ai < 2; ++ai)
#pragma unroll
                for (int m = 0; m < 4; ++m) { bf16* rowp = H + (size_t)(row0 + ai * HALF + m * 16) * HP + col0;
#pragma unroll
                    for (int bj = 0; bj < 2; ++bj) { float x[8];
#pragma unroll
                        for (int j = 0; j < 4; ++j) { const float a0 = acc[ai][bj][m][0][j], a1 = acc[ai][bj][m][1][j];
                            x[j] = a0 * sigm(1.5957691216f * (a0 + 0.044715f * a0 * a0 * a0)); x[4 + j] = a1 * sigm(1.5957691216f * (a1 + 0.044715f * a1 * a1 * a1)); }
                        u32x4 w; w.x = cvt_pk_bf16(x[0], x[1]); w.y = cvt_pk_bf16(x[2], x[3]); w.z = cvt_pk_bf16(x[4], x[5]); w.w = cvt_pk_bf16(x[6], x[7]);
                        __builtin_nontemporal_store(w, (u32x4*)(rowp + bj * HALF)); } }
        }
    }
};
struct Epi1F8 {
    static constexpr bool PERM = true, HAS_MID = false; static constexpr int MID0 = -1, MID1 = -1, F8_FROM = -1, LR_PN = -1;
    bf16* H; const float* gbias; unsigned char* G;
    __device__ __forceinline__ void operator()(const f32x4 (&acc)[2][2][4][2], const pg8::Unit& u, int wr, int wc, int fr, int fq) const {
        using namespace pg8;
        { const int l = lane_id_v(); fr = l & 15; fq = l >> 4; }
        if (u.pn >= 46) {
            const int pn = u.pn; f32x4 bv[2][2];
#pragma unroll
            for (int bj = 0; bj < 2; ++bj)
#pragma unroll
                for (int n = 0; n < 2; ++n) bv[bj][n] = -1.44269504089f * *(const f32x4*)(gbias + (pn - 46) * BM + wc * 32 + 8 * fq + bj * HALF + 4 * n);
            const int gb = (pn - 46) >> 4, gct = (pn - 46) & 15;
            constexpr float KS = -1.44269504089f * 0.015625f;
#pragma unroll
            for (int ai = 0; ai < 2; ++ai)
#pragma unroll
                for (int m = 0; m < 4; ++m) {
#pragma unroll
                    for (int bj = 0; bj < 2; ++bj) { float x[8];
#pragma unroll
                        for (int j = 0; j < 4; ++j) { x[j] = __builtin_amdgcn_rcpf(1.0f + __builtin_amdgcn_exp2f(acc[ai][bj][m][0][j] * KS + bv[bj][0][j])); x[4 + j] = __builtin_amdgcn_rcpf(1.0f + __builtin_amdgcn_exp2f(acc[ai][bj][m][1][j] * KS + bv[bj][1][j])); }
                        u32x4 w; w.x = cvt_pk_bf16(x[0], x[1]); w.y = cvt_pk_bf16(x[2], x[3]); w.z = cvt_pk_bf16(x[4], x[5]); w.w = cvt_pk_bf16(x[6], x[7]);
                        __builtin_nontemporal_store(w, (u32x4*)(G + gate_off(gb, u.pm, gct, ai, m, bj, wr, wc, fr, fq))); } }
            return;
        }
        const int row0 = u.pm * BM + wr * 64 + fr, col0 = u.pn * BM + u.tag * HALF + wc * 32 + 8 * fq; const bool gate = u.pn >= 40;
#pragma unroll
        for (int ai = 0; ai < 2; ++ai)
#pragma unroll
            for (int m = 0; m < 4; ++m)
#pragma unroll
              for (int bj = 0; bj < 2; ++bj) { float x[8];
#pragma unroll
                for (int j = 0; j < 4; ++j) { x[j] = acc[ai][bj][m][0][j] * 0.015625f; x[4 + j] = acc[ai][bj][m][1][j] * 0.015625f; }
                if (gate) {
#pragma unroll
                    for (int j = 0; j < 8; ++j) x[j] = x[j] * sigm(x[j]); }
                u32x4 w; w.x = cvt_pk_bf16(x[0], x[1]); w.y = cvt_pk_bf16(x[2], x[3]); w.z = cvt_pk_bf16(x[4], x[5]); w.w = cvt_pk_bf16(x[6], x[7]);
                __builtin_nontemporal_store(w, (u32x4*)(H + (size_t)(row0 + ai * HALF + m * 16) * HP + col0 + bj * HALF)); }
    }
};
struct Epi2 {
    static constexpr bool PERM = true, HAS_MID = true; static constexpr int MID0 = 24, MID1 = 40, F8_FROM = F8_OC ? 40 : -1, LR_PN = -1;
    const unsigned char* G; bf16* MG;
    __device__ __forceinline__ void mid(f32x4 (&acc)[2][2][4][2], const pg8::Unit& u, int t, int wr, int wc, int fr, int fq) const {
        using namespace pg8;
        { const int l = lane_id_v(); fr = l & 15; fq = l >> 4; }
        const int row0 = u.pm * BM + wr * 64 + fr, col0 = u.pn * BM + wc * 32 + 8 * fq, b = t == MID0 ? 0 : 1;
        const float sc = (F8_OC && b == 1) ? 512.f : 1.f;
#pragma unroll
        for (int ai = 0; ai < 2; ++ai) {
            u32x4 ga[4][2], gb[4][2];
#pragma unroll
            for (int m = 0; m < 4; ++m) {
#pragma unroll
                for (int bj = 0; bj < 2; ++bj) { ga[m][bj] = *(const u32x4*)(G + gate_off(b, u.pm, u.pn, ai, m, bj, wr, wc, fr, fq)); gb[m][bj] = *(const u32x4*)(G + gate_off(b + 1, u.pm, u.pn, ai, m, bj, wr, wc, fr, fq)); } }
#pragma unroll
            for (int m = 0; m < 4; ++m)
#pragma unroll
                for (int bj = 0; bj < 2; ++bj) { float xa[8], xb[8]; unpack8(ga[m][bj], xa); unpack8(gb[m][bj], xb);
#pragma unroll
                    for (int j = 0; j < 4; ++j) { acc[ai][bj][m][0][j] *= xa[j] * __builtin_amdgcn_rcpf(xb[j]) * sc; acc[ai][bj][m][1][j] *= xa[4 + j] * __builtin_amdgcn_rcpf(xb[4 + j]) * sc; } }
        }
    }
    __device__ __forceinline__ void operator()(const f32x4 (&acc)[2][2][4][2], const pg8::Unit& u, int wr, int wc, int fr, int fq) const {
        using namespace pg8;
        { const int l = lane_id_v(); fr = l & 15; fq = l >> 4; }
        const int row0 = u.pm * BM + wr * 64 + fr, col0 = u.pn * BM + wc * 32 + 8 * fq;
#pragma unroll
        for (int ai = 0; ai < 2; ++ai)
#pragma unroll
            for (int m = 0; m < 4; ++m) { const size_t row = (size_t)(row0 + ai * HALF + m * 16);
                bf16* mp = MG + row * D + col0;
#pragma unroll
                for (int bj = 0; bj < 2; ++bj) { const u32x4 gw = *(const u32x4*)(G + gate_off(2, u.pm, u.pn, ai, m, bj, wr, wc, fr, fq));
                    float g[8]; unpack8(gw, g);
                    if (F8_OC) {
#pragma unroll
                        for (int j = 0; j < 8; ++j) g[j] *= (1.f / 512.f); }
                    u32x4 w; w.x = cvt_pk_bf16(acc[ai][bj][m][0][0] * g[0], acc[ai][bj][m][0][1] * g[1]); w.y = cvt_pk_bf16(acc[ai][bj][m][0][2] * g[2], acc[ai][bj][m][0][3] * g[3]);
                    w.z = cvt_pk_bf16(acc[ai][bj][m][1][0] * g[4], acc[ai][bj][m][1][1] * g[5]); w.w = cvt_pk_bf16(acc[ai][bj][m][1][2] * g[6], acc[ai][bj][m][1][3] * g[7]);
                    *(u32x4*)(mp + bj * HALF) = w; } }
    }
};
struct Epi3 {
    static constexpr bool PERM = false, HAS_MID = false; static constexpr int MID0 = -1, MID1 = -1, F8_FROM = -1, LR_PN = -1;
    const float* xp; const float* xs; float* out; int layer;
    __device__ __forceinline__ void operator()(const f32x4 (&acc)[2][2][4][2], const pg8::Unit& u, int wr, int wc, int fr, int fq) const {
        using namespace pg8;
        const int row0 = u.pm * BM + wr * 64 + fr, col0 = u.pn * BM + wc * 32 + 4 * fq;
#pragma unroll
        for (int ai = 0; ai < 2; ++ai)
#pragma unroll
            for (int m = 0; m < 4; ++m) { const int row = row0 + ai * HALF + m * 16;
                const float* xr = (layer == 0 ? (row < TP ? xp + (size_t)row * D : xs + (size_t)(row - TP) * D) : out + (size_t)row * D) + col0;
                float* op = out + (size_t)row * D + col0;
#pragma unroll
                for (int bj = 0; bj < 2; ++bj)
#pragma unroll
                    for (int n = 0; n < 2; ++n) { const f32x4 xv = *(const f32x4*)(xr + bj * HALF + n * 16); __builtin_nontemporal_store(xv + acc[ai][bj][m][n], (f32x4*)(op + bj * HALF + n * 16)); } }
    }
};

__device__ __forceinline__ void phase_prep(Frame& F, const Args& a, int layer) {
    PHASE_IDS();
    const int gw = F.vcu * NWAVES + wave, NGW = F.G * NWAVES;
    bf16* H = (bf16*)(a.ws + WS_H);
    const float2* rt = (const float2*)(a.ws + WS_ROPE);
    const float* qg = a.in[11] + layer * 128; const float* kg = a.in[12] + layer * 128;
#if !(MFMA_ATT && ATT_FUSED_NORM)
    {
        const int li = lane & 15;
        float qgv[8], kgv[8];
#pragma unroll
        for (int i = 0; i < 8; ++i) { qgv[i] = qg[8 * li + i]; kgv[i] = kg[8 * li + i]; }
        v4u w[4], wn[4];
        if (gw < T) { const v4u* p = (const v4u*)(H + (size_t)gw * HP + C_CQ) + lane;
#pragma unroll
            for (int j = 0; j < 4; ++j) w[j] = p[64 * j]; }
        for (int row = gw; row < T; row += NGW) {
            const int rn = row + NGW;
            if (rn < T) { const v4u* p = (const v4u*)(H + (size_t)rn * HP + C_CQ) + lane;
#pragma unroll
                for (int j = 0; j < 4; ++j) wn[j] = p[64 * j]; }
            const int pos = row < TP ? (row & 2047) : row - TP;
            float cs[8], sn[8];
            if (li < 4) { const f32x4* r4 = (const f32x4*)(rt + pos * 16 + 8 * (li & 1));
#pragma unroll
                for (int i = 0; i < 4; ++i) { const f32x4 t4 = r4[i]; cs[2 * i] = t4.x; sn[2 * i] = t4.y; cs[2 * i + 1] = t4.z; sn[2 * i + 1] = t4.w; } }
            v4u* po = (v4u*)(H + (size_t)row * HP + C_CQ) + lane;
#pragma unroll
            for (int j = 0; j < 4; ++j) { float x[8]; unpack8(w[j], x);
                float ss = 0.f;
#pragma unroll
                for (int i = 0; i < 8; ++i) ss += x[i] * x[i];
                ss += shx<1>(ss); ss += shx<2>(ss); ss += shx<4>(ss); ss += shx<8>(ss);
                const float rstd = 1.0f / sqrtf(ss * (1.f / 128.f) + 1e-6f);
                const bool isq = j < 3;
#pragma unroll
                for (int i = 0; i < 8; ++i) x[i] = x[i] * rstd * (isq ? qgv[i] : kgv[i]);
                float pv[8];
#pragma unroll
                for (int i = 0; i < 8; ++i) pv[i] = shx<2>(x[i]);
                if (li < 4) {
#pragma unroll
                    for (int i = 0; i < 8; ++i) x[i] = li < 2 ? x[i] * cs[i] - pv[i] * sn[i] : x[i] * cs[i] + pv[i] * sn[i]; }
                if (isq) {
#pragma unroll
                    for (int i = 0; i < 8; ++i) x[i] *= (MFMA_ATT ? 0.12751743082459868f : 0.08838834764831845f); }
                v4u o; o.x = pk2(x[0], x[1]); o.y = pk2(x[2], x[3]); o.z = pk2(x[4], x[5]); o.w = pk2(x[6], x[7]);
                po[64 * j] = o; }
#pragma unroll
            for (int j = 0; j < 4; ++j) w[j] = wn[j];
        }
    }
#endif
#if !MFMA_SGU
    const float* lg = a.in[7] + layer * 1024; const float* lb = a.in[8] + layer * 1024;
    for (int row = gw; row < T; row += NGW) {
        v4u* p = (v4u*)(H + (size_t)row * HP + C_BV) + lane;
        v4u w0 = p[0], w1 = p[64]; float x[16];
        x[0] = bflo(w0.x); x[1] = bfhi(w0.x); x[2] = bflo(w0.y); x[3] = bfhi(w0.y); x[4] = bflo(w0.z); x[5] = bfhi(w0.z); x[6] = bflo(w0.w); x[7] = bfhi(w0.w);
        x[8] = bflo(w1.x); x[9] = bfhi(w1.x); x[10] = bflo(w1.y); x[11] = bfhi(w1.y); x[12] = bflo(w1.z); x[13] = bfhi(w1.z); x[14] = bflo(w1.w); x[15] = bfhi(w1.w);
        float s = 0.f;
#pragma unroll
        for (int j = 0; j < 16; ++j) s += x[j];
        const float mean = wave_sum(s) * (1.f / 1024.f); float q = 0.f;
#pragma unroll
        for (int j = 0; j < 16; ++j) { x[j] -= mean; q += x[j] * x[j]; }
        const float rstd = 1.0f / sqrtf(wave_sum(q) * (1.f / 1024.f) + 1e-5f);
#pragma unroll
        for (int j = 0; j < 16; ++j) { const int c = (j < 8 ? 8 * lane + j : 512 + 8 * lane + (j - 8)); x[j] = x[j] * rstd * lg[c] + lb[c]; }
        w0.x = pk2(x[0], x[1]); w0.y = pk2(x[2], x[3]); w0.z = pk2(x[4], x[5]); w0.w = pk2(x[6], x[7]);
        w1.x = pk2(x[8], x[9]); w1.y = pk2(x[10], x[11]); w1.z = pk2(x[12], x[13]); w1.w = pk2(x[14], x[15]);
        p[0] = w0; p[64] = w1;
    }
#endif
#if MFMA_GLA
    {
        const float* up = a.in[4] + (size_t)layer * 2 * 16 * 768; const float* gb = a.in[5] + layer * 2 * 768;
        const float* LR0 = (const float*)(a.ws + WS_LR); const float* LR1 = LR0 + (size_t)T * 32;
        float* Bc = (float*)(a.ws + WS_MG);
        LAS float* lrs = (LAS float*)(F.lds + RING_OFF);
        for (int rep8 = 0; rep8 < ((DUP_MASK & 8) ? (F.G > 100 ? 2 : 1) : 1); ++rep8)
        for (int chunk = blockIdx.x; chunk < 512; chunk += F.G) {
            __syncthreads();
            { const size_t o = (size_t)chunk * 2048 + tid * 4; const f32x4 x0 = *(const f32x4*)(LR0 + o), x1 = *(const f32x4*)(LR1 + o); *(LAS f32x4*)(lrs + tid * 4) = x0 + x1; }
            __syncthreads();
#pragma unroll 1
            for (int rr = 0; rr < 3; ++rr) { const int r = tid + 512 * rr, dir = r >= 768 ? 1 : 0, k = r - dir * 768;
                float upv[16];
#pragma unroll
                for (int j = 0; j < 16; ++j) upv[j] = up[(dir * 16 + j) * 768 + k];
                const float bias = gb[dir * 768 + k]; float b = 0.f;
#pragma unroll 4
                for (int i = 0; i < 64; ++i) { const int ri = dir == 0 ? i : 63 - i; const LAS f32x4* l4 = (const LAS f32x4*)(lrs + ri * 32 + dir * 16);
                    float z = bias;
#pragma unroll
                    for (int j = 0; j < 4; ++j) { const f32x4 x = l4[j]; z += x.x * upv[4 * j] + x.y * upv[4 * j + 1] + x.z * upv[4 * j + 2] + x.w * upv[4 * j + 3]; }
                    const float ls = fminf(z, 0.f) - __logf(1.0f + __expf(-fabsf(z)));
                    b += ls * (1.f / 16.f); ((_Float16*)Bc)[((size_t)chunk * 64 + ri) * 1536 + r] = (_Float16)b; }
            }
        }
    }
#endif
#if !MFMA_GLA
    const float* up = a.in[4] + (size_t)layer * 2 * 16 * 768; const float* gb = a.in[5] + layer * 2 * 768;
    const float* LR0 = (const float*)(a.ws + WS_LR); const float* LR1 = LR0 + (size_t)T * 32;
    float* DEC = (float*)(a.ws + WS_MG);
    for (size_t e = (size_t)(F.vcu * NWAVES + wave) * 64 + lane; e < (size_t)T * 1536; e += (size_t)F.G * NWAVES * 64) {
        const int row = (int)(e / 1536), r = (int)(e - (size_t)row * 1536), dir = r / 768, k = r - dir * 768;
        float z = gb[dir * 768 + k];
#pragma unroll
        for (int j = 0; j < 16; ++j) z += (LR0[(size_t)row * 32 + dir * 16 + j] + LR1[(size_t)row * 32 + dir * 16 + j]) * up[(dir * 16 + j) * 768 + k];
        const float ls = fminf(z, 0.f) - log1pf(expf(-fabsf(z)));
        DEC[e] = expf(ls * (1.f / 16.f));
    }
#endif
}

__device__ __forceinline__ void phase_mix_naive(Frame& F, const Args& a, int layer) {
    PHASE_IDS();
    bf16* H = (bf16*)(a.ws + WS_H); bf16* O = (bf16*)(a.ws + WS_XN);
#if !MFMA_SGU
    {
        const float* W = a.in[9] + (size_t)layer * 8 * 128 * 128; const float* sb = a.in[10] + layer * 8 * 128;
        const int c = tid & 127, pq = tid >> 7;
        for (int it = blockIdx.x; it < 256 * 8; it += F.G) {
            const int chunk = it >> 3, g = it & 7; const size_t r0 = (size_t)chunk * 128;
            for (int pp = 0; pp < 32; ++pp) { const int p = pp * 4 + pq; const float* wr = W + ((size_t)g * 128 + p) * 128;
                float acc = 0.f;
                for (int q = 0; q < 128; ++q) acc += wr[q] * bf1(H[(r0 + q) * HP + C_BV + g * 128 + c]);
                const size_t row = r0 + p;
                const float u = bf1(H[row * HP + C_BU + g * 128 + c]), sg = bf1(H[row * HP + C_BG + g * 128 + c]);
                O[row * D + O_B + g * 128 + c] = (bf16)f2bf((acc + sb[g * 128 + p]) * u * sg); }
        }
    }
#endif
#if !MFMA_ATT
    {
        LAS float* wq = (LAS float*)(F.lds + RING_OFF + wave * 2048);
        LAS float* sc = wq + 128;
        const float* sink = a.in[13] + layer * 12;
        const int gw = F.vcu * NWAVES + wave, NGW = F.G * NWAVES;
        for (int it = gw; it < T * 12; it += NGW) {
            const int row = it / 12, hq = it - row * 12, kvh = hq / 3;
            const int s0 = row < TP ? (row & ~2047) : TP, L = row < TP ? 2048 : 16384, qpos = row - s0;
            { const unsigned w = *((const unsigned*)(H + (size_t)row * HP + C_CQ + hq * 128) + lane); wq[2 * lane] = bflo(w); wq[2 * lane + 1] = bfhi(w); }
            LDS_WAIT(); asm volatile("" ::: "memory");
            float mx = -INFINITY;
            for (int pass = 0; pass < 5; ++pass) { const int jj = pass * 64 + lane, kpos = qpos - 128 + jj; float s = -INFINITY;
                if (jj <= 256 && kpos >= 0 && kpos < L) { const v4u* kr = (const v4u*)(H + (size_t)(s0 + kpos) * HP + C_CK + kvh * 128); float d = 0.f;
#pragma unroll 4
                    for (int i = 0; i < 16; ++i) { const v4u w = kr[i]; const LAS float* q8 = wq + 8 * i;
                        d += q8[0] * bflo(w.x) + q8[1] * bfhi(w.x) + q8[2] * bflo(w.y) + q8[3] * bfhi(w.y) + q8[4] * bflo(w.z) + q8[5] * bfhi(w.z) + q8[6] * bflo(w.w) + q8[7] * bfhi(w.w); }
                    s = d; }
                sc[jj] = s; mx = fmaxf(mx, s); }
            const float sk = sink[hq];
            const float m = fmaxf(wave_max(mx), sk);
            LDS_WAIT(); asm volatile("" ::: "memory");
            float ps = 0.f;
            for (int pass = 0; pass < 5; ++pass) { const int jj = pass * 64 + lane; const float s = sc[jj]; const float p = (s == -INFINITY) ? 0.f : __expf(s - m); sc[jj] = p; ps += p; }
            const float denom = wave_sum(ps) + __expf(sk - m);
            LDS_WAIT(); asm volatile("" ::: "memory");
            float o0 = 0.f, o1 = 0.f;
            const int jlo = qpos >= 128 ? 0 : 128 - qpos, jhi = (qpos + 128 < L) ? 256 : (L - 1 - qpos + 128);
            for (int jj = jlo; jj <= jhi; ++jj) { const float p = sc[jj]; const unsigned w = *((const unsigned*)(H + (size_t)(s0 + qpos - 128 + jj) * HP + C_CV + kvh * 128) + lane);
                o0 += p * bflo(w); o1 += p * bfhi(w); }
            const float inv = 1.0f / denom;
            const unsigned gwd = *((const unsigned*)(H + (size_t)row * HP + C_CG + hq * 128) + lane);
            *((unsigned*)(O + (size_t)row * D + O_C + hq * 128) + lane) = pk2(o0 * inv * bflo(gwd), o1 * inv * bfhi(gwd));
            LDS_WAIT(); asm volatile("" ::: "memory");
        }
    }
#endif
    __syncthreads();
    if (blockIdx.x < 108) {
        const int b = blockIdx.x, seq = b / 12, hd = (b % 12) >> 1, dir = b & 1;
        const int s0 = seq < 8 ? seq * 2048 : TP, L = seq < 8 ? 2048 : 16384;
        LAS float* la = (LAS float*)(F.lds + RING_OFF + 32768); LAS float* lq = la + 128; LAS float* lk = lq + 128; LAS float* lo = lk + 128;
        const float* DEC = (const float*)(a.ws + WS_MG);
        float* OUT = (float*)(a.ws + WS_ST) + (size_t)dir * T * 1536;
        const int dv = tid & 255, half = tid >> 8;
        float S[64];
#pragma unroll
        for (int j = 0; j < 64; ++j) S[j] = 0.f;
        float na = 0.f, nq = 0.f, nk = 0.f, nv;
        { const size_t p = (size_t)(dir == 0 ? s0 : s0 + L - 1);
          if (tid < 128) { na = DEC[p * 1536 + dir * 768 + hd * 128 + tid]; nq = bf1(H[p * HP + C_AQ + hd * 128 + tid]) * 0.08838834764831845f; nk = bf1(H[p * HP + C_AK + hd * 128 + tid]); }
          nv = bf1(H[p * HP + C_AV + hd * 256 + dv]); }
        for (int t = 0; t < L; ++t) {
            const size_t p = (size_t)(dir == 0 ? s0 + t : s0 + L - 1 - t);
            if (tid < 128) { la[tid] = na; lq[tid] = nq; lk[tid] = nk; }
            const float v = nv;
            __syncthreads();
            if (t + 1 < L) { const size_t pn = (size_t)(dir == 0 ? p + 1 : p - 1);
                if (tid < 128) { na = DEC[pn * 1536 + dir * 768 + hd * 128 + tid]; nq = bf1(H[pn * HP + C_AQ + hd * 128 + tid]) * 0.08838834764831845f; nk = bf1(H[pn * HP + C_AK + hd * 128 + tid]); }
                nv = bf1(H[pn * HP + C_AV + hd * 256 + dv]); }
            float acc = 0.f;
#pragma unroll
            for (int j = 0; j < 64; ++j) { const int dk = half * 64 + j; S[j] = la[dk] * S[j] + lk[dk] * v; acc += lq[dk] * S[j]; }
            if (half == 1) lo[dv] = acc;
            __syncthreads();
            if (half == 0) OUT[p * 1536 + hd * 256 + dv] = acc + lo[dv];
        }
    }
}

__device__ __forceinline__ void phase_gla_fin(Frame& F, const Args& a, int layer) {
    PHASE_IDS();
    const int gw = F.vcu * NWAVES + wave, NGW = F.G * NWAVES;
    const bf16* H = (const bf16*)(a.ws + WS_H); bf16* O = (bf16*)(a.ws + WS_XN);
    const float* OF = (const float*)(a.ws + WS_ST); const float* OB = OF + (size_t)T * 1536;
    const float* gn = a.in[6] + layer * 256;
    for (int it = gw; it < T * 6; it += NGW) {
        const int row = it / 6, hd = it - row * 6;
        const f32x4 f = *((const f32x4*)(OF + (size_t)row * 1536 + hd * 256) + lane), b = *((const f32x4*)(OB + (size_t)row * 1536 + hd * 256) + lane);
        const f32x4 s = f + b;
        const float rstd = 1.0f / sqrtf(wave_sum((s.x * s.x + s.y * s.y) + (s.z * s.z + s.w * s.w)) * (1.f / 256.f) + 1e-6f);
        const f32x4 g = *((const f32x4*)gn + lane);
        const v2u gt = *((const v2u*)(H + (size_t)row * HP + C_AG + hd * 256) + lane);
        v2u w; w.x = pk2(s.x * rstd * g.x * bflo(gt.x), s.y * rstd * g.y * bfhi(gt.x)); w.y = pk2(s.z * rstd * g.z * bflo(gt.y), s.w * rstd * g.w * bfhi(gt.y));
        *((v2u*)(O + (size_t)row * D + O_A + hd * 256) + lane) = w;
    }
}


typedef short bf16x8 __attribute__((ext_vector_type(8)));
#define MFMA16(a_, b_, c_) __builtin_amdgcn_mfma_f32_16x16x32_bf16(a_, b_, c_, 0, 0, 0)
__device__ __forceinline__ bf16x8 ldsfrag(const LAS unsigned char* base, int pitch, int row0, int k0, int fr, int fq) {
    return *(const LAS bf16x8*)(base + (row0 + fr) * pitch + (k0 + 8 * fq) * 2);
}

__device__ __forceinline__ void phase_sgu(Frame& F, const Args& a, int layer) {
    PHASE_IDS();
    const int fr = lane & 15, fq = lane >> 4;
    constexpr int PIT = 272;
    LAS unsigned char* VT = F.lds + RING_OFF;
    LAS unsigned char* WA = VT + 128 * PIT;
    LAS float* STt = (LAS float*)(WA + 128 * PIT);
    const bf16* H = (const bf16*)(a.ws + WS_H); bf16* O = (bf16*)(a.ws + WS_XN);
    const float* lg = a.in[7] + layer * 1024; const float* lb = a.in[8] + layer * 1024;
    const float* W = a.in[9] + (size_t)layer * 8 * 128 * 128; const float* sb = a.in[10] + layer * 8 * 128;
    for (int chunk = blockIdx.x; chunk < 256; chunk += F.G) {
        const size_t r0 = (size_t)chunk * 128;
        __syncthreads();
#pragma unroll 1
        for (int ib = 0; ib < 2; ++ib) {
            v4u ra[8], rb[8];
#pragma unroll
            for (int i = 0; i < 8; ++i) { const v4u* p = (const v4u*)(H + (r0 + 16 * wave + 8 * ib + i) * HP + C_BV) + lane; ra[i] = p[0]; rb[i] = p[64]; }
            float s[8], q[8];
#pragma unroll
            for (int i = 0; i < 8; ++i) { float x[16]; unpack8(ra[i], x); unpack8(rb[i], x + 8); s[i] = 0.f;
#pragma unroll
                for (int j = 0; j < 16; ++j) s[i] += x[j]; }
#pragma unroll
            for (int i = 0; i < 8; ++i) s[i] = wave_sum(s[i]) * (1.f / 1024.f);
#pragma unroll
            for (int i = 0; i < 8; ++i) { float x[16]; unpack8(ra[i], x); unpack8(rb[i], x + 8); q[i] = 0.f;
#pragma unroll
                for (int j = 0; j < 16; ++j) { const float d = x[j] - s[i]; q[i] += d * d; } }
#pragma unroll
            for (int i = 0; i < 8; ++i) q[i] = wave_sum(q[i]);
#pragma unroll
            for (int i = 0; i < 8; ++i) { const float rstd = 1.0f / sqrtf(q[i] * (1.f / 1024.f) + 1e-5f);
                if (lane == 0) { STt[2 * (16 * wave + 8 * ib + i)] = s[i]; STt[2 * (16 * wave + 8 * ib + i) + 1] = rstd; } }
        }
        __syncthreads();
        v4u vraw[4]; f32x4 wraw[8];
#define SGU_LOAD(g_) do { const v4u* vs_ = (const v4u*)(H + (r0 + (tid & 127)) * HP + C_BV + (g_) * 128 + (tid >> 7) * 32); _Pragma("unroll") for (int i_ = 0; i_ < 4; ++i_) vraw[i_] = vs_[i_]; \
        const f32x4* ws_ = (const f32x4*)(W + ((size_t)(g_) * 128 + (tid >> 2)) * 128 + (tid & 3) * 32); _Pragma("unroll") for (int i_ = 0; i_ < 8; ++i_) wraw[i_] = ws_[i_]; } while (0)
        SGU_LOAD(0);
        for (int g = 0; g < 8; ++g) {
            { const int q = tid & 127, cb = (tid >> 7) * 32; const float st_x = STt[2 * q], st_y = STt[2 * q + 1];
#pragma unroll
              for (int i = 0; i < 4; ++i) { float x[8]; unpack8(vraw[i], x);
#pragma unroll
                  for (int j = 0; j < 8; ++j) { const int c = cb + 8 * i + j; const float y = (x[j] - st_x) * st_y * lg[g * 128 + c] + lb[g * 128 + c];
                      *(LAS bf16*)(VT + c * PIT + q * 2) = (bf16)f2bf(y); } } }
            { const int p = tid >> 2, qb = (tid & 3) * 32;
#pragma unroll
              for (int i = 0; i < 4; ++i) { const f32x4 u0 = wraw[2 * i], u1 = wraw[2 * i + 1]; v4u w; w.x = pk2(u0.x, u0.y); w.y = pk2(u0.z, u0.w); w.z = pk2(u1.x, u1.y); w.w = pk2(u1.z, u1.w);
                  *(LAS v4u*)(WA + p * PIT + (qb + 8 * i) * 2) = w; } }
            if (g < 7) SGU_LOAD(g + 1);
            const int p = 16 * wave + fr; const size_t row = r0 + p; const float sbv = sb[g * 128 + p];
            v2u gu[8], sg[8];
#pragma unroll
            for (int n = 0; n < 8; ++n) { const int c = g * 128 + 16 * n + 4 * fq; gu[n] = *(const v2u*)(H + row * HP + C_BU + c); sg[n] = *(const v2u*)(H + row * HP + C_BG + c); }
            __syncthreads();
            f32x4 acc[8];
#pragma unroll
            for (int n = 0; n < 8; ++n) acc[n] = (f32x4){0.f, 0.f, 0.f, 0.f};
#pragma unroll
            for (int ks = 0; ks < 4; ++ks) { const bf16x8 af = ldsfrag(WA, PIT, 16 * wave, 32 * ks, fr, fq);
#pragma unroll
                for (int n = 0; n < 8; ++n) acc[n] = MFMA16(ldsfrag(VT, PIT, 16 * n, 32 * ks, fr, fq), af, acc[n]); }
#pragma unroll
            for (int n = 0; n < 8; ++n) { const int c = g * 128 + 16 * n + 4 * fq;
                v2u w; w.x = pk2((acc[n][0] + sbv) * bflo(gu[n].x) * bflo(sg[n].x), (acc[n][1] + sbv) * bfhi(gu[n].x) * bfhi(sg[n].x));
                w.y = pk2((acc[n][2] + sbv) * bflo(gu[n].y) * bflo(sg[n].y), (acc[n][3] + sbv) * bfhi(gu[n].y) * bfhi(sg[n].y));
                *(v2u*)(O + row * D + O_B + c) = w; }
            __syncthreads();
        }
#undef SGU_LOAD
    }
}

__device__ __forceinline__ void phase_attn(Frame& F, const Args& a, int layer) {
    PHASE_IDS();
    const int fr = lane & 15, fq = lane >> 4;
    constexpr int PIT = 272;
    LAS unsigned char* Kt = F.lds + RING_OFF;
    LAS unsigned char* Vt = Kt + 128 * PIT;
    LAS unsigned char* Pm = Vt + 128 * PIT;
    const bf16* H = (const bf16*)(a.ws + WS_H); bf16* O = (bf16*)(a.ws + WS_XN);
    const float* sink = a.in[13] + layer * 12;
    const float* qg = a.in[11] + layer * 128; const float* kg = a.in[12] + layer * 128;
    const float* rt = (const float*)(a.ws + WS_ROPE);
    constexpr int NU = 256 * 12;
    int u = F.vcu; if (u >= NU) return;
#define ATT_DECODE(u_, qb_, hq_, r0_, s0_, nblk_, qi_) const int qb_ = (u_) / 12, hq_ = (u_) - qb_ * 12, r0_ = qb_ * 128, s0_ = r0_ < TP ? (r0_ & ~2047) : TP, nblk_ = r0_ < TP ? 16 : 128, qi_ = (r0_ - s0_) >> 7
#define ATT_LOAD_KV(s0_, kbi_, kvh_) do { const size_t kr0_ = (size_t)((s0_) + (kbi_) * 128); \
        const v4u* ks_ = (const v4u*)(H + (kr0_ + (tid >> 2)) * HP + C_CK + (kvh_) * 128 + (tid & 3) * 32); const v4u* vs_ = (const v4u*)(H + (kr0_ + (tid & 127)) * HP + C_CV + (kvh_) * 128 + (tid >> 7) * 32); \
        _Pragma("unroll") for (int i_ = 0; i_ < 4; ++i_) { kraw[i_] = ks_[i_]; vraw[i_] = vs_[i_]; } } while (0)
#define ATT_LOAD_Q(r0_, hq_) do { const bf16* qp_ = H + (size_t)((r0_) + 16 * wave + fr) * HP + C_CQ + (hq_) * 128 + 8 * fq; \
        _Pragma("unroll") for (int i_ = 0; i_ < 4; ++i_) qraw[i_] = *(const v4u*)(qp_ + 32 * i_); } while (0)
    v4u kraw[4], vraw[4], qraw[4];
    int t;
    { ATT_DECODE(u, qb, hq, r0, s0, nblk, qi); (void)nblk; t = qi == 0 ? 0 : -1; ATT_LOAD_KV(s0, qi + t, hq / 3); ATT_LOAD_Q(r0, hq); }
    for (;;) {
        ATT_DECODE(u, qb, hq, r0, s0, nblk, qi); const int kvh = hq / 3;
        const size_t qrow = (size_t)(r0 + 16 * wave + fr);
        bf16x8 qf[4];
#if ATT_FUSED_NORM
        { float x[4][8]; float ss = 0.f;
#pragma unroll
          for (int ks = 0; ks < 4; ++ks) { unpack8(qraw[ks], x[ks]);
#pragma unroll
              for (int j = 0; j < 8; ++j) ss += x[ks][j] * x[ks][j]; }
          ss += shx<16>(ss); ss = sum32(ss);
          const float rstd = 1.0f / sqrtf(ss * (1.f / 128.f) + 1e-6f);
#pragma unroll
          for (int ks = 0; ks < 4; ++ks) { const f32x4 g0 = *(const f32x4*)(qg + 32 * ks + 8 * fq), g1 = *(const f32x4*)(qg + 32 * ks + 8 * fq + 4);
              x[ks][0] *= rstd * g0.x; x[ks][1] *= rstd * g0.y; x[ks][2] *= rstd * g0.z; x[ks][3] *= rstd * g0.w; x[ks][4] *= rstd * g1.x; x[ks][5] *= rstd * g1.y; x[ks][6] *= rstd * g1.z; x[ks][7] *= rstd * g1.w; }
          { const int pos = (int)qrow - s0; const f32x4* c4 = (const f32x4*)(rt + (pos * 16 + 8 * (fq & 1)) * 2);
#pragma unroll
            for (int j2 = 0; j2 < 4; ++j2) { const f32x4 cs = c4[j2]; const float pa = xch32(x[0][2 * j2], fq >= 2), pb = xch32(x[0][2 * j2 + 1], fq >= 2);
                x[0][2 * j2] = fq < 2 ? x[0][2 * j2] * cs.x - pa * cs.y : x[0][2 * j2] * cs.x + pa * cs.y;
                x[0][2 * j2 + 1] = fq < 2 ? x[0][2 * j2 + 1] * cs.z - pb * cs.w : x[0][2 * j2 + 1] * cs.z + pb * cs.w; } }
#pragma unroll
          for (int ks = 0; ks < 4; ++ks) { v4u w; const float sc = 0.12751743082459868f;
              w.x = pk2(x[ks][0] * sc, x[ks][1] * sc); w.y = pk2(x[ks][2] * sc, x[ks][3] * sc); w.z = pk2(x[ks][4] * sc, x[ks][5] * sc); w.w = pk2(x[ks][6] * sc, x[ks][7] * sc);
              qf[ks] = __builtin_bit_cast(bf16x8, w); } }
#else
#pragma unroll
        for (int ks = 0; ks < 4; ++ks) qf[ks] = __builtin_bit_cast(bf16x8, qraw[ks]);
#endif
        v2u gtr[8];
#pragma unroll
        for (int n = 0; n < 8; ++n) gtr[n] = *(const v2u*)(H + qrow * HP + C_CG + hq * 128 + 16 * n + 4 * fq);
        float m = sink[hq] * 1.44269504089f, l = fq == 0 ? 1.f : 0.f;
        f32x4 Oa[8];
#pragma unroll
        for (int n = 0; n < 8; ++n) Oa[n] = (f32x4){0.f, 0.f, 0.f, 0.f};
        int un = u, tn = t; bool more = true;
        for (;;) {
            const size_t kr0 = (size_t)(s0 + (qi + t) * 128);
            __syncthreads();
#if ATT_FUSED_NORM
            { const int key = tid >> 2, dq = tid & 3, db = dq * 32; float ss = 0.f;
#pragma unroll
              for (int i = 0; i < 4; ++i) { float x[8]; unpack8(kraw[i], x);
#pragma unroll
                  for (int j = 0; j < 8; ++j) ss += x[j] * x[j]; }
              ss += shx<1>(ss); ss += shx<2>(ss);
              const float rstd = 1.0f / sqrtf(ss * (1.f / 128.f) + 1e-6f);
              if (dq == 0) {
                  const int pos = (int)(kr0 - s0) + key; const f32x4* c4 = (const f32x4*)(rt + pos * 32);
#pragma unroll
                  for (int h = 0; h < 2; ++h) { float xa[8], xb[8]; unpack8(kraw[h], xa); unpack8(kraw[h + 2], xb);
#pragma unroll
                      for (int j = 0; j < 8; ++j) { xa[j] *= rstd * kg[8 * h + j]; xb[j] *= rstd * kg[16 + 8 * h + j]; }
#pragma unroll
                      for (int j2 = 0; j2 < 4; ++j2) { const f32x4 cs = c4[4 * h + j2];
                          const float a0 = xa[2 * j2], b0 = xb[2 * j2], a1 = xa[2 * j2 + 1], b1 = xb[2 * j2 + 1];
                          xa[2 * j2] = a0 * cs.x - b0 * cs.y; xb[2 * j2] = b0 * cs.x + a0 * cs.y; xa[2 * j2 + 1] = a1 * cs.z - b1 * cs.w; xb[2 * j2 + 1] = b1 * cs.z + a1 * cs.w; }
                      v4u w; w.x = pk2(xa[0], xa[1]); w.y = pk2(xa[2], xa[3]); w.z = pk2(xa[4], xa[5]); w.w = pk2(xa[6], xa[7]); *(LAS v4u*)(Kt + key * PIT + (8 * h) * 2) = w;
                      w.x = pk2(xb[0], xb[1]); w.y = pk2(xb[2], xb[3]); w.z = pk2(xb[4], xb[5]); w.w = pk2(xb[6], xb[7]); *(LAS v4u*)(Kt + key * PIT + (16 + 8 * h) * 2) = w; }
              } else {
#pragma unroll
                  for (int i = 0; i < 4; ++i) { float x[8]; unpack8(kraw[i], x);
#pragma unroll
                      for (int j = 0; j < 8; ++j) x[j] *= rstd * kg[db + 8 * i + j];
                      v4u w; w.x = pk2(x[0], x[1]); w.y = pk2(x[2], x[3]); w.z = pk2(x[4], x[5]); w.w = pk2(x[6], x[7]); *(LAS v4u*)(Kt + key * PIT + (db + 8 * i) * 2) = w; } } }
#else
            { const int key = tid >> 2, db = (tid & 3) * 32;
#pragma unroll
              for (int i = 0; i < 4; ++i) *(LAS v4u*)(Kt + key * PIT + (db + 8 * i) * 2) = kraw[i]; }
#endif
            { const int key = tid & 127, db = (tid >> 7) * 32;
#pragma unroll
              for (int i = 0; i < 4; ++i) { const v4u w = vraw[i]; const unsigned ww[4] = {w.x, w.y, w.z, w.w};
#pragma unroll
                  for (int j = 0; j < 4; ++j) { *(LAS bf16*)(Vt + (db + 8 * i + 2 * j) * PIT + key * 2) = (bf16)(ww[j] & 0xffffu); *(LAS bf16*)(Vt + (db + 8 * i + 2 * j + 1) * PIT + key * 2) = (bf16)(ww[j] >> 16); } } }
            if (t + 1 <= 1 && qi + t + 1 < nblk) { tn = t + 1; ATT_LOAD_KV(s0, qi + tn, kvh); }
            else { un = u + F.G; if (un < NU) { ATT_DECODE(un, qb2, hq2, r02, s02, nblk2, qi2); (void)nblk2; tn = qi2 == 0 ? 0 : -1; ATT_LOAD_KV(s02, qi2 + tn, hq2 / 3); ATT_LOAD_Q(r02, hq2); } else more = false; }
            __syncthreads();
            f32x4 S[8];
#pragma unroll
            for (int n = 0; n < 8; ++n) S[n] = (f32x4){0.f, 0.f, 0.f, 0.f};
#pragma unroll
            for (int ks = 0; ks < 4; ++ks)
#pragma unroll
                for (int n = 0; n < 8; ++n) S[n] = MFMA16(ldsfrag(Kt, PIT, 16 * n, 32 * ks, fr, fq), qf[ks], S[n]);
            const int qi_ = 16 * wave + fr; float mx = -INFINITY;
            if (t != 0) {
#pragma unroll
                for (int n = 0; n < 8; ++n)
#pragma unroll
                    for (int j = 0; j < 4; ++j) { const int kj = 16 * n + 4 * fq + j; const bool ok = t < 0 ? kj >= qi_ : kj <= qi_; S[n][j] = ok ? S[n][j] : -INFINITY; } }
#pragma unroll
            for (int n = 0; n < 8; ++n) mx = fmaxf(mx, fmaxf(fmaxf(S[n][0], S[n][1]), fmaxf(S[n][2], S[n][3])));
            mx = fmaxf(mx, shx<16>(mx)); mx = max32(mx);
            const float mn = fmaxf(m, mx), alpha = __builtin_amdgcn_exp2f(m - mn); m = mn;
            float ps = 0.f;
#pragma unroll
            for (int n = 0; n < 8; ++n) { float p0 = __builtin_amdgcn_exp2f(S[n][0] - mn), p1 = __builtin_amdgcn_exp2f(S[n][1] - mn), p2 = __builtin_amdgcn_exp2f(S[n][2] - mn), p3 = __builtin_amdgcn_exp2f(S[n][3] - mn);
                ps += (p0 + p1) + (p2 + p3); v2u w; w.x = pk2(p0, p1); w.y = pk2(p2, p3);
                *(LAS v2u*)(Pm + (16 * wave + fr) * PIT + (16 * n + 4 * fq) * 2) = w; Oa[n] = Oa[n] * alpha; }
            l = l * alpha + ps;
            LDS_WAIT(); asm volatile("" ::: "memory");
#pragma unroll
            for (int ks = 0; ks < 4; ++ks) { const bf16x8 pf = ldsfrag(Pm, PIT, 16 * wave, 32 * ks, fr, fq);
#pragma unroll
                for (int n = 0; n < 8; ++n) Oa[n] = MFMA16(ldsfrag(Vt, PIT, 16 * n, 32 * ks, fr, fq), pf, Oa[n]); }
            if (un != u || !more) break;
            t = tn;
        }
        l += shx<16>(l); l = sum32(l);
        const float inv = 1.0f / l;
#pragma unroll
        for (int n = 0; n < 8; ++n) { const int d = hq * 128 + 16 * n + 4 * fq; const v2u gt = gtr[n];
            v2u w; w.x = pk2(Oa[n][0] * inv * bflo(gt.x), Oa[n][1] * inv * bfhi(gt.x)); w.y = pk2(Oa[n][2] * inv * bflo(gt.y), Oa[n][3] * inv * bfhi(gt.y));
#if F8_OC
#define F8C(x) __builtin_amdgcn_fmed3f(8.f * (x), -448.f, 448.f)
            int w8 = 0; w8 = __builtin_amdgcn_cvt_pk_fp8_f32(F8C(Oa[n][0] * inv * bflo(gt.x)), F8C(Oa[n][1] * inv * bfhi(gt.x)), w8, false); w8 = __builtin_amdgcn_cvt_pk_fp8_f32(F8C(Oa[n][2] * inv * bflo(gt.y)), F8C(Oa[n][3] * inv * bfhi(gt.y)), w8, true);
#undef F8C
            *(unsigned*)((unsigned char*)O + qrow * 8192 + 5120 + d) = (unsigned)w8; (void)w; }
#else
            *(v2u*)(O + qrow * D + O_C + d) = w; }
#endif
        if (!more) break;
        u = un; t = tn;
    }
#undef ATT_DECODE
#undef ATT_LOAD_KV
#undef ATT_LOAD_Q
}

__device__ __forceinline__ void phase_gla_c1(Frame& F, const Args& a, int layer) {
    PHASE_IDS();
    const int fr = lane & 15, fq = lane >> 4;
    constexpr int PV = 144;
    LAS unsigned char* VT = F.lds + RING_OFF;
    LAS unsigned char* K1T = VT + 256 * PV;
    const bf16* H = (const bf16*)(a.ws + WS_H); const float* Bc = (const float*)(a.ws + WS_MG);
    bf16* STb = (bf16*)(a.ws + WS_ST); float* DECC = (float*)(a.ws + WS_DECC);
    v4u vraw[4], kraw[2], braw[2][2];
#define C1_LOAD(u_) do { const int c_ = (u_) / 6, hd_ = (u_) - c_ * 6; const size_t r0_ = (size_t)c_ * 64; const int s_ = tid & 63; \
        const v4u* vs_ = (const v4u*)(H + (r0_ + s_) * HP + C_AV + hd_ * 256 + (tid >> 6) * 32); _Pragma("unroll") for (int i_ = 0; i_ < 4; ++i_) vraw[i_] = vs_[i_]; \
        const v4u* ks_ = (const v4u*)(H + (r0_ + s_) * HP + C_AK + hd_ * 128 + (tid >> 6) * 16); kraw[0] = ks_[0]; kraw[1] = ks_[1]; \
        _Pragma("unroll") for (int d_ = 0; d_ < 2; ++d_) { const v4u* bs_ = (const v4u*)((const _Float16*)Bc + (r0_ + s_) * 1536 + d_ * 768 + hd_ * 128 + (tid >> 6) * 16); braw[d_][0] = bs_[0]; braw[d_][1] = bs_[1]; } } while (0)
    if (F.vcu < 512 * 6) C1_LOAD(F.vcu);
    for (int u = F.vcu; u < 512 * 6; u += F.G) {
        const int c = u / 6, hd = u - c * 6; const size_t r0 = (size_t)c * 64;
        __syncthreads();
        { const int s = tid & 63, dvb = (tid >> 6) * 32;
#pragma unroll
          for (int i = 0; i < 4; ++i) { const v4u w = vraw[i]; const unsigned ww[4] = {w.x, w.y, w.z, w.w};
#pragma unroll
              for (int j = 0; j < 4; ++j) { *(LAS bf16*)(VT + (dvb + 8 * i + 2 * j) * PV + s * 2) = (bf16)(ww[j] & 0xffffu); *(LAS bf16*)(VT + (dvb + 8 * i + 2 * j + 1) * PV + s * 2) = (bf16)(ww[j] >> 16); } } }
        { const int s = tid & 63, dkb = (tid >> 6) * 16; float kx[16]; unpack8(kraw[0], kx); unpack8(kraw[1], kx + 8);
#pragma unroll
          for (int dir = 0; dir < 2; ++dir)
#pragma unroll
            for (int i = 0; i < 4; ++i) { const f32x4 bb = h4q(braw[dir][i >> 1], i & 1);
#pragma unroll
                for (int j = 0; j < 4; ++j) *(LAS bf16*)(K1T + (dir * 128 + dkb + 4 * i + j) * PV + s * 2) = (bf16)f2bf(kx[4 * i + j] * __expf(-bb[j])); } }
        if (u + F.G < 512 * 6) C1_LOAD(u + F.G);
        __syncthreads();
#pragma unroll
        for (int dir = 0; dir < 2; ++dir) {
            f32x4 acc[2][8];
#pragma unroll
            for (int m = 0; m < 2; ++m)
#pragma unroll
                for (int n = 0; n < 8; ++n) acc[m][n] = (f32x4){0.f, 0.f, 0.f, 0.f};
#pragma unroll
            for (int ks = 0; ks < 2; ++ks) { const bf16x8 a0 = ldsfrag(VT, PV, 32 * wave, 32 * ks, fr, fq), a1 = ldsfrag(VT, PV, 32 * wave + 16, 32 * ks, fr, fq);
#pragma unroll
                for (int n = 0; n < 8; ++n) { const bf16x8 bfr = ldsfrag(K1T + dir * 128 * PV, PV, 16 * n, 32 * ks, fr, fq); acc[0][n] = MFMA16(bfr, a0, acc[0][n]); acc[1][n] = MFMA16(bfr, a1, acc[1][n]); } }
            const size_t lastrow = r0 + (dir == 0 ? 63 : 0); const int slot = (c * 6 + hd) * 2 + dir; bf16* dst = STb + (size_t)slot * 32768;
#pragma unroll
            for (int n = 0; n < 8; ++n) { const int dk = 16 * n + 4 * fq; const f32x4 bl = h4(*(const v2u*)((const _Float16*)Bc + lastrow * 1536 + dir * 768 + hd * 128 + dk));
                const float e0 = __expf(bl.x), e1 = __expf(bl.y), e2 = __expf(bl.z), e3 = __expf(bl.w);
#pragma unroll
                for (int m = 0; m < 2; ++m) { const int dv = 32 * wave + 16 * m + fr; v2u w; w.x = pk2(acc[m][n][0] * e0, acc[m][n][1] * e1); w.y = pk2(acc[m][n][2] * e2, acc[m][n][3] * e3);
                    *(v2u*)(dst + dv * 128 + dk) = w; } }
            if (tid < 128) DECC[slot * 128 + tid] = __expf((float)((const _Float16*)Bc)[lastrow * 1536 + dir * 768 + hd * 128 + tid]);
        }
    }
#undef C1_LOAD
}
__device__ __forceinline__ void gla_scan_item(int it, bf16* STb, const float* DECC, int lane) {
    int seq, hdir, slab;
    if (it < 768) { seq = 8; hdir = it >> 6; slab = it & 63; } else { const int j = it - 768; const int sh = j >> 6; seq = sh / 12; hdir = sh - seq * 12; slab = j & 63; }
    const int c0 = seq < 8 ? seq * 32 : 256, nc = seq < 8 ? 32 : 256, hd = hdir >> 1, dir = hdir & 1;
    const int e0 = slab * 512 + lane * 8, dk0 = e0 & 127;
    float S[8];
#pragma unroll
    for (int j = 0; j < 8; ++j) S[j] = 0.f;
    v4u kvn[8];
#pragma unroll
    for (int i = 0; i < 8; ++i) { const int c = dir == 0 ? c0 + i : c0 + nc - 1 - i; kvn[i] = *(const v4u*)(STb + (size_t)((c * 6 + hd) * 2 + dir) * 32768 + e0); }
    for (int st = 0; st < nc; st += 8) {
        v4u kv[8]; f32x4 d0[8], d1[8];
#pragma unroll
        for (int i = 0; i < 8; ++i) { const int c = dir == 0 ? c0 + st + i : c0 + nc - 1 - (st + i); const int slot = (c * 6 + hd) * 2 + dir;
            kv[i] = kvn[i]; d0[i] = *(const f32x4*)(DECC + slot * 128 + dk0); d1[i] = *(const f32x4*)(DECC + slot * 128 + dk0 + 4); }
        if (st + 8 < nc) {
#pragma unroll
            for (int i = 0; i < 8; ++i) { const int c = dir == 0 ? c0 + st + 8 + i : c0 + nc - 1 - (st + 8 + i); kvn[i] = *(const v4u*)(STb + (size_t)((c * 6 + hd) * 2 + dir) * 32768 + e0); } }
#pragma unroll
        for (int i = 0; i < 8; ++i) { const int c = dir == 0 ? c0 + st + i : c0 + nc - 1 - (st + i); const int slot = (c * 6 + hd) * 2 + dir;
            v4u w; w.x = pk2(S[0], S[1]); w.y = pk2(S[2], S[3]); w.z = pk2(S[4], S[5]); w.w = pk2(S[6], S[7]);
            *(v4u*)(STb + (size_t)slot * 32768 + e0) = w;
            float x[8]; unpack8(kv[i], x);
            S[0] = d0[i].x * S[0] + x[0]; S[1] = d0[i].y * S[1] + x[1]; S[2] = d0[i].z * S[2] + x[2]; S[3] = d0[i].w * S[3] + x[3];
            S[4] = d1[i].x * S[4] + x[4]; S[5] = d1[i].y * S[5] + x[5]; S[6] = d1[i].z * S[6] + x[6]; S[7] = d1[i].w * S[7] + x[7]; }
    }
}
__device__ __forceinline__ void phase_gla_scan(Frame& F, const Args& a) {
    PHASE_IDS();
    bf16* STb = (bf16*)(a.ws + WS_ST); const float* DECC = (const float*)(a.ws + WS_DECC);
    const int gw = F.vcu * NWAVES + wave, NGW = F.G * NWAVES;
    if (F.G == 256) {
        const int cu = blockIdx.x;
        if (wave < 3) gla_scan_item(cu * 3 + wave, STb, DECC, lane);
        else for (int it = 768 + cu * 5 + (wave - 3); it < 768 + 6144; it += 1280) gla_scan_item(it, STb, DECC, lane);
    }
    else for (int it = gw; it < 768 + 6144; it += NGW) gla_scan_item(it, STb, DECC, lane);
}
__device__ __forceinline__ void phase_gla_c3(Frame& F, const Args& a, int layer) {
    PHASE_IDS();
    const int fr = lane & 15, fq = lane >> 4;
    constexpr int PQ = 272, PV = 144;
    LAS unsigned char* Q1 = F.lds + RING_OFF;
    LAS unsigned char* K1 = Q1 + 2 * 64 * PQ;
    LAS unsigned char* VT = K1 + 2 * 64 * PQ;
    LAS unsigned char* Pm = VT + 256 * PV;
    LAS float* red = (LAS float*)(Pm + 2 * 64 * PV);
    const bf16* H = (const bf16*)(a.ws + WS_H); const float* Bc = (const float*)(a.ws + WS_MG);
    const bf16* STb = (const bf16*)(a.ws + WS_ST); bf16* O = (bf16*)(a.ws + WS_XN);
    const float* gn = a.in[6] + layer * 256;
    v4u qraw[2], kraw[2], vraw[4], braw[2][2];
#define C3_LOAD(u_) do { const int c_ = (u_) / 6, hd_ = (u_) - c_ * 6; const size_t r0_ = (size_t)c_ * 64; const int s_ = tid >> 3, dkb_ = (tid & 7) * 16; \
        const v4u* qs_ = (const v4u*)(H + (r0_ + s_) * HP + C_AQ + hd_ * 128 + dkb_); const v4u* ks_ = (const v4u*)(H + (r0_ + s_) * HP + C_AK + hd_ * 128 + dkb_); \
        qraw[0] = qs_[0]; qraw[1] = qs_[1]; kraw[0] = ks_[0]; kraw[1] = ks_[1]; \
        _Pragma("unroll") for (int d_ = 0; d_ < 2; ++d_) { const v4u* bs_ = (const v4u*)((const _Float16*)Bc + (r0_ + s_) * 1536 + d_ * 768 + hd_ * 128 + dkb_); braw[d_][0] = bs_[0]; braw[d_][1] = bs_[1]; } \
        const v4u* vs_ = (const v4u*)(H + (r0_ + (tid & 63)) * HP + C_AV + hd_ * 256 + (tid >> 6) * 32); _Pragma("unroll") for (int i_ = 0; i_ < 4; ++i_) vraw[i_] = vs_[i_]; } while (0)
    if (F.vcu < 512 * 6) C3_LOAD(F.vcu);
    for (int u = F.vcu; u < 512 * 6; u += F.G) {
        const int c = u / 6, hd = u - c * 6; const size_t r0 = (size_t)c * 64;
        bf16x8 sfr[2][4][2];
#pragma unroll
        for (int dir = 0; dir < 2; ++dir) { const bf16* Sg = STb + (size_t)((c * 6 + hd) * 2 + dir) * 32768;
#pragma unroll
            for (int ks = 0; ks < 4; ++ks)
#pragma unroll
                for (int n = 0; n < 2; ++n) sfr[dir][ks][n] = *(const bf16x8*)(Sg + (32 * wave + 16 * n + fr) * 128 + 32 * ks + 8 * fq); }
        __syncthreads();
        { const int s = tid >> 3, dkb = (tid & 7) * 16; float q0[16], k0[16]; unpack8(qraw[0], q0); unpack8(qraw[1], q0 + 8); unpack8(kraw[0], k0); unpack8(kraw[1], k0 + 8);
#pragma unroll
          for (int dir = 0; dir < 2; ++dir) { float qx[16], kx[16];
#pragma unroll
            for (int i = 0; i < 4; ++i) { const f32x4 bb = h4q(braw[dir][i >> 1], i & 1);
#pragma unroll
                for (int j = 0; j < 4; ++j) { const float e = __expf(bb[j]); qx[4 * i + j] = q0[4 * i + j] * e * 0.08838834764831845f; kx[4 * i + j] = k0[4 * i + j] * __builtin_amdgcn_rcpf(e); } }
            v4u w;
            w.x = pk2(qx[0], qx[1]); w.y = pk2(qx[2], qx[3]); w.z = pk2(qx[4], qx[5]); w.w = pk2(qx[6], qx[7]); *(LAS v4u*)(Q1 + (dir * 64 + s) * PQ + dkb * 2) = w;
            w.x = pk2(qx[8], qx[9]); w.y = pk2(qx[10], qx[11]); w.z = pk2(qx[12], qx[13]); w.w = pk2(qx[14], qx[15]); *(LAS v4u*)(Q1 + (dir * 64 + s) * PQ + dkb * 2 + 16) = w;
            w.x = pk2(kx[0], kx[1]); w.y = pk2(kx[2], kx[3]); w.z = pk2(kx[4], kx[5]); w.w = pk2(kx[6], kx[7]); *(LAS v4u*)(K1 + (dir * 64 + s) * PQ + dkb * 2) = w;
            w.x = pk2(kx[8], kx[9]); w.y = pk2(kx[10], kx[11]); w.z = pk2(kx[12], kx[13]); w.w = pk2(kx[14], kx[15]); *(LAS v4u*)(K1 + (dir * 64 + s) * PQ + dkb * 2 + 16) = w; } }
        { const int s = tid & 63, dvb = (tid >> 6) * 32;
#pragma unroll
          for (int i = 0; i < 4; ++i) { const v4u w = vraw[i]; const unsigned ww[4] = {w.x, w.y, w.z, w.w};
#pragma unroll
              for (int j = 0; j < 4; ++j) { *(LAS bf16*)(VT + (dvb + 8 * i + 2 * j) * PV + s * 2) = (bf16)(ww[j] & 0xffffu); *(LAS bf16*)(VT + (dvb + 8 * i + 2 * j + 1) * PV + s * 2) = (bf16)(ww[j] >> 16); } } }
        if (u + F.G < 512 * 6) C3_LOAD(u + F.G);
        v2u gtr[4][2];
#pragma unroll
        for (int m = 0; m < 4; ++m)
#pragma unroll
            for (int n = 0; n < 2; ++n) gtr[m][n] = *(const v2u*)(H + (r0 + 16 * m + fr) * HP + C_AG + hd * 256 + 32 * wave + 16 * n + 4 * fq);
        __syncthreads();
        { const int mt = wave >> 1, nt0 = (wave & 1) * 2;
#pragma unroll
          for (int dir = 0; dir < 2; ++dir) { f32x4 sc[2] = {(f32x4){0.f, 0.f, 0.f, 0.f}, (f32x4){0.f, 0.f, 0.f, 0.f}};
#pragma unroll
              for (int ks = 0; ks < 4; ++ks) { const bf16x8 af = ldsfrag(Q1 + dir * 64 * PQ, PQ, 16 * mt, 32 * ks, fr, fq);
#pragma unroll
                  for (int nn = 0; nn < 2; ++nn) sc[nn] = MFMA16(ldsfrag(K1 + dir * 64 * PQ, PQ, 16 * (nt0 + nn), 32 * ks, fr, fq), af, sc[nn]); }
              const int t = 16 * mt + fr;
#pragma unroll
              for (int nn = 0; nn < 2; ++nn) { const int sb_ = 16 * (nt0 + nn) + 4 * fq; float p[4];
#pragma unroll
                  for (int j = 0; j < 4; ++j) { const int s_ = sb_ + j; const bool ok = dir == 0 ? s_ <= t : s_ >= t; p[j] = ok ? sc[nn][j] : 0.f; }
                  v2u w; w.x = pk2(p[0], p[1]); w.y = pk2(p[2], p[3]); *(LAS v2u*)(Pm + (dir * 64 + t) * PV + sb_ * 2) = w; } } }
        __syncthreads();
        f32x4 acc[4][2];
#pragma unroll
        for (int m = 0; m < 4; ++m) { acc[m][0] = (f32x4){0.f, 0.f, 0.f, 0.f}; acc[m][1] = (f32x4){0.f, 0.f, 0.f, 0.f}; }
#pragma unroll
        for (int dir = 0; dir < 2; ++dir) {
#pragma unroll
            for (int ks = 0; ks < 4; ++ks) {
#pragma unroll
                for (int m = 0; m < 4; ++m) { const bf16x8 af = ldsfrag(Q1 + dir * 64 * PQ, PQ, 16 * m, 32 * ks, fr, fq); acc[m][0] = MFMA16(sfr[dir][ks][0], af, acc[m][0]); acc[m][1] = MFMA16(sfr[dir][ks][1], af, acc[m][1]); } }
#pragma unroll
            for (int ks = 0; ks < 2; ++ks) { const bf16x8 b0 = ldsfrag(VT, PV, 32 * wave, 32 * ks, fr, fq), b1 = ldsfrag(VT, PV, 32 * wave + 16, 32 * ks, fr, fq);
#pragma unroll
                for (int m = 0; m < 4; ++m) { const bf16x8 af = ldsfrag(Pm + dir * 64 * PV, PV, 16 * m, 32 * ks, fr, fq); acc[m][0] = MFMA16(b0, af, acc[m][0]); acc[m][1] = MFMA16(b1, af, acc[m][1]); } } }
#pragma unroll
        for (int m = 0; m < 4; ++m) { float ss = 0.f;
#pragma unroll
            for (int n = 0; n < 2; ++n)
#pragma unroll
                for (int j = 0; j < 4; ++j) ss += acc[m][n][j] * acc[m][n][j];
            ss += shx<16>(ss); ss = sum32(ss);
            if (fq == 0) red[(16 * m + fr) * 8 + wave] = ss; }
        __syncthreads();
#pragma unroll
        for (int m = 0; m < 4; ++m) { const int t = 16 * m + fr; const f32x4 ra = *(const LAS f32x4*)(red + t * 8), rb = *(const LAS f32x4*)(red + t * 8 + 4);
            const float tot = ((ra.x + ra.y) + (ra.z + ra.w)) + ((rb.x + rb.y) + (rb.z + rb.w)); const float rstd = 1.0f / sqrtf(tot * (1.f / 256.f) + 1e-6f);
            const size_t row = r0 + t;
#pragma unroll
            for (int n = 0; n < 2; ++n) { const int dv = 32 * wave + 16 * n + 4 * fq; const f32x4 g = *(const f32x4*)(gn + dv); const v2u gt = gtr[m][n];
                v2u w; w.x = pk2(acc[m][n][0] * rstd * g.x * bflo(gt.x), acc[m][n][1] * rstd * g.y * bfhi(gt.x)); w.y = pk2(acc[m][n][2] * rstd * g.z * bflo(gt.y), acc[m][n][3] * rstd * g.w * bfhi(gt.y));
                *(v2u*)(O + row * D + O_A + hd * 256 + dv) = w; } }
    }
#undef C3_LOAD
}

__global__ void __launch_bounds__(NWAVES * 64, 2) fwd_kernel(Args args) {
    extern __shared__ __attribute__((aligned(16))) unsigned char lds[];
    Frame F;
    F.lds = (LAS unsigned char*)lds;
    F.wv = __builtin_amdgcn_readfirstlane((int)threadIdx.x >> 6);
    volatile LAS unsigned* MISC = (volatile LAS unsigned*)(F.lds + MISC_OFF);
    F.G = gridDim.x; { const int bx = blockIdx.x; F.vcu = (F.G % 8 == 0) ? (bx % 8) * (F.G / 8) + bx / 8 : bx; }
    unsigned char* ws = args.ws;
    gu32* ctl = (gu32*)(ws + WS_CTL);
    for (int u = threadIdx.x; u < (LDS_BYTES - LDSCTL_OFF) / 4; u += NWAVES * 64) ((LAS unsigned*)(F.lds + LDSCTL_OFF))[u] = 0u;
    __syncthreads();
    XcdBarrier bar; bar.bar = (unsigned*)(ctl + CW_BAR); bar.x = 0; bar.st = nullptr; bar.wv = F.wv;
    if (N_LAUNCHES == 1) bar = xcd_barrier_post((unsigned*)(ctl + CW_BAR), MISC + 8, F.wv);
    const int lo = args.ph_lo, hi = args.ph_hi;
#define IN(k) (lo <= (k) && (k) < hi)
#define REPS(bit) ((DUP_MASK & (bit)) ? (hi > 16 ? 2 : 1) : 1)
#define SEAM(k) do { if (IN(k) && IN((k) + 1)) xcd_barrier(bar); } while (0)

    if (IN(0)) { for (int rep = 0; rep < REPS(1); ++rep) phase_convert(F, args); }
    SEAM(0);
    for (int layer = 0; layer < DEPTH; ++layer) {
        const int pb = 1 + 8 * layer;
        if (IN(pb + 0)) { for (int rep = 0; rep < REPS(2); ++rep) phase_rmsnorm(F, args, layer); }
        SEAM(pb + 0);
        if (IN(pb + 1)) {
            pg8::Gemm g{(const bf16*)(ws + WS_XN), (const bf16*)(ws + WS_WIN + layer * (190 * MiB)), (const bf16*)(ws + WS_MG)};
            Sched1 S{(int)blockIdx.x, F.G};
            Epi1 E{(bf16*)(ws + WS_H), (float*)(ws + WS_LR), args.in[14] + layer * 3 * D, ws + WS_G};
            for (int rep = 0; rep < REPS(4); ++rep) {
                pg8::gemm_phase<Epi1, Sched1, true, true>(F.lds + RING_OFF, g, S, E, F.wv);
#if FP8_ATT
                { int c8 = (int)blockIdx.x, g8 = F.G; asm volatile("" : "+s"(c8), "+s"(g8));
                  Sched1F8 S8{c8, g8}; Epi1F8 E8{(bf16*)(ws + WS_H), args.in[14] + layer * 3 * D, ws + WS_G}; pg8::gemm_phase<Epi1F8, Sched1F8, true, true, true>(F.lds + RING_OFF, g, S8, E8, F.wv); }
#endif
            }
        }
        SEAM(pb + 1);
        if (IN(pb + 2)) { phase_prep(F, args, layer); }
        SEAM(pb + 2);
        if (IN(pb + 3)) {
#if MFMA_SGU
            for (int rep = 0; rep < REPS(16); ++rep) phase_sgu(F, args, layer);
#endif
#if MFMA_ATT
            for (int rep = 0; rep < REPS(32); ++rep) phase_attn(F, args, layer);
#endif
#if MFMA_GLA
            for (int rep = 0; rep < REPS(64); ++rep) phase_gla_c1(F, args, layer);
#else
            phase_mix_naive(F, args, layer);
#endif
        }
        SEAM(pb + 3);
        if (IN(pb + 4)) {
#if MFMA_GLA
            phase_gla_scan(F, args);
#endif
        }
        SEAM(pb + 4);
        if (IN(pb + 5)) {
#if MFMA_GLA
            for (int rep = 0; rep < REPS(128); ++rep) phase_gla_c3(F, args, layer);
#else
            phase_gla_fin(F, args, layer);
#endif
        }
        SEAM(pb + 5);
        if (IN(pb + 6)) {
            pg8::Gemm g{(const bf16*)(ws + WS_XN), (const bf16*)(ws + WS_WBR + layer * (32 * MiB)), nullptr};
            Sched2 S{(int)blockIdx.x, F.G};
            Epi2 E{ws + WS_G, (bf16*)(ws + WS_MG)};
            if (STAG2 && (blockIdx.x & 1)) { const unsigned long long t0 = __builtin_amdgcn_s_memrealtime(); while (__builtin_amdgcn_s_memrealtime() - t0 < (unsigned long long)STAG2) __builtin_amdgcn_s_sleep(8); }
            for (int rep = 0; rep < REPS(256); ++rep) pg8::gemm_phase<Epi2, Sched2, true, true>(F.lds + RING_OFF, g, S, E, F.wv);
        }
        SEAM(pb + 6);
        if (IN(pb + 7)) {
            pg8::Gemm g{(const bf16*)(ws + WS_MG), (const bf16*)(ws + WS_WOUT + layer * (32 * MiB)), nullptr};
            Sched3 S{(int)blockIdx.x, F.G};
            Epi3 E{args.in[0], args.in[1], args.out, layer};
            if (STAG3 && (blockIdx.x & 1)) { const unsigned long long t0 = __builtin_amdgcn_s_memrealtime(); while (__builtin_amdgcn_s_memrealtime() - t0 < (unsigned long long)STAG3) __builtin_amdgcn_s_sleep(8); }
            for (int rep = 0; rep < (layer == 0 ? REPS(512) : 1); ++rep) pg8::gemm_phase<Epi3, Sched3, true, true>(F.lds + RING_OFF, g, S, E, F.wv);
        }
        SEAM(pb + 7);
    }
#undef IN
#undef SEAM
}

extern "C" void kernel_launch(void* const* d_in, const int* in_sizes, int n_in, void* d_out, int out_size, void* d_ws, size_t ws_size, hipStream_t stream) {
    static int grid = 0;
    if (grid == 0) {
        if (n_in != 17 || ws_size < WS_END) { fprintf(stderr, "kernel_launch: bad inputs / workspace (%d, %zu < %zu)\n", n_in, ws_size, (size_t)WS_END); grid = -1; return; }
        int dev = 0, cus = 0;
        if (hipGetDevice(&dev) != hipSuccess || hipDeviceGetAttribute(&cus, hipDeviceAttributeMultiprocessorCount, dev) != hipSuccess) { grid = -1; return; }
        if (hipFuncSetAttribute((const void*)fwd_kernel, hipFuncAttributeMaxDynamicSharedMemorySize, LDS_BYTES) != hipSuccess) { grid = -1; return; }
        int per_cu = 0;
        (void)hipOccupancyMaxActiveBlocksPerMultiprocessor(&per_cu, (const void*)fwd_kernel, NWAVES * 64, LDS_BYTES);
        (void)hipGetLastError();
        grid = cus;
    }
    if (grid < 0) return;
    (void)hipMemsetAsync((char*)d_ws + WS_CTL, 0, CTL_ZERO_BYTES, stream);
    Args a{};
    for (int i = 0; i < 17; ++i) a.in[i] = (const float*)d_in[i];
    a.out = (float*)d_out; a.ws = (unsigned char*)d_ws;
    if (N_LAUNCHES == 1) { a.ph_lo = 0; a.ph_hi = N_PHASES; hipLaunchKernelGGL(fwd_kernel, dim3(grid), dim3(NWAVES * 64), LDS_BYTES, stream, a); }
    else for (int p = 0; p < N_PHASES; ++p) { a.ph_lo = p; a.ph_hi = p + 1; hipLaunchKernelGGL(fwd_kernel, dim3(grid), dim3(NWAVES * 64), LDS_BYTES, stream, a); }
}
```
